# Optimizing an MI355X kernel written in HIP

```python
import math
import jax, jax.numpy as jnp
from jax import lax
import numpy as np

D_MODEL = 1024
BATCH = 8
SEQ = 4096
DEPTH = 2

HEAD_DIM = 64
ROT_DIM = HEAD_DIM // 4
ROPE_THETA = 500000.0
RMS_EPS = 1e-6
CONV_WIDTH = D_MODEL // 2
CONV_K = 3
DIFF_HEADS = (D_MODEL // 2) // (2 * HEAD_DIM)
DIFF_VDIM = 2 * HEAD_DIM
DIFF_WIDTH = DIFF_HEADS * 2 * HEAD_DIM
DIFF_EPS = 1e-5
QBLK = 128
EVEN_IN = 3 * CONV_WIDTH + 3 * DIFF_WIDTH
SWA_HEADS = D_MODEL // HEAD_DIM
SWA_GROUP = 8
SWA_KV_HEADS = SWA_HEADS // SWA_GROUP
WINDOW = 128
ODD_IN = (SWA_HEADS + 2 * SWA_KV_HEADS) * HEAD_DIM
D_FF = 4 * D_MODEL
N_EVEN = (DEPTH + 1) // 2
N_ODD = DEPTH // 2

kernel_name = "hybrid_conv_diffattn_swa_sink_trunk"


def rmsnorm(x, w, eps=RMS_EPS):
    xf = x.astype(jnp.float32)
    xf = xf * lax.rsqrt(jnp.mean(xf * xf, axis=-1, keepdims=True) + eps)
    return (xf * w.astype(jnp.float32)).astype(x.dtype)


def rope_tables(positions):
    inv_freq = ROPE_THETA ** (-jnp.arange(0, ROT_DIM, 2, dtype=jnp.float32) / ROT_DIM)
    ang = positions.astype(jnp.float32)[..., None] * inv_freq
    return jnp.cos(ang), jnp.sin(ang)


def apply_partial_rope(x, cos, sin):
    half = ROT_DIM // 2
    extra = x.ndim - 3
    c = cos.reshape(cos.shape[:2] + (1,) * extra + (half,))
    s = sin.reshape(sin.shape[:2] + (1,) * extra + (half,))
    xr = x[..., :ROT_DIM].astype(jnp.float32)
    x1, x2 = xr[..., :half], xr[..., half:]
    rot = jnp.concatenate([x1 * c - x2 * s, x2 * c + x1 * s], axis=-1)
    return jnp.concatenate([rot.astype(x.dtype), x[..., ROT_DIM:]], axis=-1)


def causal_short_conv(u, w):
    S = u.shape[1]
    up = jnp.pad(u, ((0, 0), (CONV_K - 1, 0), (0, 0)))
    return sum(w[i] * up[:, i:i + S] for i in range(CONV_K))


def diff_attention(q, k, v, lam, subln_w, lam_init):
    B, S, H, _, d = q.shape
    nb = S // QBLK
    scale = d ** -0.5
    qb = jnp.moveaxis(q.reshape(B, nb, QBLK, H, 2, d), 1, 0)
    kpos = jnp.arange(S)

    def one_block(args):
        blk, qblk = args
        s = jnp.einsum('bqhcd,bkhcd->bhcqk', qblk, k,
                       preferred_element_type=jnp.float32) * scale
        qpos = blk * QBLK + jnp.arange(QBLK)
        mask = kpos[None, :] <= qpos[:, None]
        p = jax.nn.softmax(jnp.where(mask, s, -jnp.inf), axis=-1)
        a = p[:, :, 0] - lam[None, None, None, None] * p[:, :, 1]
        return jnp.einsum('bhqk,bkhe->bqhe', a.astype(v.dtype), v)

    o = lax.map(one_block, (jnp.arange(nb), qb))
    o = jnp.moveaxis(o, 0, 1).reshape(B, S, H, 2 * d)
    o = rmsnorm(o, subln_w, DIFF_EPS) * (1.0 - lam_init)
    return o.reshape(B, S, H * 2 * d)


def even_mixer(h, cos, sin, w_in, conv_w, lq1, lk1, lq2, lk2, subln_w, w_out, lam_init):
    B, S, _ = h.shape
    proj = h @ w_in
    c0 = CONV_WIDTH
    gb, gc, xc, q, k, v = jnp.split(
        proj, [c0, 2 * c0, 3 * c0, 3 * c0 + DIFF_WIDTH, 3 * c0 + 2 * DIFF_WIDTH], axis=-1)
    conv_out = gb * causal_short_conv(gc * xc, conv_w)
    q = apply_partial_rope(q.reshape(B, S, DIFF_HEADS, 2, HEAD_DIM), cos, sin)
    k = apply_partial_rope(k.reshape(B, S, DIFF_HEADS, 2, HEAD_DIM), cos, sin)
    v = v.reshape(B, S, DIFF_HEADS, DIFF_VDIM)
    f32 = jnp.float32
    lam = (jnp.exp(jnp.sum(lq1.astype(f32) * lk1.astype(f32)))
           - jnp.exp(jnp.sum(lq2.astype(f32) * lk2.astype(f32))) + lam_init)
    diff_out = diff_attention(q, k, v, lam, subln_w, lam_init)
    return jnp.concatenate([conv_out, diff_out], axis=-1) @ w_out


def band(t, nb):
    B, S, KV, d = t.shape
    tp = jnp.pad(t, ((0, 0), (WINDOW, 0), (0, 0), (0, 0)))
    prev = tp[:, :S].reshape(B, nb, WINDOW, KV, d)
    cur = t.reshape(B, nb, WINDOW, KV, d)
    return jnp.concatenate([prev, cur], axis=2)


def sliding_window_attention(q, k, v, sinks):
    B, S, H, d = q.shape
    nb = S // WINDOW
    qb = q.reshape(B, nb, WINDOW, SWA_KV_HEADS, SWA_GROUP, d)
    kb, vb = band(k, nb), band(v, nb)
    s = jnp.einsum('bnqkgd,bnjkd->bnkgqj', qb, kb,
                   preferred_element_type=jnp.float32) * (d ** -0.5)
    i = jnp.arange(WINDOW)[:, None]
    j = jnp.arange(2 * WINDOW)[None, :]
    dist = i + WINDOW - j
    in_band = (dist >= 0) & (dist < WINDOW)
    key_valid = (jnp.arange(nb)[:, None, None] * WINDOW - WINDOW + j[None]) >= 0
    mask = in_band[None] & key_valid
    s = jnp.where(mask[None, :, None, None], s, -jnp.inf)
    sink = sinks.astype(jnp.float32).reshape(SWA_KV_HEADS, SWA_GROUP)[None, None, :, :, None, None]
    sink = jnp.broadcast_to(sink, s.shape[:-1] + (1,))
    p = jax.nn.softmax(jnp.concatenate([s, sink], axis=-1), axis=-1)[..., :-1]
    o = jnp.einsum('bnkgqj,bnjkd->bnqkgd', p.astype(v.dtype), vb)
    return o.reshape(B, S, H * d)


def odd_mixer(h, cos, sin, w_qkv, b_qkv, sinks, w_o, b_o):
    B, S, _ = h.shape
    proj = h @ w_qkv + b_qkv
    nq = SWA_HEADS * HEAD_DIM
    nk = SWA_KV_HEADS * HEAD_DIM
    q, k, v = jnp.split(proj, [nq, nq + nk], axis=-1)
    q = apply_partial_rope(q.reshape(B, S, SWA_HEADS, HEAD_DIM), cos, sin)
    k = apply_partial_rope(k.reshape(B, S, SWA_KV_HEADS, HEAD_DIM), cos, sin)
    v = v.reshape(B, S, SWA_KV_HEADS, HEAD_DIM)
    return sliding_window_attention(q, k, v, sinks) @ w_o + b_o


def squared_relu_mlp(h, w1, w2):
    return jnp.square(jax.nn.relu(h @ w1)) @ w2


def setup_inputs(seed: int = 0) -> dict:
    key = jax.random.key(seed)
    ks = jax.random.split(key, 24)
    f32 = jnp.float32

    def nrm(k, shape, scale):
        return jax.random.normal(k, shape, f32) * scale

    def gain(k, shape):
        return 1.0 + 0.05 * jax.random.normal(k, shape, f32)

    offset = jax.random.randint(ks[1], (BATCH, 1), 0, SEQ, dtype=jnp.int32)
    positions = offset + jnp.arange(SEQ, dtype=jnp.int32)[None, :]
    return {
        "x": nrm(ks[0], (BATCH, SEQ, D_MODEL), 1.0),
        "positions": positions,
        "norm_pre_mix": gain(ks[2], (DEPTH, D_MODEL)),
        "norm_post_mix": gain(ks[3], (DEPTH, D_MODEL)),
        "norm_pre_mlp": gain(ks[4], (DEPTH, D_MODEL)),
        "norm_post_mlp": gain(ks[5], (DEPTH, D_MODEL)),
        "even_w_in": nrm(ks[6], (N_EVEN, D_MODEL, EVEN_IN), D_MODEL ** -0.5),
        "even_conv_w": nrm(ks[7], (N_EVEN, CONV_K, CONV_WIDTH), CONV_K ** -0.5),
        "even_lambda_q1": nrm(ks[8], (N_EVEN, HEAD_DIM), 0.1),
        "even_lambda_k1": nrm(ks[9], (N_EVEN, HEAD_DIM), 0.1),
        "even_lambda_q2": nrm(ks[10], (N_EVEN, HEAD_DIM), 0.1),
        "even_lambda_k2": nrm(ks[11], (N_EVEN, HEAD_DIM), 0.1),
        "even_subln_w": gain(ks[12], (N_EVEN, DIFF_VDIM)),
        "even_w_out": nrm(ks[13], (N_EVEN, D_MODEL, D_MODEL), D_MODEL ** -0.5),
        "odd_w_qkv": nrm(ks[14], (N_ODD, D_MODEL, ODD_IN), D_MODEL ** -0.5),
        "odd_b_qkv": nrm(ks[15], (N_ODD, ODD_IN), 0.02),
        "odd_sinks": nrm(ks[16], (N_ODD, SWA_HEADS), 0.5),
        "odd_w_o": nrm(ks[17], (N_ODD, D_MODEL, D_MODEL), D_MODEL ** -0.5),
        "odd_b_o": nrm(ks[18], (N_ODD, D_MODEL), 0.02),
        "mlp_w1": nrm(ks[19], (DEPTH, D_MODEL, D_FF), D_MODEL ** -0.5),
        "mlp_w2": nrm(ks[20], (DEPTH, D_FF, D_MODEL), D_FF ** -0.5),
    }


def reference(x, positions, norm_pre_mix, norm_post_mix, norm_pre_mlp, norm_post_mlp,
              even_w_in, even_conv_w, even_lambda_q1, even_lambda_k1, even_lambda_q2,
              even_lambda_k2, even_subln_w, even_w_out, odd_w_qkv, odd_b_qkv, odd_sinks,
              odd_w_o, odd_b_o, mlp_w1, mlp_w2):
    cos, sin = rope_tables(positions)
    for l in range(DEPTH):
        h = rmsnorm(x, norm_pre_mix[l])
        if l % 2 == 0:
            e = l // 2
            lam_init = 0.8 - 0.6 * math.exp(-0.3 * l)
            h = even_mixer(h, cos, sin, even_w_in[e], even_conv_w[e], even_lambda_q1[e],
                           even_lambda_k1[e], even_lambda_q2[e], even_lambda_k2[e],
                           even_subln_w[e], even_w_out[e], lam_init)
        else:
            o = l // 2
            h = odd_mixer(h, cos, sin, odd_w_qkv[o], odd_b_qkv[o], odd_sinks[o],
                          odd_w_o[o], odd_b_o[o])
        x = x + rmsnorm(h, norm_post_mix[l])
        h = squared_relu_mlp(rmsnorm(x, norm_pre_mlp[l]), mlp_w1[l], mlp_w2[l])
        x = x + rmsnorm(h, norm_post_mlp[l])
    return x
```

```cpp
#include <hip/hip_runtime.h>
#include <hip/hip_cooperative_groups.h>
#include <cstdio>
#include <cstdint>
#include <cmath>
namespace cg = cooperative_groups;
namespace pg8 {
#define PG8_LAS __attribute__((address_space(3)))
typedef unsigned short bf16_t;
typedef short bf16x8 __attribute__((ext_vector_type(8)));
typedef float f32x4 __attribute__((ext_vector_type(4)));
typedef unsigned u32x4 __attribute__((ext_vector_type(4)));
constexpr int BM = 256, BK = 64, HALF = 128, HTB = HALF * BK * 2  , STAGE_BYTES = 8 * HTB, NXCD = 8, WGM = 8;

__host__ __device__ __forceinline__ int lds_byte(int r, int c) { const int st = (r >> 4) * 2 + (c >> 5), rr = r & 15, cc = c & 31, ob = rr * 64 + cc * 2; return st * 1024 + (ob ^ (((ob >> 9) & 1) << 5)); }
__host__ __device__ __forceinline__ void stage_rc(int b, int& R, int& C) { const int st = b / 1024, sb = b % 1024, swz = sb ^ (((sb >> 9) & 1) << 5); R = (st >> 1) * 16 + swz / 64; C = (st & 1) * 32 + (swz % 64) / 2; }
__host__ __device__ __forceinline__ int perm32(int rho) { const int n = rho >> 4, i = rho & 15; return 8 * (i >> 2) + 4 * n + (i & 3); }

struct Unit { int pm, pn; };
struct Gemm { const bf16_t* A; const bf16_t* Bt; int M, N, K; };

struct StaticOrder {
    int nM, nN, nwg, G, c;
    __host__ __device__ void init(int M, int N, int G_, int c_) { nM = M / BM; nN = N / BM; nwg = nM * nN; G = G_; c = c_; }
    __host__ __device__ bool next(int i, Unit& u) const {
        const long L = (long)i * G + c; if (L >= nwg) return false;
        int wgid = (int)L; { const int q = nwg / NXCD, r = nwg % NXCD, xcd = wgid % NXCD, off = wgid / NXCD; wgid = (xcd < r ? xcd * (q + 1) : r * (q + 1) + (xcd - r) * q) + off; }
        const int nig = WGM * nN, gid = wgid / nig, fm = gid * WGM, gsz = (nM - fm) < WGM ? (nM - fm) : WGM;
        u.pm = fm + ((wgid % nig) % gsz); u.pn = (wgid % nig) / gsz; return true;
    }
    __device__ __forceinline__ void a_ready(const Unit&) const {}
    __device__ __forceinline__ void done(const Unit&) const {}
};

__device__ __forceinline__ unsigned cvt_pk_bf16(float lo, float hi) { unsigned r; asm volatile("v_cvt_pk_bf16_f32 %0, %1, %2" : "=v"(r) : "v"(lo), "v"(hi)); return r; }
typedef float f32x2 __attribute__((ext_vector_type(2)));
struct RevOrder {
    StaticOrder so; int nrounds;
    __host__ __device__ bool next(int i, Unit& u) const { return i < nrounds && so.next(nrounds - 1 - i, u); }
    __device__ __forceinline__ void a_ready(const Unit&) const {}
    __device__ __forceinline__ void done(const Unit&) const {}
};
template <int MODE> struct EpiX {
    static constexpr bool PERM = true, AFTER_DRAIN = false;
    bf16_t* O; int ldc; const float* bias; const float* cs; int q_lo, q_hi, k_lo, k_hi; float qscale; const float* rs; int blk;
    __device__ __forceinline__ void operator()(const f32x4 (&acc)[2][2][4][2], const Unit& u, int wr, int wc, int fr, int fq) const {
        const int row0 = u.pm * BM + wr * 64 + fr; const int col0 = u.pn * BM + wc * 32 + 8 * fq;
        f32x4 bv[2][2];
#pragma unroll
        for (int bj = 0; bj < 2; ++bj)
#pragma unroll
            for (int n = 0; n < 2; ++n) bv[bj][n] = bias ? *(const f32x4*)(bias + col0 + bj * HALF + 4 * n) : (f32x4){0.f, 0.f, 0.f, 0.f};
        const bool ropelane = (MODE == 2) && ((wc & 1) == 0) && (fq < 2);
#pragma unroll
        for (int ai = 0; ai < 2; ++ai)
#pragma unroll
            for (int m = 0; m < 4; ++m) { const int row = row0 + ai * HALF + m * 16; bf16_t* rowp = blk ? O + ((size_t)u.pm * blk + u.pn) * 65536 + (size_t)(row - u.pm * BM) * 256 + (col0 - u.pn * BM) : O + (size_t)row * ldc + col0;
                const float rsv = rs ? rs[row] : 1.0f;
                f32x4 c01 = (f32x4){1.f, 0.f, 1.f, 0.f}, c23 = (f32x4){1.f, 0.f, 1.f, 0.f};
                if (MODE == 2) { if (ropelane) { const float* cp = cs + (size_t)row * 16 + fq * 8; c01 = *(const f32x4*)cp; c23 = *(const f32x4*)(cp + 4); } }
#pragma unroll
                for (int bj = 0; bj < 2; ++bj) { f32x4 v0 = acc[ai][bj][m][0] * rsv + bv[bj][0], v1 = acc[ai][bj][m][1] * rsv + bv[bj][1];
                    if (MODE == 1) { v0 = __builtin_elementwise_max(v0, (f32x4){0.f, 0.f, 0.f, 0.f}); v1 = __builtin_elementwise_max(v1, (f32x4){0.f, 0.f, 0.f, 0.f}); v0 = v0 * v0; v1 = v1 * v1; }
                    if (MODE == 2) { const int cb = u.pn * BM + bj * HALF + wc * 32; const bool isq = cb >= q_lo && cb < q_hi, isk = cb >= k_lo && cb < k_hi;
                        if (ropelane && (isq || isk)) {
                            f32x4 r0, r1;
                            r0[0] = v0[0] * c01[0] - v0[1] * c01[1]; r0[1] = v0[1] * c01[0] + v0[0] * c01[1];
                            r0[2] = v0[2] * c01[2] - v0[3] * c01[3]; r0[3] = v0[3] * c01[2] + v0[2] * c01[3];
                            r1[0] = v1[0] * c23[0] - v1[1] * c23[1]; r1[1] = v1[1] * c23[0] + v1[0] * c23[1];
                            r1[2] = v1[2] * c23[2] - v1[3] * c23[3]; r1[3] = v1[3] * c23[2] + v1[2] * c23[3];
                            v0 = r0; v1 = r1; }
                        if (isq) { v0 = v0 * qscale; v1 = v1 * qscale; } }
                    u32x4 w; w.x = cvt_pk_bf16(v0[0], v0[1]); w.y = cvt_pk_bf16(v0[2], v0[3]); w.z = cvt_pk_bf16(v1[0], v1[1]); w.w = cvt_pk_bf16(v1[2], v1[3]);
                    *(u32x4*)(rowp + bj * HALF) = w; } }
    }
};
struct EpiU {
    static constexpr bool PERM = true, AFTER_DRAIN = false;
    bf16_t* O; int ldc; const float* rs;
    __device__ __forceinline__ void operator()(const f32x4 (&acc)[2][2][4][2], const Unit& u, int wr, int wc, int fr, int fq) const {
        const int row0 = u.pm * BM + wr * 64 + fr; bf16_t* base = O + 512 + (u.pn - 2) * 128 + wc * 32 + 8 * fq;
#pragma unroll
        for (int ai = 0; ai < 2; ++ai)
#pragma unroll
            for (int m = 0; m < 4; ++m) { const int row = row0 + ai * HALF + m * 16; const float r2 = rs[row] * rs[row];
                const f32x4 p0 = acc[ai][0][m][0] * acc[ai][1][m][0] * r2, p1 = acc[ai][0][m][1] * acc[ai][1][m][1] * r2;
                u32x4 w; w.x = cvt_pk_bf16(p0[0], p0[1]); w.y = cvt_pk_bf16(p0[2], p0[3]); w.z = cvt_pk_bf16(p1[0], p1[1]); w.w = cvt_pk_bf16(p1[2], p1[3]);
                *(u32x4*)(base + (size_t)row * ldc) = w; }
    }
};
struct SubsetOrder {
    StaticOrder so; int keep, skip;
    __host__ __device__ bool next(int i, Unit& u) const { if (!so.next(i, u)) return false; if (u.pn >= keep) u.pn += skip; return true; }
    __device__ __forceinline__ void a_ready(const Unit&) const {}
    __device__ __forceinline__ void done(const Unit&) const {}
};
template <class Epi, class Sched, bool ALIGN_EPI = false, bool SP2 = false, bool ABLK = false>
__device__ __forceinline__ void gemm_phase(PG8_LAS unsigned char* lds, const Gemm g, const Sched& S, const Epi& E) {
    int tid_ = threadIdx.x; asm volatile("" : "+v"(tid_));
    const int tid = tid_, wid = __builtin_amdgcn_readfirstlane(tid >> 6), lane = tid & 63, wr = wid >> 2, wc = wid & 3, fr = lane & 15, fq = lane >> 4;
    const int K = g.K, nt = K / BK;
    unsigned voffA[2], voffB[2];
#pragma unroll
    for (int i = 0; i < 2; ++i) { int R, C; stage_rc(tid * 16 + i * 8192, R, C); const int Rb = Epi::PERM ? ((R & ~31) + perm32(R & 31)) : R;
        voffA[i] = (unsigned)(R * (ABLK ? 256 : K) + C) * 2u; voffB[i] = (unsigned)(Rb * K + C) * 2u; }
    const size_t kstep = (size_t)(BK * 2);
    const size_t hstep = (size_t)HALF * K * 2;
    const size_t tstep = 2 * hstep;
    const size_t hstepA = ABLK ? (size_t)HALF * 256 * 2 : hstep;
#define PG8_KA(t) (ABLK ? ((size_t)((t) >> 2) * 131072 + (size_t)(((t) >> 1) & 1) * 256) : (size_t)(t) * kstep)
    const unsigned ldsw = (unsigned)wid * 1024u;
    const int aoff = lds_byte(wr * 64 + fr, fq * 8), boff = lds_byte(wc * 32 + fr, fq * 8);
#define PG8_SA(b, h) (((b) * 2 + (h)) * HTB)
#define PG8_SB(b, h) ((4 + (b) * 2 + (h)) * HTB)
#define PG8_STAGE(bufoff, gbase, voff) do { _Pragma("unroll") for (int _i = 0; _i < 2; ++_i) \
        __builtin_amdgcn_global_load_lds((const unsigned*)((const char*)(gbase) + (voff)[_i]), (PG8_LAS unsigned*)(lds + (bufoff) + ldsw + _i * 8192), 16, 0, 0); } while (0)
#define PG8_LDA(dst, b, h) do { _Pragma("unroll") for (int m = 0; m < 4; ++m) _Pragma("unroll") for (int k = 0; k < 2; ++k) dst[m][k] = *(const PG8_LAS bf16x8*)(lds + PG8_SA(b, h) + aoff + m * 2048 + k * 1024); } while (0)
#define PG8_LDB(dst, b, h) do { _Pragma("unroll") for (int n = 0; n < 2; ++n) _Pragma("unroll") for (int k = 0; k < 2; ++k) dst[n][k] = *(const PG8_LAS bf16x8*)(lds + PG8_SB(b, h) + boff + n * 2048 + k * 1024); } while (0)
#define PG8_MMA(ai, bj, At, Bt) do { __builtin_amdgcn_s_setprio(1); _Pragma("unroll") for (int m = 0; m < 4; ++m) _Pragma("unroll") for (int n = 0; n < 2; ++n) _Pragma("unroll") for (int k = 0; k < 2; ++k) \
        acc[ai][bj][m][n] = __builtin_amdgcn_mfma_f32_16x16x32_bf16(Bt[n][k], At[m][k], acc[ai][bj][m][n], 0, 0, 0); __builtin_amdgcn_s_setprio(0); } while (0)
#define PG8_WAIT_V(n) asm volatile("s_waitcnt vmcnt(" #n ")" ::: "memory")
#define PG8_WAIT_L(n) asm volatile("s_waitcnt lgkmcnt(" #n ")" ::: "memory")
#define PG8_BAR __builtin_amdgcn_s_barrier()
#define PG8_SCHED __builtin_amdgcn_sched_barrier(0)
    Unit cur, nxt; int ui = 0;
    if (!S.next(0, cur)) return;
    f32x4 acc[2][2][4][2];
#pragma unroll
    for (int a = 0; a < 2; ++a)
#pragma unroll
        for (int b = 0; b < 2; ++b)
#pragma unroll
            for (int m = 0; m < 4; ++m)
#pragma unroll
                for (int n = 0; n < 2; ++n) acc[a][b][m][n] = (f32x4){0.f, 0.f, 0.f, 0.f};
    bf16x8 At[4][2], B0[2][2], B1[2][2];
    const char* cA = (const char*)g.A + (size_t)cur.pm * tstep; const char* cB = (const char*)g.Bt + (size_t)cur.pn * tstep;
    S.a_ready(cur);
    if constexpr (SP2) {
        PG8_STAGE(PG8_SB(0, 0), cB, voffB); PG8_STAGE(PG8_SB(0, 1), cB + hstep, voffB); PG8_STAGE(PG8_SA(0, 0), cA, voffA); PG8_STAGE(PG8_SA(0, 1), cA + hstepA, voffA);
        if (wr == 1) PG8_BAR;
        PG8_WAIT_V(2); PG8_BAR;
        PG8_STAGE(PG8_SB(1, 0), cB + kstep, voffB); PG8_STAGE(PG8_SA(1, 0), cA + kstep, voffA); PG8_STAGE(PG8_SB(1, 1), cB + hstep + kstep, voffB);
        PG8_WAIT_V(6); PG8_BAR;
    } else {
        PG8_STAGE(PG8_SB(0, 0), cB, voffB); PG8_STAGE(PG8_SA(0, 0), cA, voffA); PG8_STAGE(PG8_SB(0, 1), cB + hstep, voffB); PG8_STAGE(PG8_SA(0, 1), cA + hstepA, voffA);
        if (wr == 1) PG8_BAR;
        PG8_WAIT_V(4); PG8_BAR;
        PG8_STAGE(PG8_SB(1, 0), cB + kstep, voffB); PG8_STAGE(PG8_SA(1, 0), cA + kstep, voffA); PG8_STAGE(PG8_SB(1, 1), cB + hstep + kstep, voffB);
        PG8_WAIT_V(6); PG8_BAR;
    }
    for (;;) {
        const bool has_next = S.next(ui + 1, nxt);
        const char* nA = has_next ? (const char*)g.A + (size_t)nxt.pm * tstep : cA; const char* nB = has_next ? (const char*)g.Bt + (size_t)nxt.pn * tstep : cB;
        for (int t = 0; t < nt; t += 2) {
            const bool last = (t == nt - 2);
            const char* a1 = cA + PG8_KA(t) + kstep;
            const char* a2 = last ? nA : cA + PG8_KA(t + 2); const char* b2 = last ? nB : cB + (size_t)(t + 2) * kstep;
            const char* a3 = a2 + kstep; const char* b3 = b2 + kstep;
            if (last && has_next) S.a_ready(nxt);
            if constexpr (SP2) {
            PG8_LDB(B0, 0, 0); PG8_LDB(B1, 0, 1); PG8_SCHED; PG8_LDA(At, 0, 0); PG8_STAGE(PG8_SA(1, 1), a1 + hstepA, voffA);
            PG8_WAIT_V(8); PG8_WAIT_L(0); PG8_BAR; PG8_MMA(0, 0, At, B0); PG8_MMA(0, 1, At, B1); PG8_BAR; PG8_SCHED;
            PG8_LDA(At, 0, 1); PG8_STAGE(PG8_SB(0, 0), b2, voffB); PG8_STAGE(PG8_SB(0, 1), b2 + hstep, voffB); PG8_STAGE(PG8_SA(0, 0), a2, voffA);
            PG8_WAIT_V(8); PG8_WAIT_L(0); PG8_BAR; PG8_MMA(1, 0, At, B0); PG8_MMA(1, 1, At, B1); PG8_BAR; PG8_SCHED;
            PG8_LDB(B0, 1, 0); PG8_LDB(B1, 1, 1); PG8_SCHED; PG8_LDA(At, 1, 0); PG8_STAGE(PG8_SA(0, 1), a2 + hstepA, voffA);
            PG8_WAIT_V(8); PG8_WAIT_L(0); PG8_BAR; PG8_MMA(0, 0, At, B0); PG8_MMA(0, 1, At, B1); PG8_BAR; PG8_SCHED;
            PG8_LDA(At, 1, 1); PG8_STAGE(PG8_SB(1, 0), b3, voffB); PG8_STAGE(PG8_SB(1, 1), b3 + hstep, voffB); PG8_STAGE(PG8_SA(1, 0), a3, voffA);
            PG8_WAIT_V(8); PG8_WAIT_L(0); PG8_BAR; PG8_MMA(1, 0, At, B0); PG8_MMA(1, 1, At, B1); PG8_BAR; PG8_SCHED;
            } else {
            PG8_LDB(B0, 0, 0); PG8_SCHED; PG8_LDA(At, 0, 0); PG8_STAGE(PG8_SA(1, 1), a1 + hstepA, voffA);
            PG8_WAIT_L(8); PG8_BAR; PG8_WAIT_L(0); PG8_MMA(0, 0, At, B0); PG8_BAR; PG8_SCHED;
            PG8_LDB(B1, 0, 1); PG8_STAGE(PG8_SB(0, 0), b2, voffB);
            PG8_BAR; PG8_WAIT_L(0); PG8_MMA(0, 1, At, B1); PG8_BAR;
            PG8_LDA(At, 0, 1); PG8_STAGE(PG8_SA(0, 0), a2, voffA);
            PG8_BAR; PG8_WAIT_L(0); PG8_MMA(1, 0, At, B0); PG8_BAR; PG8_SCHED;
            PG8_STAGE(PG8_SB(0, 1), b2 + hstep, voffB);
            PG8_WAIT_V(6); PG8_BAR; PG8_MMA(1, 1, At, B1); PG8_BAR;
            PG8_LDB(B0, 1, 0); PG8_SCHED; PG8_LDA(At, 1, 0); PG8_STAGE(PG8_SA(0, 1), a2 + hstepA, voffA);
            PG8_WAIT_L(8); PG8_BAR; PG8_WAIT_L(0); PG8_MMA(0, 0, At, B0); PG8_BAR; PG8_SCHED;
            PG8_LDB(B1, 1, 1); PG8_STAGE(PG8_SB(1, 0), b3, voffB);
            PG8_BAR; PG8_WAIT_L(0); PG8_MMA(0, 1, At, B1); PG8_BAR;
            PG8_LDA(At, 1, 1); PG8_STAGE(PG8_SA(1, 0), a3, voffA);
            PG8_BAR; PG8_WAIT_L(0); PG8_MMA(1, 0, At, B0); PG8_BAR; PG8_SCHED;
            PG8_STAGE(PG8_SB(1, 1), b3 + hstep, voffB);
            PG8_WAIT_V(6); PG8_BAR; PG8_MMA(1, 1, At, B1); PG8_BAR;
            }
        }
        if constexpr (ALIGN_EPI) { if (wr == 0) PG8_BAR; }
        if constexpr (!Epi::AFTER_DRAIN) { E(acc, cur, wr, wc, fr, fq); S.done(cur); }
        if (!has_next) break;
#pragma unroll
        for (int a = 0; a < 2; ++a)
#pragma unroll
            for (int b = 0; b < 2; ++b)
#pragma unroll
                for (int m = 0; m < 4; ++m)
#pragma unroll
                    for (int n = 0; n < 2; ++n) acc[a][b][m][n] = (f32x4){0.f, 0.f, 0.f, 0.f};
        cur = nxt; cA = nA; cB = nB; ++ui;
        if constexpr (ALIGN_EPI) { if (wr == 1) PG8_BAR; }
    }
    PG8_WAIT_V(0);
    if constexpr (!ALIGN_EPI) { if (wr == 0) PG8_BAR; }
    PG8_BAR;
    if constexpr (Epi::AFTER_DRAIN) { E.fused(acc, cur, wr, wc, fr, fq, lds, wid, lane); S.done(cur); }
#undef PG8_KA
#undef PG8_SA
#undef PG8_SB
#undef PG8_STAGE
#undef PG8_LDA
#undef PG8_LDB
#undef PG8_MMA
#undef PG8_WAIT_V
#undef PG8_WAIT_L
#undef PG8_BAR
#undef PG8_SCHED
}
}
#include <hip/hip_bf16.h>
#include <cmath>
namespace attn_body {
using bf16=__hip_bfloat16;
using bf16x8=__attribute__((ext_vector_type(8)))short;
using s16x4=__attribute__((ext_vector_type(4)))short;
using f32x16=__attribute__((ext_vector_type(16)))float;
using u32x4=__attribute__((ext_vector_type(4)))unsigned;
constexpr int SEQ=4096,D=64,PQ=3072,PO=1024;
constexpr int NW=8,QBLK=32,QB=QBLK*NW,KVBLK=64,NQB=SEQ/QB;
constexpr int ATTN_UNIT_ROWS=QB;
__device__ __forceinline__ int crow(int r,int hi){return (r&3)+8*(r>>2)+4*hi;}
#define SBAR() __builtin_amdgcn_sched_barrier(0)
__device__ __forceinline__ void cmask(f32x16&p0,f32x16&p1,int jb,int qrel,int hi){
  const float NEG=-INFINITY; int kb=64*jb+4*hi;
  #pragma unroll
  for(int r=0;r<16;++r){int kv=kb+(r&3)+8*(r>>2); if(kv>qrel)p0[r]=NEG; if(kv+32>qrel)p1[r]=NEG;}
}

constexpr int NSLOT=3, SLOTB=8192;
constexpr int LDS_K=0, LDS_V=NSLOT*SLOTB, LDS_WS=2*NSLOT*SLOTB, LDS_OST=LDS_WS+NW*64*4, LDS_BYTES=LDS_OST+NW*4096;
constexpr float C2=0.125f*1.4426950408889634f;
__device__ __forceinline__ void glds16(const void*gsrc,unsigned lds_dst){unsigned keep;
  asm volatile("s_mov_b32 %0, m0\n\ts_mov_b32 m0, %2\n\ts_nop 0\n\tglobal_load_lds_dwordx4 %1, off\n\ts_mov_b32 m0, %0":"=&s"(keep):"v"(gsrc),"s"(lds_dst):"memory");}
__device__ __forceinline__ float max3f(float a,float b,float c){float r;asm("v_max3_f32 %0, %1, %2, %3":"=v"(r):"v"(a),"v"(b),"v"(c));return r;}
__device__ __forceinline__ float max2f(float a,float b){float r;asm("v_max_f32_e32 %0, %1, %2":"=v"(r):"v"(a),"v"(b));return r;}
__device__ __forceinline__ float fadd_s(float a,float b){float r;asm("v_add_f32_e32 %0, %1, %2":"=v"(r):"v"(a),"v"(b));return r;}
__device__ __forceinline__ float fsub_s(float a,float b){float r;asm("v_sub_f32_e32 %0, %1, %2":"=v"(r):"v"(a),"v"(b));return r;}
typedef float f32x2_t __attribute__((ext_vector_type(2))); typedef __bf16 bf16x2_t __attribute__((ext_vector_type(2)));
__device__ __forceinline__ unsigned cvtpk_s(float lo,float hi){f32x2_t v={lo,hi};bf16x2_t b=__builtin_convertvector(v,bf16x2_t);return __builtin_bit_cast(unsigned,b);}
#define WAIT_BAR(N) asm volatile("s_waitcnt vmcnt(" #N ") lgkmcnt(0)\n\ts_barrier":::"memory")

__device__ __forceinline__ void qkt(f32x16&p0,f32x16&p1,const char*Kslot,const bf16x8*qr,const f32x16&negm,int r32,int hi){
  const char*kb=Kslot+hi*1024+r32*16;
  #pragma unroll
  for(int d0=0;d0<4;++d0){
    const bf16x8 b0=*reinterpret_cast<const bf16x8*>(kb+d0*2048);
    const bf16x8 b1=*reinterpret_cast<const bf16x8*>(kb+d0*2048+512);
    if(d0==0){p0=__builtin_amdgcn_mfma_f32_32x32x16_bf16(b0,qr[0],negm,0,0,0);p1=__builtin_amdgcn_mfma_f32_32x32x16_bf16(b1,qr[0],negm,0,0,0);}
    else{p0=__builtin_amdgcn_mfma_f32_32x32x16_bf16(b0,qr[d0],p0,0,0,0);p1=__builtin_amdgcn_mfma_f32_32x32x16_bf16(b1,qr[d0],p1,0,0,0);}}
}
typedef __attribute__((address_space(3))) const char* lds_cptr;
typedef short v4i16_t __attribute__((ext_vector_type(4)));
__device__ __forceinline__ void kload8(bf16x8*kf,lds_cptr kp){
  kf[0]=*(const __attribute__((address_space(3))) bf16x8*)(kp);      kf[1]=*(const __attribute__((address_space(3))) bf16x8*)(kp+512);
  kf[2]=*(const __attribute__((address_space(3))) bf16x8*)(kp+2048); kf[3]=*(const __attribute__((address_space(3))) bf16x8*)(kp+2560);
  kf[4]=*(const __attribute__((address_space(3))) bf16x8*)(kp+4096); kf[5]=*(const __attribute__((address_space(3))) bf16x8*)(kp+4608);
  kf[6]=*(const __attribute__((address_space(3))) bf16x8*)(kp+6144); kf[7]=*(const __attribute__((address_space(3))) bf16x8*)(kp+6656);
}
__device__ __forceinline__ void kload2(bf16x8*kf,lds_cptr kp,int j){ kf[2*j]=*(const __attribute__((address_space(3))) bf16x8*)(kp+j*2048); kf[2*j+1]=*(const __attribute__((address_space(3))) bf16x8*)(kp+j*2048+512); }
__device__ __forceinline__ s16x4 vtr(lds_cptr p){ return __builtin_bit_cast(s16x4,__builtin_amdgcn_ds_read_tr16_b64_v4i16((__attribute__((address_space(3))) v4i16_t*)p)); }
__device__ __forceinline__ float rowmax(const f32x16&p0,const f32x16&p1){
  float a=max3f(p0[0],p0[1],p1[0]),b=max3f(p0[2],p0[3],p1[1]);a=max3f(a,p1[2],p1[3]);
  #pragma unroll
  for(int r=4;r<16;r+=4){a=max3f(a,p0[r],p0[r+1]);b=max3f(b,p0[r+2],p0[r+3]);a=max3f(a,p1[r],p1[r+1]);b=max3f(b,p1[r+2],p1[r+3]);}
  const float m=max2f(a,b);
  auto rr=__builtin_amdgcn_permlane32_swap(__float_as_uint(m),__float_as_uint(m),false,false);
  return max2f(__uint_as_float(rr[0]),__uint_as_float(rr[1]));
}
__device__ __forceinline__ void pv(f32x16*o,int vb,bf16x8 pa0,bf16x8 pa1,bf16x8 pa2,bf16x8 pa3){
  #pragma unroll
  for(int d0=0;d0<2;++d0){s16x4 lo[4],hi[4];
    #pragma unroll
    for(int ks=0;ks<4;++ks){
      asm volatile("ds_read_b64_tr_b16 %0,%1 offset:%c2":"=&v"(lo[ks]):"v"(vb),"i"(d0*4096+ks*1024):"memory");
      asm volatile("ds_read_b64_tr_b16 %0,%1 offset:%c2":"=&v"(hi[ks]):"v"(vb),"i"(d0*4096+ks*1024+512):"memory");}
    asm volatile("s_waitcnt lgkmcnt(0)":::"memory");SBAR();
    #define PK(k) (bf16x8){lo[k][0],lo[k][1],lo[k][2],lo[k][3],hi[k][0],hi[k][1],hi[k][2],hi[k][3]}
    o[d0]=__builtin_amdgcn_mfma_f32_32x32x16_bf16(pa0,PK(0),o[d0],0,0,0);
    o[d0]=__builtin_amdgcn_mfma_f32_32x32x16_bf16(pa1,PK(1),o[d0],0,0,0);
    o[d0]=__builtin_amdgcn_mfma_f32_32x32x16_bf16(pa2,PK(2),o[d0],0,0,0);
    o[d0]=__builtin_amdgcn_mfma_f32_32x32x16_bf16(pa3,PK(3),o[d0],0,0,0);
    #undef PK
  }
}

#ifndef ATTN_STORE16
#define ATTN_STORE16(p,v) (*(u32x4*)(p)=(v))
#endif
template<int THRL> __device__ __forceinline__ void attn_unit(int b,int qb,const bf16*Q,const bf16*__restrict__ K,const bf16*__restrict__ V,bf16*O,char*shm){
  int tid_=threadIdx.x; asm volatile("":"+v"(tid_)); const int tid=tid_,lane=tid&63,r32=lane&31,hi=lane>>5; const int wid=__builtin_amdgcn_readfirstlane(tid>>6);
  const long rowbase=(long)b*SEQ; const int q0=qb*QB;
  const bf16*Qw=Q+(rowbase+q0+wid*QBLK)*PQ;
  const bf16*Kh=K+rowbase*PQ,*Vh=V+rowbase*PQ;
  const unsigned lds0=(unsigned)(uintptr_t)shm;
  float*wsf=(float*)(shm+LDS_WS)+wid*64;
  const bf16*ksrc=Kh+(long)lane*PQ+wid*8;
  const bf16*vsrc=Vh+(long)(16*(wid&3)+(lane>>2))*PQ+(wid>>2)*32+(lane&3)*8;
  const unsigned kdst=lds0+LDS_K+wid*1024, vdst=lds0+LDS_V+wid*1024;
  #define DMA_K(t,slot) glds16(ksrc+(long)(t)*KVBLK*PQ,(unsigned)__builtin_amdgcn_readfirstlane(kdst+(slot)))
  #define DMA_V(t,slot) glds16(vsrc+(long)(t)*KVBLK*PQ,(unsigned)__builtin_amdgcn_readfirstlane(vdst+(slot)))
  const int vb0=(int)(lds0+LDS_V)+((lane>>4)&1)*32+(lane&3)*8+(4*hi+((lane&15)>>2))*64;
  const char*Kbase=shm+LDS_K; bf16x8 kf[8];
  const lds_cptr shm3=(lds_cptr)shm; const lds_cptr kp0=shm3+LDS_K+hi*1024+r32*16; const lds_cptr vp0=shm3+LDS_V+((lane>>4)&1)*32+(lane&3)*8+(4*hi+((lane&15)>>2))*64;
  const int NT=(q0+QB)/KVBLK;
  DMA_K(0,0);DMA_V(0,0);DMA_K(1,SLOTB);
  bf16x8 qr[4];
  #pragma unroll
  for(int d0=0;d0<4;++d0)qr[d0]=*reinterpret_cast<const bf16x8*>(&Qw[(long)r32*PQ+d0*16+hi*8]);
  float mhat=0.f,l_reg=0.f;f32x16 o[2];o[0]=f32x16{};o[1]=f32x16{};f32x16 negm=f32x16{};asm volatile("":"+v"(negm));
  const int qrel=wid*QBLK+r32;
  #define CMASK(P0,P1,t) do{int jb_=(t)-(NT-4); if(jb_>=0)cmask(P0,P1,jb_,qrel,hi);}while(0)
  bool resc=false;
  #define START(P0,P1) do{ const float rm=rowmax(P0,P1); resc=false; \
    { const float dl=rm; mhat=fadd_s(mhat,dl); \
      _Pragma("unroll") for(int r=0;r<16;++r){P0[r]=fsub_s(P0[r],dl);P1[r]=fsub_s(P1[r],dl);} \
      _Pragma("unroll") for(int r=0;r<16;++r)negm[r]=-mhat; asm volatile("":"+v"(negm)); } \
    _Pragma("unroll") for(int r=0;r<16;++r)P0[r]=__builtin_amdgcn_exp2f(P0[r]); }while(0)
  #define RESC() do{ if(resc){ asm volatile("s_waitcnt lgkmcnt(0)":::"memory"); \
      _Pragma("unroll") for(int d_=0;d_<2;++d_) _Pragma("unroll") for(int r=0;r<16;++r)o[d_][r]*=wsf[crow(r,hi)]; } }while(0)
  f32x16 pA0,pA1,pB0,pB1;
  int sl_prev=0,sl_cur=0,sl_next=SLOTB;
  #define ROT() do{sl_prev=sl_cur;sl_cur=sl_next;sl_next=(sl_next==(NSLOT-1)*SLOTB)?0:sl_next+SLOTB;}while(0)
  DMA_K(2,2*SLOTB);
  WAIT_BAR(3);
  qkt(pA0,pA1,Kbase,qr,negm,r32,hi);asm volatile("s_nop 15\n\ts_nop 7":"+v"(pA0),"+v"(pA1));CMASK(pA0,pA1,0);
  START(pA0,pA1);
  _Pragma("unroll") for(int r=0;r<16;++r)pA1[r]=__builtin_amdgcn_exp2f(pA1[r]);
  WAIT_BAR(0);
  DMA_K(3,0);DMA_V(1,SLOTB);
  ROT();
  kload8(kf,kp0+sl_cur);
  WAIT_BAR(2);
  s16x4 vlo[8],vhi[8]; u32x4 pw0,pw1,pw2,pw3;
  #define PKW(P,B) cvtpk_s(P[B],P[B+1])
  #define PAF(k) __builtin_bit_cast(bf16x8,pw##k)
  #define VFR(i) (bf16x8){vlo[i][0],vlo[i][1],vlo[i][2],vlo[i][3],vhi[i][0],vhi[i][1],vhi[i][2],vhi[i][3]}
  #define PIN(x) asm volatile("":"+v"(x))
  #define MX3(a,b,c) __builtin_fmaxf(__builtin_fmaxf((a),(b)),(c))
  #define GAPA(MF,A0,A1,A2,A3,W0,W1,PW) do{ MF; sacc+=A0; sacc+=A1; sacc+=A2; sacc+=A3; PIN(sacc); W0; W1; PIN(PW); SBAR(); }while(0)
  #define EX(v) __builtin_amdgcn_exp2f(v)
  #define GAPB(MF,X,B) do{ MF; X[B]=EX(X[B]); X[B+1]=EX(X[B+1]); X[B+2]=EX(X[B+2]); X[B+3]=EX(X[B+3]); PIN(X); SBAR(); }while(0)
  #define VRD(i) do{ vlo[i]=vtr(vp_+(((i)>>2)*4096+((i)&3)*1024)); vhi[i]=vtr(vp_+(((i)>>2)*4096+((i)&3)*1024+512)); }while(0)
  #define KRD(G,j) do{ if(G){ kload2(kf,kp0+sl_next,j); SBAR(); } }while(0)
  #define STEP(C0,C1,P0,P1,t,GK,GV,GL) do{ SBAR(); \
    const lds_cptr vp_=vp0+sl_prev; \
    VRD(0); SBAR(); float sacc=(P0[0]+P0[1]); \
    GAPA(C0=__builtin_amdgcn_mfma_f32_32x32x16_bf16(kf[0],qr[0],negm,0,0,0), P0[2],P0[3],P0[4],P0[5],     pw0[0]=PKW(P0,0), pw0[1]=PKW(P0,2), pw0); \
    VRD(4); SBAR(); GAPA(C1=__builtin_amdgcn_mfma_f32_32x32x16_bf16(kf[1],qr[0],negm,0,0,0), P0[6],P0[7],P0[8],P0[9],     pw0[2]=PKW(P0,4), pw0[3]=PKW(P0,6), pw0); \
    VRD(1); SBAR(); GAPA(C0=__builtin_amdgcn_mfma_f32_32x32x16_bf16(kf[2],qr[1],C0,0,0,0),   P0[10],P0[11],P0[12],P0[13], pw1[0]=PKW(P0,8), pw1[1]=PKW(P0,10), pw1); \
    VRD(5); SBAR(); GAPA(C1=__builtin_amdgcn_mfma_f32_32x32x16_bf16(kf[3],qr[1],C1,0,0,0),   P0[14],P0[15],P1[0],P1[1],   pw1[2]=PKW(P0,12),pw1[3]=PKW(P0,14), pw1); \
    VRD(2); SBAR(); GAPA(C0=__builtin_amdgcn_mfma_f32_32x32x16_bf16(kf[4],qr[2],C0,0,0,0),   P1[2],P1[3],P1[4],P1[5],     pw2[0]=PKW(P1,0), pw2[1]=PKW(P1,2), pw2); \
    VRD(6); SBAR(); GAPA(C1=__builtin_amdgcn_mfma_f32_32x32x16_bf16(kf[5],qr[2],C1,0,0,0),   P1[6],P1[7],P1[8],P1[9],     pw2[2]=PKW(P1,4), pw2[3]=PKW(P1,6), pw2); \
    VRD(3); SBAR(); GAPA(C0=__builtin_amdgcn_mfma_f32_32x32x16_bf16(kf[6],qr[3],C0,0,0,0),   P1[10],P1[11],P1[12],P1[13], pw3[0]=PKW(P1,8), pw3[1]=PKW(P1,10), pw3); \
    VRD(7); SBAR(); GAPA(C1=__builtin_amdgcn_mfma_f32_32x32x16_bf16(kf[7],qr[3],C1,0,0,0),   P1[14],P1[15],0.f,0.f,       pw3[2]=PKW(P1,12),pw3[3]=PKW(P1,14), pw3); \
    l_reg+=sacc; \
    if(GK){DMA_K((t)+3,sl_cur);} if(GV){DMA_V((t)+1,sl_next);} \
    CMASK(C0,C1,t); \
    { float a=MX3(C0[0],C0[1],C1[0]),b=MX3(C0[2],C0[3],C1[1]); a=MX3(a,C1[2],C1[3]); \
      _Pragma("unroll") for(int r=4;r<16;r+=4){a=MX3(a,C0[r],C0[r+1]);b=MX3(b,C0[r+2],C0[r+3]);a=MX3(a,C1[r],C1[r+1]);b=MX3(b,C1[r+2],C1[r+3]);} \
      float rm=__builtin_fmaxf(a,b); { auto rr=__builtin_amdgcn_permlane32_swap(__float_as_uint(rm),__float_as_uint(rm),false,false); rm=__builtin_fmaxf(__uint_as_float(rr[0]),__uint_as_float(rr[1])); } \
      resc=false; \
      if(__builtin_expect(__any(rm>(float)THRL),0)){ const float dl=__builtin_fmaxf(rm,0.f); mhat+=dl; \
        _Pragma("unroll") for(int r=0;r<16;++r){C0[r]-=dl;C1[r]-=dl;} \
        _Pragma("unroll") for(int r=0;r<16;++r)negm[r]=-mhat; asm volatile("":"+v"(negm)); \
        const float f=__builtin_amdgcn_exp2f(-dl); l_reg*=f; if(hi==0)wsf[r32]=f; resc=true; } } \
    SBAR(); \
    GAPB(o[0]=__builtin_amdgcn_mfma_f32_32x32x16_bf16(PAF(0),VFR(0),o[0],0,0,0), C0,0); \
    GAPB(o[1]=__builtin_amdgcn_mfma_f32_32x32x16_bf16(PAF(0),VFR(4),o[1],0,0,0), C0,4); \
    KRD(GL,0); GAPB(o[0]=__builtin_amdgcn_mfma_f32_32x32x16_bf16(PAF(1),VFR(1),o[0],0,0,0), C0,8); \
    KRD(GL,1); GAPB(o[1]=__builtin_amdgcn_mfma_f32_32x32x16_bf16(PAF(1),VFR(5),o[1],0,0,0), C0,12); \
    KRD(GL,2); GAPB(o[0]=__builtin_amdgcn_mfma_f32_32x32x16_bf16(PAF(2),VFR(2),o[0],0,0,0), C1,0); \
    KRD(GL,3); GAPB(o[1]=__builtin_amdgcn_mfma_f32_32x32x16_bf16(PAF(2),VFR(6),o[1],0,0,0), C1,4); \
    GAPB(o[0]=__builtin_amdgcn_mfma_f32_32x32x16_bf16(PAF(3),VFR(3),o[0],0,0,0), C1,8); \
    GAPB(o[1]=__builtin_amdgcn_mfma_f32_32x32x16_bf16(PAF(3),VFR(7),o[1],0,0,0), C1,12); \
    }while(0)
  int t=1;
  #undef CMASK
  #define CMASK(P0,P1,t) do{}while(0)
  for(;t+5<NT;t+=2){
    STEP(pB0,pB1,pA0,pA1,t,true,true,true);     WAIT_BAR(2); RESC(); ROT();
    STEP(pA0,pA1,pB0,pB1,t+1,true,true,true);   WAIT_BAR(2); RESC(); ROT();
  }
  #undef CMASK
  #define CMASK(P0,P1,t) do{int jb_=(t)-(NT-4); if(jb_>=0)cmask(P0,P1,jb_,qrel,hi);}while(0)
  #define ENDW(tt) do{ if((tt)+3<NT){WAIT_BAR(2);} else if((tt)+2<NT){WAIT_BAR(1);} else {WAIT_BAR(0);} }while(0)
  for(;t+1<NT;t+=2){
    STEP(pB0,pB1,pA0,pA1,t,(t+3<NT),(t+1<NT),(t+1<NT));       ENDW(t);   RESC(); ROT();
    STEP(pA0,pA1,pB0,pB1,t+1,(t+4<NT),(t+2<NT),(t+2<NT));     ENDW(t+1); RESC(); ROT();
  }
  STEP(pB0,pB1,pA0,pA1,NT-1,false,false,false); RESC();
  { float sacc=pB0[0]+pB0[1]; _Pragma("unroll") for(int r=2;r<16;++r)sacc+=pB0[r]; _Pragma("unroll") for(int r=0;r<16;++r)sacc+=pB1[r]; l_reg+=sacc;
    pw0=(u32x4){PKW(pB0,0),PKW(pB0,2),PKW(pB0,4),PKW(pB0,6)};pw1=(u32x4){PKW(pB0,8),PKW(pB0,10),PKW(pB0,12),PKW(pB0,14)};pw2=(u32x4){PKW(pB1,0),PKW(pB1,2),PKW(pB1,4),PKW(pB1,6)};pw3=(u32x4){PKW(pB1,8),PKW(pB1,10),PKW(pB1,12),PKW(pB1,14)};
    SBAR(); pv(o,vb0+sl_cur,PAF(0),PAF(1),PAF(2),PAF(3)); }
  #undef PKW
  #undef PAF
  #undef VFR
  #undef PIN
  #undef MX3
  #undef GAPA
  #undef GAPB
  #undef EX
  #undef VRD
  #undef KRD
  #undef STEP
  #undef ENDW
  {auto rr=__builtin_amdgcn_permlane32_swap(__float_as_uint(l_reg),__float_as_uint(l_reg),false,false);l_reg=__uint_as_float(rr[0])+__uint_as_float(rr[1]);}
  if(hi==0)wsf[32+r32]=l_reg;asm volatile("s_waitcnt lgkmcnt(0)":::"memory");
  float rli[16];
  #pragma unroll
  for(int r=0;r<16;++r)rli[r]=__builtin_amdgcn_rcpf(wsf[32+crow(r,hi)]);
  bf16*Ow=O+(rowbase+q0+wid*QBLK)*PO;
  { bf16*stg=(bf16*)(shm+LDS_OST)+wid*2048;
    #pragma unroll
    for(int r=0;r<16;++r){const int orow=crow(r,hi);
      #pragma unroll
      for(int d0=0;d0<2;++d0)stg[orow*64+d0*32+r32]=__float2bfloat16(o[d0][r]*rli[r]);}
    asm volatile("s_waitcnt lgkmcnt(0)":::"memory");
    #pragma unroll
    for(int i=0;i<4;++i){const int row=i*8+(lane>>3),ch=lane&7; const u32x4 v=*(const u32x4*)(stg+row*64+ch*8); ATTN_STORE16(Ow+(long)row*PO+ch*8,v);} }
  asm volatile("s_waitcnt lgkmcnt(0)\n\ts_barrier":::"memory");
  #undef DMA_K
  #undef DMA_V
  #undef CMASK
  #undef START
  #undef RESC
  #undef ROT
}
constexpr int ATTN_LDS_BYTES=LDS_BYTES;
#undef SBAR
#undef WAIT_BAR
}
#define GAS __attribute__((address_space(1)))
#define LAS __attribute__((address_space(3)))
typedef unsigned short bf16;
typedef unsigned v4u __attribute__((ext_vector_type(4)));
typedef unsigned v2u __attribute__((ext_vector_type(2)));
typedef float f32x4 __attribute__((ext_vector_type(4)));
typedef float f32x16 __attribute__((ext_vector_type(16)));
typedef short bf16x8 __attribute__((ext_vector_type(8)));
#define LDS_WAIT() asm volatile("s_waitcnt lgkmcnt(0)" ::: "memory")

constexpr int NWAVES = 8;
constexpr int BATCH = 8, SEQ = 4096, DMODEL = 1024, FF = 4096;
constexpr int M = BATCH * SEQ;
constexpr int EVEN_IN = 3072, ODD_IN = 1280;
constexpr float C2 = 0.125f * 1.4426950408889634f;
constexpr float LOG2E = 1.4426950408889634f;
constexpr float RMS_EPS = 1e-6f, DIFF_EPS = 1e-5f;
constexpr float LAM_INIT0 = 0.2f;

constexpr size_t MiB = 1u << 20;
constexpr int RING_BYTES = 131072;
constexpr int LDS_BYTES = 147456;
constexpr size_t WS_WIN = 2 * MiB, WS_WOUT = 8 * MiB, WS_WQKV = 10 * MiB, WS_WO = 13 * MiB, WS_W1 = 16 * MiB  , WS_W2 = 32 * MiB  ;
constexpr size_t WS_CS = 48 * MiB  , WS_BQKV = 50 * MiB, WS_RS = 51 * MiB  ;
constexpr size_t WS_BAR = 0;
constexpr int MISC_OFF = RING_BYTES + 320;
constexpr size_t WS_XN = 64 * MiB;
constexpr size_t WS_A2 = 448 * MiB;
constexpr size_t WS_H = 128 * MiB;
constexpr size_t WS_PROJ = 192 * MiB;
constexpr size_t WS_ATT = 384 * MiB;
constexpr size_t WS_HF = 192 * MiB;
constexpr size_t WS_END = 512 * MiB;


struct Args {
    const float* x; const int* pos;
    const float *npre_mix, *npost_mix, *npre_mlp, *npost_mlp;
    const float *w_in, *conv_w, *lq1, *lk1, *lq2, *lk2, *subln, *w_out;
    const float *w_qkv, *b_qkv, *sinks, *w_o, *b_o, *w1, *w2;
    float* out; unsigned char* ws;
    float inv_freq[8];
};

__device__ __forceinline__ float wave_sum(float v) {
#pragma unroll
    for (int o = 1; o < 64; o <<= 1) v += __shfl_xor(v, o);
    return v;
}
__device__ __forceinline__ unsigned f2bf(float f) { unsigned u = __builtin_bit_cast(unsigned, f); return (u + 0x7fffu + ((u >> 16) & 1u)) >> 16; }
__device__ __forceinline__ unsigned pk2(float lo, float hi) { return f2bf(lo) | (f2bf(hi) << 16); }
__device__ __forceinline__ float bflo(unsigned w) { return __builtin_bit_cast(float, w << 16); }
__device__ __forceinline__ float bfhi(unsigned w) { return __builtin_bit_cast(float, w & 0xffff0000u); }
__device__ __forceinline__ int mapcol(int n) { const int hl = n & 63; return hl < 16 ? (n & ~63) + (hl >> 1) + 8 * (hl & 1) : n; }

__device__ __forceinline__ void p0_transpose_item(const float* W, int K, int N, bf16* WT, LAS float* scr, int item, int lane, int perm_lo, int perm_hi, const float* g) {
    const int nblk = N / 32, kb = item / nblk, nb = item % nblk, k0 = 64 * kb, n0 = 32 * nb;
    int ncol = n0 + (lane & 31); if (ncol >= perm_lo && ncol < perm_hi) ncol = mapcol(ncol);
    if (perm_lo == 1536 && ncol >= 512 && ncol < 1536) { const int w_ = (ncol - 512) & 255, tt_ = (ncol - 512) >> 8; ncol = (w_ < 128 ? 512 : 1024 - 128) + 128 * tt_ + w_; }
    float wv[32];
#pragma unroll
    for (int i = 0; i < 32; ++i) { const int kk = 2 * i + (lane >> 5); wv[i] = __builtin_nontemporal_load(W + (size_t)(k0 + kk) * N + ncol); }
    if (g) {
#pragma unroll
        for (int i = 0; i < 32; ++i) { const int kk = 2 * i + (lane >> 5); wv[i] *= g[k0 + kk]; } }
#pragma unroll
    for (int i = 0; i < 32; ++i) { const int kk = 2 * i + (lane >> 5); scr[kk * 33 + (lane & 31)] = wv[i]; }
    LDS_WAIT(); asm volatile("" ::: "memory");
    const int c = lane & 7;
#pragma unroll
    for (int j = 0; j < 4; ++j) { const int n = (lane >> 3) + 8 * j; const LAS float* s = scr + (8 * c) * 33 + n;
        v4u o; o.x = pk2(s[0 * 33], s[1 * 33]); o.y = pk2(s[2 * 33], s[3 * 33]); o.z = pk2(s[4 * 33], s[5 * 33]); o.w = pk2(s[6 * 33], s[7 * 33]);
        *(GAS v4u*)(WT + (size_t)(n0 + n) * K + k0 + 8 * c) = o; }
    LDS_WAIT(); asm volatile("" ::: "memory");
}

__device__ __forceinline__ void unpack8(const v4u w, float (&f)[8]) { f[0] = bflo(w.x); f[1] = bfhi(w.x); f[2] = bflo(w.y); f[3] = bfhi(w.y); f[4] = bflo(w.z); f[5] = bfhi(w.z); f[6] = bflo(w.w); f[7] = bfhi(w.w); }
template <int RPI> __device__ __forceinline__ void x_rows_to_bf16(const float* x, bf16* XB, float* rsp, int row0, int lane) {
    f32x4 v[RPI][4];
#pragma unroll
    for (int r = 0; r < RPI; ++r) { const GAS f32x4* xr = (const GAS f32x4*)(x + (size_t)(row0 + r) * DMODEL) + lane;
#pragma unroll
        for (int j = 0; j < 4; ++j) v[r][j] = __builtin_nontemporal_load(xr + 64 * j); }
    float s[RPI];
#pragma unroll
    for (int r = 0; r < RPI; ++r) { s[r] = 0.f; GAS unsigned long long* o8 = (GAS unsigned long long*)(XB + (size_t)(row0 + r) * DMODEL) + lane;
#pragma unroll
        for (int j = 0; j < 4; ++j) { s[r] += (v[r][j].x * v[r][j].x + v[r][j].y * v[r][j].y) + (v[r][j].z * v[r][j].z + v[r][j].w * v[r][j].w);
            o8[64 * j] = (unsigned long long)pk2(v[r][j].x, v[r][j].y) | ((unsigned long long)pk2(v[r][j].z, v[r][j].w) << 32); } }
#pragma unroll
    for (int o = 1; o < 64; o <<= 1)
#pragma unroll
        for (int r = 0; r < RPI; ++r) s[r] += __shfl_xor(s[r], o);
#pragma unroll
    for (int r = 0; r < RPI; ++r) if (lane == r) rsp[row0 + r] = 1.f / sqrtf(s[r] * (1.f / DMODEL) + RMS_EPS);
}

template <int RPI> __device__ __forceinline__ void nr_pass(int gw, int NGW, int lane_, const bf16* H, bf16* XB, const float* wpost, float* rsout, float* outf) {
    int lane = lane_; asm volatile("" : "+v"(lane));
    f32x4 wp[2][2];
#pragma unroll
    for (int j = 0; j < 2; ++j)
#pragma unroll
        for (int e = 0; e < 2; ++e) wp[j][e] = *(const f32x4*)(wpost + 8 * lane + 512 * j + 4 * e);
    for (int row0 = gw * RPI; row0 < M; row0 += NGW * RPI) {
        v4u hw[RPI][2], xw[RPI][2];
#pragma unroll
        for (int r = 0; r < RPI; ++r)
#pragma unroll
            for (int j = 0; j < 2; ++j) { hw[r][j] = __builtin_nontemporal_load((const GAS v4u*)(H + (size_t)(row0 + r) * DMODEL + 8 * lane + 512 * j)); xw[r][j] = *(const GAS v4u*)(XB + (size_t)(row0 + r) * DMODEL + 8 * lane + 512 * j); }
        float ss[RPI];
#pragma unroll
        for (int r = 0; r < RPI; ++r) { ss[r] = 0.f;
#pragma unroll
            for (int j = 0; j < 2; ++j) { float f[8]; unpack8(hw[r][j], f);
#pragma unroll
                for (int e = 0; e < 8; ++e) ss[r] += f[e] * f[e]; } }
#pragma unroll
        for (int o = 1; o < 64; o <<= 1)
#pragma unroll
            for (int r = 0; r < RPI; ++r) ss[r] += __shfl_xor(ss[r], o);
        float s2[RPI];
#pragma unroll
        for (int r = 0; r < RPI; ++r) { const float rs = 1.f / sqrtf(ss[r] * (1.f / DMODEL) + RMS_EPS); s2[r] = 0.f;
#pragma unroll
            for (int j = 0; j < 2; ++j) { float f[8], x[8]; unpack8(hw[r][j], f); unpack8(xw[r][j], x);
                f32x4 x0 = (f32x4){x[0], x[1], x[2], x[3]} + (f32x4){f[0], f[1], f[2], f[3]} * rs * wp[j][0], x1 = (f32x4){x[4], x[5], x[6], x[7]} + (f32x4){f[4], f[5], f[6], f[7]} * rs * wp[j][1];
                s2[r] += ((x0.x * x0.x + x0.y * x0.y) + (x0.z * x0.z + x0.w * x0.w)) + ((x1.x * x1.x + x1.y * x1.y) + (x1.z * x1.z + x1.w * x1.w));
                if (outf) { *(GAS f32x4*)(outf + (size_t)(row0 + r) * DMODEL + 8 * lane + 512 * j) = x0; *(GAS f32x4*)(outf + (size_t)(row0 + r) * DMODEL + 8 * lane + 512 * j + 4) = x1; }
                else { v4u o; o.x = pk2(x0.x, x0.y); o.y = pk2(x0.z, x0.w); o.z = pk2(x1.x, x1.y); o.w = pk2(x1.z, x1.w); *(GAS v4u*)(XB + (size_t)(row0 + r) * DMODEL + 8 * lane + 512 * j) = o; } } }
        if (rsout) {
#pragma unroll
            for (int o = 1; o < 64; o <<= 1)
#pragma unroll
                for (int r = 0; r < RPI; ++r) s2[r] += __shfl_xor(s2[r], o);
#pragma unroll
            for (int r = 0; r < RPI; ++r) if (lane == r) rsout[row0 + r] = 1.f / sqrtf(s2[r] * (1.f / DMODEL) + RMS_EPS);
        }
    }
}


__device__ __forceinline__ void mix_pass(int gw, int NGW, int lane_, const bf16* PROJ, const bf16* ATT, bf16* A2, const float* conv_w, const float* subln, float lam) {
    int lane = lane_; asm volatile("" : "+v"(lane));
    float cw[3][8], sw[8];
#pragma unroll
    for (int i = 0; i < 3; ++i)
#pragma unroll
        for (int e = 0; e < 8; ++e) cw[i][e] = conv_w[i * 512 + 8 * lane + e];
#pragma unroll
    for (int e = 0; e < 8; ++e) sw[e] = subln[(lane & 15) * 8 + e] * (1.0f - LAM_INIT0);
    for (int row0 = gw * 2; row0 < M; row0 += NGW * 2) {
        const int t0 = row0 & (SEQ - 1);
        const bf16* pr = PROJ + (size_t)row0 * EVEN_IN + 8 * lane;
        const bf16* ar = ATT + (size_t)row0 * DMODEL + (lane >> 4) * 256 + (lane & 15) * 8;
        v4u gbw[2], uw[4], o0w[2], o1w[2];
#pragma unroll
        for (int r = 0; r < 2; ++r) { gbw[r] = *(const GAS v4u*)(pr + r * EVEN_IN); o0w[r] = *(const GAS v4u*)(ar + r * DMODEL); o1w[r] = *(const GAS v4u*)(ar + r * DMODEL + 128); }
#pragma unroll
        for (int r = 0; r < 4; ++r) { if (r >= 2 || t0 > 0) uw[r] = *(const GAS v4u*)(pr + (r - 2) * EVEN_IN + 512);
            else uw[r] = (v4u){0u, 0u, 0u, 0u}; }
        float u[4][8];
#pragma unroll
        for (int r = 0; r < 4; ++r) unpack8(uw[r], u[r]);
#pragma unroll
        for (int r = 0; r < 2; ++r) { float gb[8], co[8]; unpack8(gbw[r], gb);
#pragma unroll
            for (int e = 0; e < 8; ++e) co[e] = gb[e] * (cw[0][e] * u[r][e] + cw[1][e] * u[r + 1][e] + cw[2][e] * u[r + 2][e]);
            v4u o; o.x = pk2(co[0], co[1]); o.y = pk2(co[2], co[3]); o.z = pk2(co[4], co[5]); o.w = pk2(co[6], co[7]);
            *(GAS v4u*)(A2 + (size_t)(row0 + r) * DMODEL + 8 * lane) = o; }
#pragma unroll
        for (int r = 0; r < 2; ++r) { float o0[8], o1[8], d[8]; unpack8(o0w[r], o0); unpack8(o1w[r], o1);
            float ss = 0.f;
#pragma unroll
            for (int e = 0; e < 8; ++e) { d[e] = o0[e] - lam * o1[e]; ss += d[e] * d[e]; }
            ss += __shfl_xor(ss, 1); ss += __shfl_xor(ss, 2); ss += __shfl_xor(ss, 4); ss += __shfl_xor(ss, 8);
            const float rs = 1.f / sqrtf(ss * (1.f / 128.f) + DIFF_EPS);
#pragma unroll
            for (int e = 0; e < 8; ++e) d[e] = d[e] * rs * sw[e];
            v4u o; o.x = pk2(d[0], d[1]); o.y = pk2(d[2], d[3]); o.z = pk2(d[4], d[5]); o.w = pk2(d[6], d[7]);
            *(GAS v4u*)(A2 + (size_t)(row0 + r) * DMODEL + 512 + 8 * lane) = o; }
    }
}

__device__ __forceinline__ int crow16(int r, int hi) { return (r & 3) + 8 * (r >> 2) + 4 * hi; }
__device__ __forceinline__ unsigned cvtpk(float lo, float hi) { typedef float f2 __attribute__((ext_vector_type(2))); typedef __bf16 b2 __attribute__((ext_vector_type(2))); f2 v = {lo, hi}; b2 b = __builtin_convertvector(v, b2); return __builtin_bit_cast(unsigned, b); }

constexpr int VTP = 264;
__device__ __forceinline__ void swa_phase(int vcu, int G, LAS unsigned char* lds, const bf16* QKV, const float* sinks, bf16* ATT) {
    int tid_ = threadIdx.x; asm volatile("" : "+v"(tid_)); const int tid = tid_, lane = tid & 63, q = lane & 31, hi = lane >> 5; const int wid = __builtin_amdgcn_readfirstlane(tid >> 6);
    LAS unsigned char* Kl = lds; LAS bf16* Vt = (LAS bf16*)(lds + 32768);
    for (int unit = vcu; unit < BATCH * 32 * 2; unit += G) {
        const int b = unit >> 6, blk = (unit & 63) >> 1, kvh = unit & 1;
        __syncthreads();
        v4u kvr[4], vvr[4];
#pragma unroll
        for (int i = 0; i < 4; ++i) { const int idx = tid + 512 * i, row = idx >> 3, ch = idx & 7; const int t = blk * 128 - 128 + row;
            kvr[i] = (v4u){0u, 0u, 0u, 0u}; if (t >= 0) kvr[i] = *(const GAS v4u*)(QKV + (size_t)(b * SEQ + t) * ODD_IN + 1024 + kvh * 64 + ch * 8);
            const int row2 = idx & 255, ch2 = idx >> 8; const int t2 = blk * 128 - 128 + row2;
            vvr[i] = (v4u){0u, 0u, 0u, 0u}; if (t2 >= 0) vvr[i] = *(const GAS v4u*)(QKV + (size_t)(b * SEQ + t2) * ODD_IN + 1152 + kvh * 64 + ch2 * 8); }
#pragma unroll
        for (int i = 0; i < 4; ++i) { const int idx = tid + 512 * i, row = idx >> 3, ch = idx & 7; const v4u kv = kvr[i], vv = vvr[i];
            *(LAS v4u*)(Kl + ch * 4096 + row * 16) = kv;
            const int kvi = idx & 255, kc = kvi & 15, kpos = (kvi & ~15) + ((kc & 3) | ((kc & 4) << 1) | ((kc & 8) >> 1));
            LAS bf16* vp = Vt + ((idx >> 8) * 8) * VTP + kpos;
            vp[0 * VTP] = (bf16)(vv.x & 0xffffu); vp[1 * VTP] = (bf16)(vv.x >> 16); vp[2 * VTP] = (bf16)(vv.y & 0xffffu); vp[3 * VTP] = (bf16)(vv.y >> 16);
            vp[4 * VTP] = (bf16)(vv.z & 0xffffu); vp[5 * VTP] = (bf16)(vv.z >> 16); vp[6 * VTP] = (bf16)(vv.w & 0xffffu); vp[7 * VTP] = (bf16)(vv.w >> 16); }
        __syncthreads();
        const int head = kvh * 8 + wid; const float sink2 = sinks[head] * LOG2E;
        bf16x8 qn[4];
        { const size_t tok0 = (size_t)b * SEQ + blk * 128 + q;
#pragma unroll
            for (int ks = 0; ks < 4; ++ks) qn[ks] = *(const GAS bf16x8*)(QKV + tok0 * ODD_IN + head * 64 + 16 * ks + 8 * hi); }
        for (int ci = 0; ci < 4; ++ci) {
            const int r0 = 32 * ci; const size_t tok = (size_t)b * SEQ + blk * 128 + r0 + q;
            bf16x8 qf[4];
#pragma unroll
            for (int ks = 0; ks < 4; ++ks) qf[ks] = qn[ks];
            if (ci < 3) {
#pragma unroll
                for (int ks = 0; ks < 4; ++ks) qn[ks] = *(const GAS bf16x8*)(QKV + (tok + 32) * ODD_IN + head * 64 + 16 * ks + 8 * hi); }
            f32x16 p[5];
#pragma unroll
            for (int jt = 0; jt < 5; ++jt) p[jt] = (f32x16){};
#pragma unroll
            for (int ks = 0; ks < 4; ++ks)
#pragma unroll
                for (int jt = 0; jt < 5; ++jt) { const bf16x8 kf = *(const LAS bf16x8*)(Kl + (2 * ks + hi) * 4096 + (r0 + 32 * jt + q) * 16); p[jt] = __builtin_amdgcn_mfma_f32_32x32x16_bf16(kf, qf[ks], p[jt], 0, 0, 0); }
            float mx = -INFINITY;
            if (blk == 0) {
#pragma unroll
                for (int jt = 0; jt < 5; ++jt)
#pragma unroll
                    for (int r = 0; r < 16; ++r) { const int j = r0 + 32 * jt + crow16(r, hi); const bool valid = (j >= r0 + q + 1) && (j <= r0 + q + 128) && (j >= 128);
                        p[jt][r] = valid ? p[jt][r] : -INFINITY; }
            } else {
#pragma unroll
                for (int r = 0; r < 16; ++r) { const int c = crow16(r, hi); p[0][r] = (c > q) ? p[0][r] : -INFINITY; p[4][r] = (c <= q) ? p[4][r] : -INFINITY; }
            }
#pragma unroll
            for (int jt = 0; jt < 5; ++jt)
#pragma unroll
                for (int r = 0; r < 16; ++r) mx = fmaxf(mx, p[jt][r]);
            mx = fmaxf(mx, __shfl_xor(mx, 32)); mx = fmaxf(mx, sink2);
            float l = 0.f;
#pragma unroll
            for (int jt = 0; jt < 5; ++jt)
#pragma unroll
                for (int r = 0; r < 16; ++r) { p[jt][r] = __builtin_amdgcn_exp2f(p[jt][r] - mx); l += p[jt][r]; }
            l += __shfl_xor(l, 32); l += __builtin_amdgcn_exp2f(sink2 - mx);
            f32x16 o[2]; o[0] = (f32x16){}; o[1] = (f32x16){};
#pragma unroll
            for (int jt = 0; jt < 5; ++jt)
#pragma unroll
                for (int kb = 0; kb < 2; ++kb) { v4u pw; pw.x = cvtpk(p[jt][8 * kb + 0], p[jt][8 * kb + 1]); pw.y = cvtpk(p[jt][8 * kb + 2], p[jt][8 * kb + 3]); pw.z = cvtpk(p[jt][8 * kb + 4], p[jt][8 * kb + 5]); pw.w = cvtpk(p[jt][8 * kb + 6], p[jt][8 * kb + 7]);
                    const bf16x8 pf = __builtin_bit_cast(bf16x8, pw);
#pragma unroll
                    for (int dt = 0; dt < 2; ++dt) { const bf16x8 vf = *(const LAS bf16x8*)(Vt + (32 * dt + q) * VTP + r0 + 32 * jt + 16 * kb + 8 * hi);
                        o[dt] = __builtin_amdgcn_mfma_f32_32x32x16_bf16(vf, pf, o[dt], 0, 0, 0); } }
            const float il = 1.f / l;
            bf16* op = ATT + tok * DMODEL + head * 64 + 8 * hi;
#pragma unroll
            for (int dt = 0; dt < 2; ++dt)
#pragma unroll
                for (int rp = 0; rp < 2; ++rp) {
                    v2u y, x; y.x = cvtpk(o[dt][8 * rp] * il, o[dt][8 * rp + 1] * il); y.y = cvtpk(o[dt][8 * rp + 2] * il, o[dt][8 * rp + 3] * il);
                    x.x = cvtpk(o[dt][8 * rp + 4] * il, o[dt][8 * rp + 5] * il); x.y = cvtpk(o[dt][8 * rp + 6] * il, o[dt][8 * rp + 7] * il);
                    const v2u snd = hi ? y : x;
                    v2u rcv; rcv.x = __shfl_xor(snd.x, 32); rcv.y = __shfl_xor(snd.y, 32);
                    v4u w; if (hi) { w.x = rcv.x; w.y = rcv.y; w.z = x.x; w.w = x.y; } else { w.x = y.x; w.y = y.y; w.z = rcv.x; w.w = rcv.y; }
                    *(GAS v4u*)(op + 32 * dt + 16 * rp) = w; }
        }
    }
}
#define RLX_AGENT __ATOMIC_RELAXED, __HIP_MEMORY_SCOPE_AGENT
#define XB_TMO      128
#define XB_XCNT(j)  (256  + 64 * (j))
#define XB_XSUB(j)  (1280 + 64 * (j))
#define XB_XGEN(j)  (2304 + 64 * (j))
#define XB_TOP      3328
#define XB_TOPGEN   3392
#define XCD_BAR_WORDS 3456
#define XB_SPIN_CAP (1u << 18)

__device__ __forceinline__ unsigned xb_ld(unsigned* p)              { return __hip_atomic_load(p, __ATOMIC_RELAXED, __HIP_MEMORY_SCOPE_AGENT); }
__device__ __forceinline__ unsigned xb_add(unsigned* p, unsigned v) { return __hip_atomic_fetch_add(p, v, __ATOMIC_RELAXED, __HIP_MEMORY_SCOPE_AGENT); }
__device__ __forceinline__ unsigned xb_xcc_id() { return (unsigned)__builtin_amdgcn_s_getreg((3 << 11) | 20) & 0xFu; }
#define XB_SPIN(cond, bar) do { unsigned _sp = 0; while (cond) { __builtin_amdgcn_s_sleep(1); \
    if ((++_sp & 255u) == 0u) { if (xb_ld(&(bar)[XB_TMO])) break; if (_sp > XB_SPIN_CAP) { atomicAdd(&(bar)[XB_TMO], 1u); break; } } } } while (0)

struct XcdBarrier {
    unsigned* bar; unsigned x;
    volatile LAS unsigned* st;
};

__device__ __forceinline__ XcdBarrier xcd_barrier_post(unsigned* bar, volatile LAS unsigned* st) {
    XcdBarrier b; b.bar = bar; b.x = xb_xcc_id(); b.st = st;
    if (threadIdx.x == 0) (void)xb_add(&bar[XB_XCNT(b.x)], 1u);
    return b;
}
__device__ __forceinline__ void xcd_barrier_complete(unsigned* bar, unsigned x, unsigned& nloc, unsigned& nx) {
    const unsigned G = gridDim.x * gridDim.y * gridDim.z;
    unsigned sum, cnt, mine, sp = 0u;
    for (;;) {
        sum = 0u; cnt = 0u; mine = 0u;
#pragma unroll
        for (unsigned j = 0; j < 16; ++j) { const unsigned c = xb_ld(&bar[XB_XCNT(j)]); sum += c; cnt += (c > 0u) ? 1u : 0u; mine = (j == x) ? c : mine; }
        if (sum == G) break;
        __builtin_amdgcn_s_sleep(1);
        if ((++sp & 255u) == 0u) { if (xb_ld(&bar[XB_TMO])) break; if (sp > XB_SPIN_CAP) { atomicAdd(&bar[XB_TMO], 1u); break; } }
    }
    nloc = mine > 0u ? mine : 1u; nx = cnt > 0u ? cnt : 1u;
}

__device__ __forceinline__ void xcd_barrier(const XcdBarrier& b) {
    asm volatile("s_waitcnt vmcnt(0)" ::: "memory");
    __syncthreads();
    if (threadIdx.x == 0) {
        unsigned* bar = b.bar;
        __builtin_amdgcn_s_waitcnt(0);
        unsigned nloc = b.st[0], nx = b.st[1];
        if (nloc == 0u) { xcd_barrier_complete(bar, b.x, nloc, nx); b.st[0] = nloc; b.st[1] = nx; }
        const unsigned old = xb_add(&bar[XB_XSUB(b.x)], 1u);
        const unsigned gen = old / nloc;
        if (old + 1u == (gen + 1u) * nloc) {
            __builtin_amdgcn_fence(__ATOMIC_RELEASE, "agent");
            asm volatile("s_waitcnt vmcnt(0)" ::: "memory");
            const unsigned og = xb_add(&bar[XB_TOP], 1u);
            const unsigned tg = og / nx;
            if (og + 1u == (tg + 1u) * nx) xb_add(&bar[XB_TOPGEN], 1u);
            else XB_SPIN(xb_ld(&bar[XB_TOPGEN]) == tg, bar);
            __builtin_amdgcn_fence(__ATOMIC_ACQUIRE, "agent");
            xb_add(&bar[XB_XGEN(b.x)], 1u);
            asm volatile("s_waitcnt vmcnt(0)" ::: "memory");
        } else {
            XB_SPIN(xb_ld(&bar[XB_XGEN(b.x)]) == gen, bar);
            __builtin_amdgcn_fence(__ATOMIC_ACQUIRE, "agent");
            asm volatile("s_waitcnt vmcnt(0)" ::: "memory");
        }
    }
    __syncthreads();
}
__global__ void __launch_bounds__(NWAVES * 64, 2) fwd_kernel(Args a) {
    extern __shared__ __attribute__((aligned(16))) unsigned char lds_raw[];
    cg::grid_group grid = cg::this_grid();
    LAS unsigned char* lds = (LAS unsigned char*)lds_raw;
    const int tid = threadIdx.x, lane = tid & 63, wave = __builtin_amdgcn_readfirstlane(tid >> 6);
    const int G = gridDim.x, bx = blockIdx.x, vcu = (G % 8 == 0) ? (bx % 8) * (G / 8) + bx / 8 : bx;
    const int gw = vcu * NWAVES + wave, NGW = G * NWAVES;
    unsigned char* ws = a.ws;
    bf16* Win_t = (bf16*)(ws + WS_WIN); bf16* Wout_t = (bf16*)(ws + WS_WOUT); bf16* Wqkv_t = (bf16*)(ws + WS_WQKV); bf16* Wo_t = (bf16*)(ws + WS_WO);
    bf16* W1_t = (bf16*)(ws + WS_W1); bf16* W2_t = (bf16*)(ws + WS_W2);
    float* cs = (float*)(ws + WS_CS); float* bqkv_p = (float*)(ws + WS_BQKV);
    bf16* XB = (bf16*)(ws + WS_XN); bf16* A2 = (bf16*)(ws + WS_A2); bf16* H = (bf16*)(ws + WS_H); float* RS = (float*)(ws + WS_RS); bf16* PROJ = (bf16*)(ws + WS_PROJ); bf16* ATT = (bf16*)(ws + WS_ATT); bf16* HF = (bf16*)(ws + WS_HF);

    unsigned* barw = (unsigned*)(ws + WS_BAR);
    volatile LAS unsigned* MISC = (volatile LAS unsigned*)(lds + MISC_OFF);
    if (tid < 32) MISC[tid] = 0u;
    if (bx == 0) for (int i = tid; i < XCD_BAR_WORDS; i += NWAVES * 64) barw[i] = 0u;
    {
        LAS float* scr = (LAS float*)(lds + wave * 16384);
        constexpr int I_IN = 16 * 96, I_SQ = 16 * 32, I_QKV = 16 * 40, I_W1 = 16 * 128, I_W2 = 64 * 32;
        constexpr int NITEMS = I_IN + I_SQ + I_QKV + I_SQ + 2 * I_W1 + 2 * I_W2;
        for (int it = gw; it < NITEMS; it += NGW) {
            int r = it;
            if (r < I_IN) { p0_transpose_item(a.w_in, 1024, EVEN_IN, Win_t, scr, r, lane, 1536, 2560, a.npre_mix); continue; } r -= I_IN;
            if (r < I_SQ) { p0_transpose_item(a.w_out, 1024, 1024, Wout_t, scr, r, lane, 0, 0, nullptr); continue; } r -= I_SQ;
            if (r < I_QKV) { p0_transpose_item(a.w_qkv, 1024, ODD_IN, Wqkv_t, scr, r, lane, 0, 1152, a.npre_mix + 1024); continue; } r -= I_QKV;
            if (r < I_SQ) { p0_transpose_item(a.w_o, 1024, 1024, Wo_t, scr, r, lane, 0, 0, nullptr); continue; } r -= I_SQ;
            if (r < I_W1) { p0_transpose_item(a.w1, 1024, FF, W1_t, scr, r, lane, 0, 0, a.npre_mlp); continue; } r -= I_W1;
            if (r < I_W1) { p0_transpose_item(a.w1 + (size_t)1024 * FF, 1024, FF, W1_t + (size_t)1024 * FF, scr, r, lane, 0, 0, a.npre_mlp + 1024); continue; } r -= I_W1;
            if (r < I_W2) { p0_transpose_item(a.w2, FF, 1024, W2_t, scr, r, lane, 0, 0, nullptr); continue; } r -= I_W2;
            p0_transpose_item(a.w2 + (size_t)1024 * FF, FF, 1024, W2_t + (size_t)1024 * FF, scr, r, lane, 0, 0, nullptr);
        }
        const int gtid = vcu * (NWAVES * 64) + tid, nthr = G * NWAVES * 64;
        for (int i = gtid; i < ODD_IN; i += nthr) bqkv_p[i] = a.b_qkv[i < 1152 ? mapcol(i) : i];
        for (int row = gtid; row < M; row += nthr) { const float pf = (float)a.pos[row];
#pragma unroll
            for (int i = 0; i < 8; ++i) { const float ang = pf * a.inv_freq[i]; const double t = (double)ang * 0.15915494309189535; const float fr = (float)(t - floor(t));
                cs[(size_t)row * 16 + 2 * i] = __builtin_amdgcn_cosf(fr); cs[(size_t)row * 16 + 2 * i + 1] = __builtin_amdgcn_sinf(fr); } }
        for (int m = gw * 4; m < M; m += NGW * 4) x_rows_to_bf16<4>(a.x, XB, RS, m, lane);
    }
    grid.sync();
    const XcdBarrier bar = xcd_barrier_post(barw, MISC + 8);
#define GRID_BAR() xcd_barrier(bar)

    {
        pg8::Gemm g{XB, Win_t, M, EVEN_IN, 1024};
        {   pg8::SubsetOrder S; S.so.init(M, 8 * 256, G, bx); S.keep = 2; S.skip = 4;
            pg8::EpiX<2> E{PROJ, EVEN_IN, nullptr, cs, 1536, 2048, 2048, 2560, C2, RS, 0};
            pg8::gemm_phase<pg8::EpiX<2>, pg8::SubsetOrder, true, true>(lds, g, S, E); }
        {   pg8::SubsetOrder S; S.so.init(M, 4 * 256, G, bx); S.keep = 0; S.skip = 2;
            pg8::EpiU E{PROJ, EVEN_IN, RS};
            pg8::gemm_phase<pg8::EpiU, pg8::SubsetOrder, true, true>(lds, g, S, E); }
    }
    GRID_BAR();
    {
        for (int p = vcu; p < BATCH * 16 * 8; p += G) {
            const int bvh = p >> 3, s = p & 7, b = bvh >> 4, vh = bvh & 15, h = vh >> 2, c = (vh >> 1) & 1, half = vh & 1;
            const attn_body::bf16* Q = (const attn_body::bf16*)PROJ + 1536 + (h * 2 + c) * 64;
            const attn_body::bf16* K = (const attn_body::bf16*)PROJ + 2048 + (h * 2 + c) * 64;
            const attn_body::bf16* V = (const attn_body::bf16*)PROJ + 2560 + h * 128 + half * 64;
            attn_body::bf16* O = (attn_body::bf16*)ATT + vh * 64;
            attn_body::attn_unit<8>(b, 15 - s, Q, K, V, O, (char*)lds_raw);
            attn_body::attn_unit<8>(b, s, Q, K, V, O, (char*)lds_raw);
        }
    }
    GRID_BAR();
    {
        const float s1 = wave_sum(a.lq1[lane] * a.lk1[lane]), s2 = wave_sum(a.lq2[lane] * a.lk2[lane]);
        const float lam = expf(s1) - expf(s2) + LAM_INIT0;
        mix_pass(gw, NGW, lane, PROJ, ATT, A2, a.conv_w, a.subln, lam);
    }
    GRID_BAR();
    {
        pg8::Gemm g{A2, Wout_t, M, 1024, 1024}; pg8::StaticOrder S; S.init(M, 1024, G, bx);
        pg8::EpiX<0> E{H, 1024, nullptr, nullptr, 0, 0, 0, 0, 1.f, nullptr, 0};
        pg8::gemm_phase<pg8::EpiX<0>, pg8::StaticOrder, true, true>(lds, g, S, E);
    }
    GRID_BAR();
    nr_pass<4>(gw, NGW, lane, H, XB, a.npost_mix, RS, nullptr);
    GRID_BAR();
#define MLP_PHASES(l) \
    {     \
        pg8::Gemm g{XB, W1_t + (size_t)(l) * 1024 * FF, M, FF, 1024}; pg8::StaticOrder S; S.init(M, FF, G, bx); \
        pg8::EpiX<1> E{HF, FF, nullptr, nullptr, 0, 0, 0, 0, 1.f, RS, 16}; \
        pg8::gemm_phase<pg8::EpiX<1>, pg8::StaticOrder, true, true>(lds, g, S, E); \
    } \
    GRID_BAR(); \
    {     \
        pg8::Gemm g{HF, W2_t + (size_t)(l) * 1024 * FF, M, 1024, FF}; pg8::RevOrder S; S.so.init(M, 1024, G, bx); S.nrounds = (S.so.nwg + G - 1) / G; \
        pg8::EpiX<0> E{H, 1024, nullptr, nullptr, 0, 0, 0, 0, 1.f, nullptr, 0}; \
        pg8::gemm_phase<pg8::EpiX<0>, pg8::RevOrder, true, true, true>(lds, g, S, E); \
    } \
    GRID_BAR();
    MLP_PHASES(0)
    nr_pass<4>(gw, NGW, lane, H, XB, a.npost_mlp, RS, nullptr);
    GRID_BAR();
    {
        pg8::Gemm g{XB, Wqkv_t, M, ODD_IN, 1024}; pg8::StaticOrder S; S.init(M, ODD_IN, G, bx);
        pg8::EpiX<2> E{PROJ, ODD_IN, bqkv_p, cs, 0, 1024, 1024, 1152, C2, RS, 0};
        pg8::gemm_phase<pg8::EpiX<2>, pg8::StaticOrder, true, true>(lds, g, S, E);
    }
    GRID_BAR();
    swa_phase(vcu, G, lds, PROJ, a.sinks, ATT);
    GRID_BAR();
    {
        pg8::Gemm g{ATT, Wo_t, M, 1024, 1024}; pg8::StaticOrder S; S.init(M, 1024, G, bx);
        pg8::EpiX<0> E{H, 1024, a.b_o, nullptr, 0, 0, 0, 0, 1.f, nullptr, 0};
        pg8::gemm_phase<pg8::EpiX<0>, pg8::StaticOrder, true, true>(lds, g, S, E);
    }
    GRID_BAR();
    nr_pass<4>(gw, NGW, lane, H, XB, a.npost_mix + 1024, RS, nullptr);
    GRID_BAR();
    MLP_PHASES(1)
    nr_pass<4>(gw, NGW, lane, H, XB, a.npost_mlp + 1024, nullptr, a.out);
#undef MLP_PHASES
}

extern "C" void kernel_launch(void* const* d_in, const int* in_sizes, int n_in, void* d_out, int out_size, void* d_ws, size_t ws_size, hipStream_t stream) {
    static int grid_blocks = 0;
    if (grid_blocks == 0) {
        if (n_in != 21 || in_sizes[0] != M * DMODEL || out_size != M * DMODEL || ws_size < WS_END) { fprintf(stderr, "kernel_launch: unexpected problem shape / workspace (n_in %d, ws %zu)\n", n_in, ws_size); grid_blocks = -1; return; }
        int dev = 0, cus = 0, per_cu = 0;
        if (hipGetDevice(&dev) != hipSuccess || hipDeviceGetAttribute(&cus, hipDeviceAttributeMultiprocessorCount, dev) != hipSuccess) { grid_blocks = -1; return; }
        if (hipFuncSetAttribute((const void*)fwd_kernel, hipFuncAttributeMaxDynamicSharedMemorySize, LDS_BYTES) != hipSuccess) { fprintf(stderr, "kernel_launch: hipFuncSetAttribute failed\n"); grid_blocks = -1; return; }
        if (hipOccupancyMaxActiveBlocksPerMultiprocessor(&per_cu, (const void*)fwd_kernel, NWAVES * 64, LDS_BYTES) != hipSuccess || per_cu < 1) { fprintf(stderr, "kernel_launch: occupancy query says %d blocks per CU\n", per_cu); grid_blocks = -1; (void)hipGetLastError(); return; }
        grid_blocks = cus;
    }
    if (grid_blocks < 0) return;
    Args a{};
    a.x = (const float*)d_in[0]; a.pos = (const int*)d_in[1];
    a.npre_mix = (const float*)d_in[2]; a.npost_mix = (const float*)d_in[3]; a.npre_mlp = (const float*)d_in[4]; a.npost_mlp = (const float*)d_in[5];
    a.w_in = (const float*)d_in[6]; a.conv_w = (const float*)d_in[7]; a.lq1 = (const float*)d_in[8]; a.lk1 = (const float*)d_in[9]; a.lq2 = (const float*)d_in[10]; a.lk2 = (const float*)d_in[11];
    a.subln = (const float*)d_in[12]; a.w_out = (const float*)d_in[13]; a.w_qkv = (const float*)d_in[14]; a.b_qkv = (const float*)d_in[15]; a.sinks = (const float*)d_in[16];
    a.w_o = (const float*)d_in[17]; a.b_o = (const float*)d_in[18]; a.w1 = (const float*)d_in[19]; a.w2 = (const float*)d_in[20];
    a.out = (float*)d_out; a.ws = (unsigned char*)d_ws;
    for (int i = 0; i < 8; ++i) a.inv_freq[i] = (float)pow(500000.0, -(double)i / 8.0);
    void* args[] = {&a};
    hipError_t e = hipLaunchCooperativeKernel((const void*)fwd_kernel, dim3(grid_blocks), dim3(NWAVES * 64), args, LDS_BYTES, stream);
    if (e != hipSuccess) fprintf(stderr, "kernel_launch: cooperative launch failed: %s (grid %d)\n", hipGetErrorString(e), grid_blocks);
}
```

```cpp
#include <hip/hip_runtime.h>
#include <hip/hip_cooperative_groups.h>
#include <cstdio>
#include <cstdint>
#include <cmath>
namespace cg = cooperative_groups;
namespace pg8 {
#define PG8_LAS __attribute__((address_space(3)))
typedef unsigned short bf16_t;
typedef short bf16x8 __attribute__((ext_vector_type(8)));
typedef float f32x4 __attribute__((ext_vector_type(4)));
typedef unsigned u32x4 __attribute__((ext_vector_type(4)));
constexpr int BM = 256, BK = 64, HALF = 128, HTB = HALF * BK * 2  , STAGE_BYTES = 8 * HTB, NXCD = 8, WGM = 8;

__host__ __device__ __forceinline__ int lds_byte(int r, int c) { const int st = (r >> 4) * 2 + (c >> 5), rr = r & 15, cc = c & 31, ob = rr * 64 + cc * 2; return st * 1024 + (ob ^ (((ob >> 9) & 1) << 5)); }
__host__ __device__ __forceinline__ void stage_rc(int b, int& R, int& C) { const int st = b / 1024, sb = b % 1024, swz = sb ^ (((sb >> 9) & 1) << 5); R = (st >> 1) * 16 + swz / 64; C = (st & 1) * 32 + (swz % 64) / 2; }
__host__ __device__ __forceinline__ int perm32(int rho) { const int n = rho >> 4, i = rho & 15; return 8 * (i >> 2) + 4 * n + (i & 3); }

struct Unit { int pm, pn; };
struct Gemm { const bf16_t* A; const bf16_t* Bt; int M, N, K; };

struct StaticOrder {
    int nM, nN, nwg, G, c;
    __host__ __device__ void init(int M, int N, int G_, int c_) { nM = M / BM; nN = N / BM; nwg = nM * nN; G = G_; c = c_; }
    __host__ __device__ bool next(int i, Unit& u) const {
        const long L = (long)i * G + c; if (L >= nwg) return false;
        int wgid = (int)L; { const int q = nwg / NXCD, r = nwg % NXCD, xcd = wgid % NXCD, off = wgid / NXCD; wgid = (xcd < r ? xcd * (q + 1) : r * (q + 1) + (xcd - r) * q) + off; }
        const int nig = WGM * nN, gid = wgid / nig, fm = gid * WGM, gsz = (nM - fm) < WGM ? (nM - fm) : WGM;
        u.pm = fm + ((wgid % nig) % gsz); u.pn = (wgid % nig) / gsz; return true;
    }
    __device__ __forceinline__ void a_ready(const Unit&) const {}
    __device__ __forceinline__ void done(const Unit&) const {}
};

__device__ __forceinline__ unsigned cvt_pk_bf16(float lo, float hi) { unsigned r; asm volatile("v_cvt_pk_bf16_f32 %0, %1, %2" : "=v"(r) : "v"(lo), "v"(hi)); return r; }
typedef float f32x2 __attribute__((ext_vector_type(2)));
struct RevOrder {
    StaticOrder so; int nrounds;
    __host__ __device__ bool next(int i, Unit& u) const { return i < nrounds && so.next(nrounds - 1 - i, u); }
    __device__ __forceinline__ void a_ready(const Unit&) const {}
    __device__ __forceinline__ void done(const Unit&) const {}
};
template <int MODE> struct EpiX {
    static constexpr bool PERM = true, AFTER_DRAIN = false;
    bf16_t* O; int ldc; const float* bias; const float* cs; int q_lo, q_hi, k_lo, k_hi; float qscale; const float* rs; int blk;
    __device__ __forceinline__ void operator()(const f32x4 (&acc)[2][2][4][2], const Unit& u, int wr, int wc, int fr, int fq) const {
        const int row0 = u.pm * BM + wr * 64 + fr; const int col0 = u.pn * BM + wc * 32 + 8 * fq;
        f32x4 bv[2][2];
#pragma unroll
        for (int bj = 0; bj < 2; ++bj)
#pragma unroll
            for (int n = 0; n < 2; ++n) bv[bj][n] = bias ? *(const f32x4*)(bias + col0 + bj * HALF + 4 * n) : (f32x4){0.f, 0.f, 0.f, 0.f};
        const bool ropelane = (MODE == 2) && ((wc & 1) == 0) && (fq < 2);
#pragma unroll
        for (int ai = 0; ai < 2; ++ai)
#pragma unroll
            for (int m = 0; m < 4; ++m) { const int row = row0 + ai * HALF + m * 16; bf16_t* rowp = blk ? O + ((size_t)u.pm * blk + u.pn) * 65536 + (size_t)(row - u.pm * BM) * 256 + (col0 - u.pn * BM) : O + (size_t)row * ldc + col0;
                const float rsv = rs ? rs[row] : 1.0f;
                f32x4 c01 = (f32x4){1.f, 0.f, 1.f, 0.f}, c23 = (f32x4){1.f, 0.f, 1.f, 0.f};
                if (MODE == 2) { if (ropelane) { const float* cp = cs + (size_t)row * 16 + fq * 8; c01 = *(const f32x4*)cp; c23 = *(const f32x4*)(cp + 4); } }
#pragma unroll
                for (int bj = 0; bj < 2; ++bj) { f32x4 v0 = acc[ai][bj][m][0] * rsv + bv[bj][0], v1 = acc[ai][bj][m][1] * rsv + bv[bj][1];
                    if (MODE == 1) { v0 = __builtin_elementwise_max(v0, (f32x4){0.f, 0.f, 0.f, 0.f}); v1 = __builtin_elementwise_max(v1, (f32x4){0.f, 0.f, 0.f, 0.f}); v0 = v0 * v0; v1 = v1 * v1; }
                    if (MODE == 2) { const int cb = u.pn * BM + bj * HALF + wc * 32; const bool isq = cb >= q_lo && cb < q_hi, isk = cb >= k_lo && cb < k_hi;
                        if (ropelane && (isq || isk)) {
                            f32x4 r0, r1;
                            r0[0] = v0[0] * c01[0] - v0[1] * c01[1]; r0[1] = v0[1] * c01[0] + v0[0] * c01[1];
                            r0[2] = v0[2] * c01[2] - v0[3] * c01[3]; r0[3] = v0[3] * c01[2] + v0[2] * c01[3];
                            r1[0] = v1[0] * c23[0] - v1[1] * c23[1]; r1[1] = v1[1] * c23[0] + v1[0] * c23[1];
                            r1[2] = v1[2] * c23[2] - v1[3] * c23[3]; r1[3] = v1[3] * c23[2] + v1[2] * c23[3];
                            v0 = r0; v1 = r1; }
                        if (isq) { v0 = v0 * qscale; v1 = v1 * qscale; } }
                    u32x4 w; w.x = cvt_pk_bf16(v0[0], v0[1]); w.y = cvt_pk_bf16(v0[2], v0[3]); w.z = cvt_pk_bf16(v1[0], v1[1]); w.w = cvt_pk_bf16(v1[2], v1[3]);
                    *(u32x4*)(rowp + bj * HALF) = w; } }
    }
};
struct EpiU {
    static constexpr bool PERM = true, AFTER_DRAIN = false;
    bf16_t* O; int ldc; const float* rs;
    __device__ __forceinline__ void operator()(const f32x4 (&acc)[2][2][4][2], const Unit& u, int wr, int wc, int fr, int fq) const {
        const int row0 = u.pm * BM + wr * 64 + fr; bf16_t* base = O + 512 + (u.pn - 2) * 128 + wc * 32 + 8 * fq;
#pragma unroll
        for (int ai = 0; ai < 2; ++ai)
#pragma unroll
            for (int m = 0; m < 4; ++m) { const int row = row0 + ai * HALF + m * 16; const float r2 = rs[row] * rs[row];
                const f32x4 p0 = acc[ai][0][m][0] * acc[ai][1][m][0] * r2, p1 = acc[ai][0][m][1] * acc[ai][1][m][1] * r2;
                u32x4 w; w.x = cvt_pk_bf16(p0[0], p0[1]); w.y = cvt_pk_bf16(p0[2], p0[3]); w.z = cvt_pk_bf16(p1[0], p1[1]); w.w = cvt_pk_bf16(p1[2], p1[3]);
                *(u32x4*)(base + (size_t)row * ldc) = w; }
    }
};
struct EpiInProj {
    static constexpr bool PERM = true, AFTER_DRAIN = false;
    EpiX<2> ex; EpiU eu;
    __device__ __forceinline__ void operator()(const f32x4 (&acc)[2][2][4][2], const Unit& u, int wr, int wc, int fr, int fq) const {
        if (u.pn >= 2 && u.pn < 6) eu(acc, u, wr, wc, fr, fq); else ex(acc, u, wr, wc, fr, fq);
    }
};
struct SubsetOrder {
    StaticOrder so; int keep, skip;
    __host__ __device__ bool next(int i, Unit& u) const { if (!so.next(i, u)) return false; if (u.pn >= keep) u.pn += skip; return true; }
    __device__ __forceinline__ void a_ready(const Unit&) const {}
    __device__ __forceinline__ void done(const Unit&) const {}
};
template <class Epi, class Sched, bool ALIGN_EPI = false, bool SP2 = false, bool ABLK = false>
__device__ __forceinline__ void gemm_phase(PG8_LAS unsigned char* lds, const Gemm g, const Sched& S, const Epi& E) {
    int tid_ = threadIdx.x; asm volatile("" : "+v"(tid_));
    const int tid = tid_, wid = __builtin_amdgcn_readfirstlane(tid >> 6), lane = tid & 63, wr = wid >> 2, wc = wid & 3, fr = lane & 15, fq = lane >> 4;
    const int K = g.K, nt = K / BK;
    unsigned voffA[2], voffB[2];
#pragma unroll
    for (int i = 0; i < 2; ++i) { int R, C; stage_rc(tid * 16 + i * 8192, R, C); const int Rb = Epi::PERM ? ((R & ~31) + perm32(R & 31)) : R;
        voffA[i] = (unsigned)(R * (ABLK ? 256 : K) + C) * 2u; voffB[i] = (unsigned)(Rb * K + C) * 2u; }
    const size_t kstep = (size_t)(BK * 2);
    const size_t hstep = (size_t)HALF * K * 2;
    const size_t tstep = 2 * hstep;
    const size_t hstepA = ABLK ? (size_t)HALF * 256 * 2 : hstep;
#define PG8_KA(t) (ABLK ? ((size_t)((t) >> 2) * 131072 + (size_t)(((t) >> 1) & 1) * 256) : (size_t)(t) * kstep)
    const unsigned ldsw = (unsigned)wid * 1024u;
    const int aoff = lds_byte(wr * 64 + fr, fq * 8), boff = lds_byte(wc * 32 + fr, fq * 8);
#define PG8_SA(b, h) (((b) * 2 + (h)) * HTB)
#define PG8_SB(b, h) ((4 + (b) * 2 + (h)) * HTB)
#define PG8_STAGE(bufoff, gbase, voff) do { _Pragma("unroll") for (int _i = 0; _i < 2; ++_i) \
        __builtin_amdgcn_global_load_lds((const unsigned*)((const char*)(gbase) + (voff)[_i]), (PG8_LAS unsigned*)(lds + (bufoff) + ldsw + _i * 8192), 16, 0, 0); } while (0)
#define PG8_LDA(dst, b, h) do { _Pragma("unroll") for (int m = 0; m < 4; ++m) _Pragma("unroll") for (int k = 0; k < 2; ++k) dst[m][k] = *(const PG8_LAS bf16x8*)(lds + PG8_SA(b, h) + aoff + m * 2048 + k * 1024); } while (0)
#define PG8_LDB(dst, b, h) do { _Pragma("unroll") for (int n = 0; n < 2; ++n) _Pragma("unroll") for (int k = 0; k < 2; ++k) dst[n][k] = *(const PG8_LAS bf16x8*)(lds + PG8_SB(b, h) + boff + n * 2048 + k * 1024); } while (0)
#define PG8_MMA(ai, bj, At, Bt) do { __builtin_amdgcn_s_setprio(1); _Pragma("unroll") for (int m = 0; m < 4; ++m) _Pragma("unroll") for (int n = 0; n < 2; ++n) _Pragma("unroll") for (int k = 0; k < 2; ++k) \
        acc[ai][bj][m][n] = __builtin_amdgcn_mfma_f32_16x16x32_bf16(Bt[n][k], At[m][k], acc[ai][bj][m][n], 0, 0, 0); __builtin_amdgcn_s_setprio(0); } while (0)
#define PG8_WAIT_V(n) asm volatile("s_waitcnt vmcnt(" #n ")" ::: "memory")
#define PG8_WAIT_L(n) asm volatile("s_waitcnt lgkmcnt(" #n ")" ::: "memory")
#define PG8_BAR __builtin_amdgcn_s_barrier()
#define PG8_SCHED __builtin_amdgcn_sched_barrier(0)
    Unit cur, nxt; int ui = 0;
    if (!S.next(0, cur)) return;
    f32x4 acc[2][2][4][2];
#pragma unroll
    for (int a = 0; a < 2; ++a)
#pragma unroll
        for (int b = 0; b < 2; ++b)
#pragma unroll
            for (int m = 0; m < 4; ++m)
#pragma unroll
                for (int n = 0; n < 2; ++n) acc[a][b][m][n] = (f32x4){0.f, 0.f, 0.f, 0.f};
    bf16x8 At[4][2], B0[2][2], B1[2][2];
    const char* cA = (const char*)g.A + (size_t)cur.pm * tstep; const char* cB = (const char*)g.Bt + (size_t)cur.pn * tstep;
    S.a_ready(cur);
    if constexpr (SP2) {
        PG8_STAGE(PG8_SB(0, 0), cB, voffB); PG8_STAGE(PG8_SB(0, 1), cB + hstep, voffB); PG8_STAGE(PG8_SA(0, 0), cA, voffA); PG8_STAGE(PG8_SA(0, 1), cA + hstepA, voffA);
        if (wr == 1) PG8_BAR;
        PG8_WAIT_V(2); PG8_BAR;
        PG8_STAGE(PG8_SB(1, 0), cB + kstep, voffB); PG8_STAGE(PG8_SA(1, 0), cA + kstep, voffA); PG8_STAGE(PG8_SB(1, 1), cB + hstep + kstep, voffB);
        PG8_WAIT_V(6); PG8_BAR;
    } else {
        PG8_STAGE(PG8_SB(0, 0), cB, voffB); PG8_STAGE(PG8_SA(0, 0), cA, voffA); PG8_STAGE(PG8_SB(0, 1), cB + hstep, voffB); PG8_STAGE(PG8_SA(0, 1), cA + hstepA, voffA);
        if (wr == 1) PG8_BAR;
        PG8_WAIT_V(4); PG8_BAR;
        PG8_STAGE(PG8_SB(1, 0), cB + kstep, voffB); PG8_STAGE(PG8_SA(1, 0), cA + kstep, voffA); PG8_STAGE(PG8_SB(1, 1), cB + hstep + kstep, voffB);
        PG8_WAIT_V(6); PG8_BAR;
    }
    for (;;) {
        const bool has_next = S.next(ui + 1, nxt);
        const char* nA = has_next ? (const char*)g.A + (size_t)nxt.pm * tstep : cA; const char* nB = has_next ? (const char*)g.Bt + (size_t)nxt.pn * tstep : cB;
        for (int t = 0; t < nt; t += 2) {
            const bool last = (t == nt - 2);
            const char* a1 = cA + PG8_KA(t) + kstep;
            const char* a2 = last ? nA : cA + PG8_KA(t + 2); const char* b2 = last ? nB : cB + (size_t)(t + 2) * kstep;
            const char* a3 = a2 + kstep; const char* b3 = b2 + kstep;
            if (last && has_next) S.a_ready(nxt);
            if constexpr (SP2) {
            PG8_LDB(B0, 0, 0); PG8_LDB(B1, 0, 1); PG8_SCHED; PG8_LDA(At, 0, 0); PG8_STAGE(PG8_SA(1, 1), a1 + hstepA, voffA);
            PG8_WAIT_V(8); PG8_WAIT_L(0); PG8_BAR; PG8_MMA(0, 0, At, B0); PG8_MMA(0, 1, At, B1); PG8_BAR; PG8_SCHED;
            PG8_LDA(At, 0, 1); PG8_STAGE(PG8_SB(0, 0), b2, voffB); PG8_STAGE(PG8_SB(0, 1), b2 + hstep, voffB); PG8_STAGE(PG8_SA(0, 0), a2, voffA);
            PG8_WAIT_V(8); PG8_WAIT_L(0); PG8_BAR; PG8_MMA(1, 0, At, B0); PG8_MMA(1, 1, At, B1); PG8_BAR; PG8_SCHED;
            PG8_LDB(B0, 1, 0); PG8_LDB(B1, 1, 1); PG8_SCHED; PG8_LDA(At, 1, 0); PG8_STAGE(PG8_SA(0, 1), a2 + hstepA, voffA);
            PG8_WAIT_V(8); PG8_WAIT_L(0); PG8_BAR; PG8_MMA(0, 0, At, B0); PG8_MMA(0, 1, At, B1); PG8_BAR; PG8_SCHED;
            PG8_LDA(At, 1, 1); PG8_STAGE(PG8_SB(1, 0), b3, voffB); PG8_STAGE(PG8_SB(1, 1), b3 + hstep, voffB); PG8_STAGE(PG8_SA(1, 0), a3, voffA);
            PG8_WAIT_V(8); PG8_WAIT_L(0); PG8_BAR; PG8_MMA(1, 0, At, B0); PG8_MMA(1, 1, At, B1); PG8_BAR; PG8_SCHED;
            } else {
            PG8_LDB(B0, 0, 0); PG8_SCHED; PG8_LDA(At, 0, 0); PG8_STAGE(PG8_SA(1, 1), a1 + hstepA, voffA);
            PG8_WAIT_L(8); PG8_BAR; PG8_WAIT_L(0); PG8_MMA(0, 0, At, B0); PG8_BAR; PG8_SCHED;
            PG8_LDB(B1, 0, 1); PG8_STAGE(PG8_SB(0, 0), b2, voffB);
            PG8_BAR; PG8_WAIT_L(0); PG8_MMA(0, 1, At, B1); PG8_BAR;
            PG8_LDA(At, 0, 1); PG8_STAGE(PG8_SA(0, 0), a2, voffA);
            PG8_BAR; PG8_WAIT_L(0); PG8_MMA(1, 0, At, B0); PG8_BAR; PG8_SCHED;
            PG8_STAGE(PG8_SB(0, 1), b2 + hstep, voffB);
            PG8_WAIT_V(6); PG8_BAR; PG8_MMA(1, 1, At, B1); PG8_BAR;
            PG8_LDB(B0, 1, 0); PG8_SCHED; PG8_LDA(At, 1, 0); PG8_STAGE(PG8_SA(0, 1), a2 + hstepA, voffA);
            PG8_WAIT_L(8); PG8_BAR; PG8_WAIT_L(0); PG8_MMA(0, 0, At, B0); PG8_BAR; PG8_SCHED;
            PG8_LDB(B1, 1, 1); PG8_STAGE(PG8_SB(1, 0), b3, voffB);
            PG8_BAR; PG8_WAIT_L(0); PG8_MMA(0, 1, At, B1); PG8_BAR;
            PG8_LDA(At, 1, 1); PG8_STAGE(PG8_SA(1, 0), a3, voffA);
            PG8_BAR; PG8_WAIT_L(0); PG8_MMA(1, 0, At, B0); PG8_BAR; PG8_SCHED;
            PG8_STAGE(PG8_SB(1, 1), b3 + hstep, voffB);
            PG8_WAIT_V(6); PG8_BAR; PG8_MMA(1, 1, At, B1); PG8_BAR;
            }
        }
        if constexpr (ALIGN_EPI) { if (wr == 0) PG8_BAR; }
        if constexpr (!Epi::AFTER_DRAIN) { E(acc, cur, wr, wc, fr, fq); S.done(cur); }
        if (!has_next) break;
#pragma unroll
        for (int a = 0; a < 2; ++a)
#pragma unroll
            for (int b = 0; b < 2; ++b)
#pragma unroll
                for (int m = 0; m < 4; ++m)
#pragma unroll
                    for (int n = 0; n < 2; ++n) acc[a][b][m][n] = (f32x4){0.f, 0.f, 0.f, 0.f};
        cur = nxt; cA = nA; cB = nB; ++ui;
        if constexpr (ALIGN_EPI) { if (wr == 1) PG8_BAR; }
    }
    PG8_WAIT_V(0);
    if constexpr (!ALIGN_EPI) { if (wr == 0) PG8_BAR; }
    PG8_BAR;
    if constexpr (Epi::AFTER_DRAIN) { E.fused(acc, cur, wr, wc, fr, fq, lds, wid, lane); S.done(cur); }
#undef PG8_KA
#undef PG8_SA
#undef PG8_SB
#undef PG8_STAGE
#undef PG8_LDA
#undef PG8_LDB
#undef PG8_MMA
#undef PG8_WAIT_V
#undef PG8_WAIT_L
#undef PG8_BAR
#undef PG8_SCHED
}
}
#include <hip/hip_bf16.h>
#include <cmath>
namespace attn_body {
using bf16=__hip_bfloat16;
using bf16x8=__attribute__((ext_vector_type(8)))short;
using s16x4=__attribute__((ext_vector_type(4)))short;
using f32x16=__attribute__((ext_vector_type(16)))float;
using u32x4=__attribute__((ext_vector_type(4)))unsigned;
constexpr int SEQ=4096,D=64,PQ=3072,PO=1024;
constexpr int NW=8,QBLK=32,QB=QBLK*NW,KVBLK=64,NQB=SEQ/QB;
constexpr int ATTN_UNIT_ROWS=QB;
__device__ __forceinline__ int crow(int r,int hi){return (r&3)+8*(r>>2)+4*hi;}
#define SBAR() __builtin_amdgcn_sched_barrier(0)
__device__ __forceinline__ void cmask(f32x16&p0,f32x16&p1,int jb,int qrel,int hi){
  const float NEG=-INFINITY; int kb=64*jb+4*hi;
  #pragma unroll
  for(int r=0;r<16;++r){int kv=kb+(r&3)+8*(r>>2); if(kv>qrel)p0[r]=NEG; if(kv+32>qrel)p1[r]=NEG;}
}

constexpr int NSLOT=3, SLOTB=8192;
constexpr int LDS_K=0, LDS_V=NSLOT*SLOTB, LDS_WS=2*NSLOT*SLOTB, LDS_OST=LDS_WS+NW*64*4, LDS_BYTES=LDS_OST+NW*4096;
constexpr float C2=0.125f*1.4426950408889634f;
__device__ __forceinline__ void glds16(const void*gsrc,unsigned lds_dst){unsigned keep;
  asm volatile("s_mov_b32 %0, m0\n\ts_mov_b32 m0, %2\n\ts_nop 0\n\tglobal_load_lds_dwordx4 %1, off\n\ts_mov_b32 m0, %0":"=&s"(keep):"v"(gsrc),"s"(lds_dst):"memory");}
__device__ __forceinline__ float max3f(float a,float b,float c){float r;asm("v_max3_f32 %0, %1, %2, %3":"=v"(r):"v"(a),"v"(b),"v"(c));return r;}
__device__ __forceinline__ float max2f(float a,float b){float r;asm("v_max_f32_e32 %0, %1, %2":"=v"(r):"v"(a),"v"(b));return r;}
__device__ __forceinline__ float fadd_s(float a,float b){float r;asm("v_add_f32_e32 %0, %1, %2":"=v"(r):"v"(a),"v"(b));return r;}
__device__ __forceinline__ float fsub_s(float a,float b){float r;asm("v_sub_f32_e32 %0, %1, %2":"=v"(r):"v"(a),"v"(b));return r;}
typedef float f32x2_t __attribute__((ext_vector_type(2))); typedef __bf16 bf16x2_t __attribute__((ext_vector_type(2)));
__device__ __forceinline__ unsigned cvtpk_s(float lo,float hi){f32x2_t v={lo,hi};bf16x2_t b=__builtin_convertvector(v,bf16x2_t);return __builtin_bit_cast(unsigned,b);}
#define WAIT_BAR(N) asm volatile("s_waitcnt vmcnt(" #N ") lgkmcnt(0)\n\ts_barrier":::"memory")

__device__ __forceinline__ void qkt(f32x16&p0,f32x16&p1,const char*Kslot,const bf16x8*qr,const f32x16&negm,int r32,int hi){
  const char*kb=Kslot+hi*1024+r32*16;
  #pragma unroll
  for(int d0=0;d0<4;++d0){
    const bf16x8 b0=*reinterpret_cast<const bf16x8*>(kb+d0*2048);
    const bf16x8 b1=*reinterpret_cast<const bf16x8*>(kb+d0*2048+512);
    if(d0==0){p0=__builtin_amdgcn_mfma_f32_32x32x16_bf16(b0,qr[0],negm,0,0,0);p1=__builtin_amdgcn_mfma_f32_32x32x16_bf16(b1,qr[0],negm,0,0,0);}
    else{p0=__builtin_amdgcn_mfma_f32_32x32x16_bf16(b0,qr[d0],p0,0,0,0);p1=__builtin_amdgcn_mfma_f32_32x32x16_bf16(b1,qr[d0],p1,0,0,0);}}
}
typedef __attribute__((address_space(3))) const char* lds_cptr;
typedef short v4i16_t __attribute__((ext_vector_type(4)));
__device__ __forceinline__ void kload8(bf16x8*kf,lds_cptr kp){
  kf[0]=*(const __attribute__((address_space(3))) bf16x8*)(kp);      kf[1]=*(const __attribute__((address_space(3))) bf16x8*)(kp+512);
  kf[2]=*(const __attribute__((address_space(3))) bf16x8*)(kp+2048); kf[3]=*(const __attribute__((address_space(3))) bf16x8*)(kp+2560);
  kf[4]=*(const __attribute__((address_space(3))) bf16x8*)(kp+4096); kf[5]=*(const __attribute__((address_space(3))) bf16x8*)(kp+4608);
  kf[6]=*(const __attribute__((address_space(3))) bf16x8*)(kp+6144); kf[7]=*(const __attribute__((address_space(3))) bf16x8*)(kp+6656);
}
__device__ __forceinline__ void kload2(bf16x8*kf,lds_cptr kp,int j){ kf[2*j]=*(const __attribute__((address_space(3))) bf16x8*)(kp+j*2048); kf[2*j+1]=*(const __attribute__((address_space(3))) bf16x8*)(kp+j*2048+512); }
__device__ __forceinline__ s16x4 vtr(lds_cptr p){ return __builtin_bit_cast(s16x4,__builtin_amdgcn_ds_read_tr16_b64_v4i16((__attribute__((address_space(3))) v4i16_t*)p)); }
__device__ __forceinline__ float rowmax(const f32x16&p0,const f32x16&p1){
  float a=max3f(p0[0],p0[1],p1[0]),b=max3f(p0[2],p0[3],p1[1]);a=max3f(a,p1[2],p1[3]);
  #pragma unroll
  for(int r=4;r<16;r+=4){a=max3f(a,p0[r],p0[r+1]);b=max3f(b,p0[r+2],p0[r+3]);a=max3f(a,p1[r],p1[r+1]);b=max3f(b,p1[r+2],p1[r+3]);}
  const float m=max2f(a,b);
  auto rr=__builtin_amdgcn_permlane32_swap(__float_as_uint(m),__float_as_uint(m),false,false);
  return max2f(__uint_as_float(rr[0]),__uint_as_float(rr[1]));
}
__device__ __forceinline__ void pv(f32x16*o,int vb,bf16x8 pa0,bf16x8 pa1,bf16x8 pa2,bf16x8 pa3){
  #pragma unroll
  for(int d0=0;d0<2;++d0){s16x4 lo[4],hi[4];
    #pragma unroll
    for(int ks=0;ks<4;++ks){
      asm volatile("ds_read_b64_tr_b16 %0,%1 offset:%c2":"=&v"(lo[ks]):"v"(vb),"i"(d0*4096+ks*1024):"memory");
      asm volatile("ds_read_b64_tr_b16 %0,%1 offset:%c2":"=&v"(hi[ks]):"v"(vb),"i"(d0*4096+ks*1024+512):"memory");}
    asm volatile("s_waitcnt lgkmcnt(0)":::"memory");SBAR();
    #define PK(k) (bf16x8){lo[k][0],lo[k][1],lo[k][2],lo[k][3],hi[k][0],hi[k][1],hi[k][2],hi[k][3]}
    o[d0]=__builtin_amdgcn_mfma_f32_32x32x16_bf16(pa0,PK(0),o[d0],0,0,0);
    o[d0]=__builtin_amdgcn_mfma_f32_32x32x16_bf16(pa1,PK(1),o[d0],0,0,0);
    o[d0]=__builtin_amdgcn_mfma_f32_32x32x16_bf16(pa2,PK(2),o[d0],0,0,0);
    o[d0]=__builtin_amdgcn_mfma_f32_32x32x16_bf16(pa3,PK(3),o[d0],0,0,0);
    #undef PK
  }
}

#ifndef ATTN_STORE16
#define ATTN_STORE16(p,v) (*(u32x4*)(p)=(v))
#endif
template<int THRL> __device__ __forceinline__ void attn_unit(int b,int qb,const bf16*Q,const bf16*__restrict__ K,const bf16*__restrict__ V,bf16*O,char*shm){
  int tid_=threadIdx.x; asm volatile("":"+v"(tid_)); const int tid=tid_,lane=tid&63,r32=lane&31,hi=lane>>5; const int wid=__builtin_amdgcn_readfirstlane(tid>>6);
  const long rowbase=(long)b*SEQ; const int q0=qb*QB;
  const bf16*Qw=Q+(rowbase+q0+wid*QBLK)*PQ;
  const bf16*Kh=K+rowbase*PQ,*Vh=V+rowbase*PQ;
  const unsigned lds0=(unsigned)(uintptr_t)shm;
  float*wsf=(float*)(shm+LDS_WS)+wid*64;
  const bf16*ksrc=Kh+(long)lane*PQ+wid*8;
  const bf16*vsrc=Vh+(long)(16*(wid&3)+(lane>>2))*PQ+(wid>>2)*32+(lane&3)*8;
  const unsigned kdst=lds0+LDS_K+wid*1024, vdst=lds0+LDS_V+wid*1024;
  #define DMA_K(t,slot) glds16(ksrc+(long)(t)*KVBLK*PQ,(unsigned)__builtin_amdgcn_readfirstlane(kdst+(slot)))
  #define DMA_V(t,slot) glds16(vsrc+(long)(t)*KVBLK*PQ,(unsigned)__builtin_amdgcn_readfirstlane(vdst+(slot)))
  const int vb0=(int)(lds0+LDS_V)+((lane>>4)&1)*32+(lane&3)*8+(4*hi+((lane&15)>>2))*64;
  const char*Kbase=shm+LDS_K; bf16x8 kf[8];
  const lds_cptr shm3=(lds_cptr)shm; const lds_cptr kp0=shm3+LDS_K+hi*1024+r32*16; const lds_cptr vp0=shm3+LDS_V+((lane>>4)&1)*32+(lane&3)*8+(4*hi+((lane&15)>>2))*64;
  const int NT=(q0+QB)/KVBLK;
  DMA_K(0,0);DMA_V(0,0);DMA_K(1,SLOTB);
  bf16x8 qr[4];
  #pragma unroll
  for(int d0=0;d0<4;++d0)qr[d0]=*reinterpret_cast<const bf16x8*>(&Qw[(long)r32*PQ+d0*16+hi*8]);
  float mhat=0.f,l_reg=0.f;f32x16 o[2];o[0]=f32x16{};o[1]=f32x16{};f32x16 negm=f32x16{};asm volatile("":"+v"(negm));
  const int qrel=wid*QBLK+r32;
  #define CMASK(P0,P1,t) do{int jb_=(t)-(NT-4); if(jb_>=0)cmask(P0,P1,jb_,qrel,hi);}while(0)
  bool resc=false;
  #define START(P0,P1) do{ const float rm=rowmax(P0,P1); resc=false; \
    { const float dl=rm; mhat=fadd_s(mhat,dl); \
      _Pragma("unroll") for(int r=0;r<16;++r){P0[r]=fsub_s(P0[r],dl);P1[r]=fsub_s(P1[r],dl);} \
      _Pragma("unroll") for(int r=0;r<16;++r)negm[r]=-mhat; asm volatile("":"+v"(negm)); } \
    _Pragma("unroll") for(int r=0;r<16;++r)P0[r]=__builtin_amdgcn_exp2f(P0[r]); }while(0)
  #define RESC() do{ if(resc){ asm volatile("s_waitcnt lgkmcnt(0)":::"memory"); \
      _Pragma("unroll") for(int d_=0;d_<2;++d_) _Pragma("unroll") for(int r=0;r<16;++r)o[d_][r]*=wsf[crow(r,hi)]; } }while(0)
  f32x16 pA0,pA1,pB0,pB1;
  int sl_prev=0,sl_cur=0,sl_next=SLOTB;
  #define ROT() do{sl_prev=sl_cur;sl_cur=sl_next;sl_next=(sl_next==(NSLOT-1)*SLOTB)?0:sl_next+SLOTB;}while(0)
  DMA_K(2,2*SLOTB);
  WAIT_BAR(3);
  qkt(pA0,pA1,Kbase,qr,negm,r32,hi);asm volatile("s_nop 15\n\ts_nop 7":"+v"(pA0),"+v"(pA1));CMASK(pA0,pA1,0);
  START(pA0,pA1);
  _Pragma("unroll") for(int r=0;r<16;++r)pA1[r]=__builtin_amdgcn_exp2f(pA1[r]);
  WAIT_BAR(0);
  DMA_K(3,0);DMA_V(1,SLOTB);
  ROT();
  kload8(kf,kp0+sl_cur);
  WAIT_BAR(2);
  s16x4 vlo[8],vhi[8]; u32x4 pw0,pw1,pw2,pw3;
  #define PKW(P,B) cvtpk_s(P[B],P[B+1])
  #define PAF(k) __builtin_bit_cast(bf16x8,pw##k)
  #define VFR(i) (bf16x8){vlo[i][0],vlo[i][1],vlo[i][2],vlo[i][3],vhi[i][0],vhi[i][1],vhi[i][2],vhi[i][3]}
  #define PIN(x) asm volatile("":"+v"(x))
  #define MX3(a,b,c) __builtin_fmaxf(__builtin_fmaxf((a),(b)),(c))
  #define GAPA(MF,A0,A1,A2,A3,W0,W1,PW) do{ MF; sacc+=A0; sacc+=A1; sacc+=A2; sacc+=A3; PIN(sacc); W0; W1; PIN(PW); SBAR(); }while(0)
  #define EX(v) __builtin_amdgcn_exp2f(v)
  #define GAPB(MF,X,B) do{ MF; X[B]=EX(X[B]); X[B+1]=EX(X[B+1]); X[B+2]=EX(X[B+2]); X[B+3]=EX(X[B+3]); PIN(X); SBAR(); }while(0)
  #define VRD(i) do{ vlo[i]=vtr(vp_+(((i)>>2)*4096+((i)&3)*1024)); vhi[i]=vtr(vp_+(((i)>>2)*4096+((i)&3)*1024+512)); }while(0)
  #define KRD(G,j) do{ if(G){ kload2(kf,kp0+sl_next,j); SBAR(); } }while(0)
  #define STEP(C0,C1,P0,P1,t,GK,GV,GL) do{ SBAR(); \
    const lds_cptr vp_=vp0+sl_prev; \
    VRD(0); SBAR(); float sacc=(P0[0]+P0[1]); \
    GAPA(C0=__builtin_amdgcn_mfma_f32_32x32x16_bf16(kf[0],qr[0],negm,0,0,0), P0[2],P0[3],P0[4],P0[5],     pw0[0]=PKW(P0,0), pw0[1]=PKW(P0,2), pw0); \
    VRD(4); SBAR(); GAPA(C1=__builtin_amdgcn_mfma_f32_32x32x16_bf16(kf[1],qr[0],negm,0,0,0), P0[6],P0[7],P0[8],P0[9],     pw0[2]=PKW(P0,4), pw0[3]=PKW(P0,6), pw0); \
    VRD(1); SBAR(); GAPA(C0=__builtin_amdgcn_mfma_f32_32x32x16_bf16(kf[2],qr[1],C0,0,0,0),   P0[10],P0[11],P0[12],P0[13], pw1[0]=PKW(P0,8), pw1[1]=PKW(P0,10), pw1); \
    VRD(5); SBAR(); GAPA(C1=__builtin_amdgcn_mfma_f32_32x32x16_bf16(kf[3],qr[1],C1,0,0,0),   P0[14],P0[15],P1[0],P1[1],   pw1[2]=PKW(P0,12),pw1[3]=PKW(P0,14), pw1); \
    VRD(2); SBAR(); GAPA(C0=__builtin_amdgcn_mfma_f32_32x32x16_bf16(kf[4],qr[2],C0,0,0,0),   P1[2],P1[3],P1[4],P1[5],     pw2[0]=PKW(P1,0), pw2[1]=PKW(P1,2), pw2); \
    VRD(6); SBAR(); GAPA(C1=__builtin_amdgcn_mfma_f32_32x32x16_bf16(kf[5],qr[2],C1,0,0,0),   P1[6],P1[7],P1[8],P1[9],     pw2[2]=PKW(P1,4), pw2[3]=PKW(P1,6), pw2); \
    VRD(3); SBAR(); GAPA(C0=__builtin_amdgcn_mfma_f32_32x32x16_bf16(kf[6],qr[3],C0,0,0,0),   P1[10],P1[11],P1[12],P1[13], pw3[0]=PKW(P1,8), pw3[1]=PKW(P1,10), pw3); \
    VRD(7); SBAR(); GAPA(C1=__builtin_amdgcn_mfma_f32_32x32x16_bf16(kf[7],qr[3],C1,0,0,0),   P1[14],P1[15],0.f,0.f,       pw3[2]=PKW(P1,12),pw3[3]=PKW(P1,14), pw3); \
    l_reg+=sacc; \
    if(GK){DMA_K((t)+3,sl_cur);} if(GV){DMA_V((t)+1,sl_next);} \
    CMASK(C0,C1,t); \
    { float a=MX3(C0[0],C0[1],C1[0]),b=MX3(C0[2],C0[3],C1[1]); a=MX3(a,C1[2],C1[3]); \
      _Pragma("unroll") for(int r=4;r<16;r+=4){a=MX3(a,C0[r],C0[r+1]);b=MX3(b,C0[r+2],C0[r+3]);a=MX3(a,C1[r],C1[r+1]);b=MX3(b,C1[r+2],C1[r+3]);} \
      float rm=__builtin_fmaxf(a,b); { auto rr=__builtin_amdgcn_permlane32_swap(__float_as_uint(rm),__float_as_uint(rm),false,false); rm=__builtin_fmaxf(__uint_as_float(rr[0]),__uint_as_float(rr[1])); } \
      resc=false; \
      if(__builtin_expect(__any(rm>(float)THRL),0)){ const float dl=__builtin_fmaxf(rm,0.f); mhat+=dl; \
        _Pragma("unroll") for(int r=0;r<16;++r){C0[r]-=dl;C1[r]-=dl;} \
        _Pragma("unroll") for(int r=0;r<16;++r)negm[r]=-mhat; asm volatile("":"+v"(negm)); \
        const float f=__builtin_amdgcn_exp2f(-dl); l_reg*=f; if(hi==0)wsf[r32]=f; resc=true; } } \
    SBAR(); \
    GAPB(o[0]=__builtin_amdgcn_mfma_f32_32x32x16_bf16(PAF(0),VFR(0),o[0],0,0,0), C0,0); \
    GAPB(o[1]=__builtin_amdgcn_mfma_f32_32x32x16_bf16(PAF(0),VFR(4),o[1],0,0,0), C0,4); \
    KRD(GL,0); GAPB(o[0]=__builtin_amdgcn_mfma_f32_32x32x16_bf16(PAF(1),VFR(1),o[0],0,0,0), C0,8); \
    KRD(GL,1); GAPB(o[1]=__builtin_amdgcn_mfma_f32_32x32x16_bf16(PAF(1),VFR(5),o[1],0,0,0), C0,12); \
    KRD(GL,2); GAPB(o[0]=__builtin_amdgcn_mfma_f32_32x32x16_bf16(PAF(2),VFR(2),o[0],0,0,0), C1,0); \
    KRD(GL,3); GAPB(o[1]=__builtin_amdgcn_mfma_f32_32x32x16_bf16(PAF(2),VFR(6),o[1],0,0,0), C1,4); \
    GAPB(o[0]=__builtin_amdgcn_mfma_f32_32x32x16_bf16(PAF(3),VFR(3),o[0],0,0,0), C1,8); \
    GAPB(o[1]=__builtin_amdgcn_mfma_f32_32x32x16_bf16(PAF(3),VFR(7),o[1],0,0,0), C1,12); \
    }while(0)
  int t=1;
  #undef CMASK
  #define CMASK(P0,P1,t) do{}while(0)
  for(;t+5<NT;t+=2){
    STEP(pB0,pB1,pA0,pA1,t,true,true,true);     WAIT_BAR(2); RESC(); ROT();
    STEP(pA0,pA1,pB0,pB1,t+1,true,true,true);   WAIT_BAR(2); RESC(); ROT();
  }
  #undef CMASK
  #define CMASK(P0,P1,t) do{int jb_=(t)-(NT-4); if(jb_>=0)cmask(P0,P1,jb_,qrel,hi);}while(0)
  #define ENDW(tt) do{ if((tt)+3<NT){WAIT_BAR(2);} else if((tt)+2<NT){WAIT_BAR(1);} else {WAIT_BAR(0);} }while(0)
  for(;t+1<NT;t+=2){
    STEP(pB0,pB1,pA0,pA1,t,(t+3<NT),(t+1<NT),(t+1<NT));       ENDW(t);   RESC(); ROT();
    STEP(pA0,pA1,pB0,pB1,t+1,(t+4<NT),(t+2<NT),(t+2<NT));     ENDW(t+1); RESC(); ROT();
  }
  STEP(pB0,pB1,pA0,pA1,NT-1,false,false,false); RESC();
  { float sacc=pB0[0]+pB0[1]; _Pragma("unroll") for(int r=2;r<16;++r)sacc+=pB0[r]; _Pragma("unroll") for(int r=0;r<16;++r)sacc+=pB1[r]; l_reg+=sacc;
    pw0=(u32x4){PKW(pB0,0),PKW(pB0,2),PKW(pB0,4),PKW(pB0,6)};pw1=(u32x4){PKW(pB0,8),PKW(pB0,10),PKW(pB0,12),PKW(pB0,14)};pw2=(u32x4){PKW(pB1,0),PKW(pB1,2),PKW(pB1,4),PKW(pB1,6)};pw3=(u32x4){PKW(pB1,8),PKW(pB1,10),PKW(pB1,12),PKW(pB1,14)};
    SBAR(); pv(o,vb0+sl_cur,PAF(0),PAF(1),PAF(2),PAF(3)); }
  #undef PKW
  #undef PAF
  #undef VFR
  #undef PIN
  #undef MX3
  #undef GAPA
  #undef GAPB
  #undef EX
  #undef VRD
  #undef KRD
  #undef STEP
  #undef ENDW
  {auto rr=__builtin_amdgcn_permlane32_swap(__float_as_uint(l_reg),__float_as_uint(l_reg),false,false);l_reg=__uint_as_float(rr[0])+__uint_as_float(rr[1]);}
  if(hi==0)wsf[32+r32]=l_reg;asm volatile("s_waitcnt lgkmcnt(0)":::"memory");
  float rli[16];
  #pragma unroll
  for(int r=0;r<16;++r)rli[r]=__builtin_amdgcn_rcpf(wsf[32+crow(r,hi)]);
  bf16*Ow=O+(rowbase+q0+wid*QBLK)*PO;
  { bf16*stg=(bf16*)(shm+LDS_OST)+wid*2048;
    #pragma unroll
    for(int r=0;r<16;++r){const int orow=crow(r,hi);
      #pragma unroll
      for(int d0=0;d0<2;++d0)stg[orow*64+d0*32+r32]=__float2bfloat16(o[d0][r]*rli[r]);}
    asm volatile("s_waitcnt lgkmcnt(0)":::"memory");
    #pragma unroll
    for(int i=0;i<4;++i){const int row=i*8+(lane>>3),ch=lane&7; const u32x4 v=*(const u32x4*)(stg+row*64+ch*8); ATTN_STORE16(Ow+(long)row*PO+ch*8,v);} }
  asm volatile("s_waitcnt lgkmcnt(0)\n\ts_barrier":::"memory");
  #undef DMA_K
  #undef DMA_V
  #undef CMASK
  #undef START
  #undef RESC
  #undef ROT
}
constexpr int ATTN_LDS_BYTES=LDS_BYTES;
#undef SBAR
#undef WAIT_BAR
}
#define GAS __attribute__((address_space(1)))
#define LAS __attribute__((address_space(3)))
typedef unsigned short bf16;
typedef unsigned v4u __attribute__((ext_vector_type(4)));
typedef unsigned v2u __attribute__((ext_vector_type(2)));
typedef float f32x4 __attribute__((ext_vector_type(4)));
typedef float f32x16 __attribute__((ext_vector_type(16)));
typedef short bf16x8 __attribute__((ext_vector_type(8)));
#define LDS_WAIT() asm volatile("s_waitcnt lgkmcnt(0)" ::: "memory")

constexpr int NWAVES = 8;
constexpr int BATCH = 8, SEQ = 4096, DMODEL = 1024, FF = 4096;
constexpr int M = BATCH * SEQ;
constexpr int EVEN_IN = 3072, ODD_IN = 1280;
constexpr float C2 = 0.125f * 1.4426950408889634f;
constexpr float LOG2E = 1.4426950408889634f;
constexpr float RMS_EPS = 1e-6f, DIFF_EPS = 1e-5f;
constexpr float LAM_INIT0 = 0.2f;

constexpr size_t MiB = 1u << 20;
constexpr int RING_BYTES = 131072;
constexpr int LDS_BYTES = 147456;
constexpr size_t WS_WIN = 2 * MiB, WS_WOUT = 8 * MiB, WS_WQKV = 10 * MiB, WS_WO = 13 * MiB, WS_W1 = 16 * MiB  , WS_W2 = 32 * MiB  ;
constexpr size_t WS_CS = 48 * MiB  , WS_BQKV = 50 * MiB, WS_RS = 51 * MiB  ;
constexpr size_t WS_BAR = 0;
constexpr int MISC_OFF = RING_BYTES + 320;
constexpr size_t WS_XN = 64 * MiB;
constexpr size_t WS_A2 = 448 * MiB;
constexpr size_t WS_H = 128 * MiB;
constexpr size_t WS_PROJ = 192 * MiB;
constexpr size_t WS_ATT = 384 * MiB;
constexpr size_t WS_HF = 192 * MiB;
constexpr size_t WS_END = 512 * MiB;


struct Args {
    const float* x; const int* pos;
    const float *npre_mix, *npost_mix, *npre_mlp, *npost_mlp;
    const float *w_in, *conv_w, *lq1, *lk1, *lq2, *lk2, *subln, *w_out;
    const float *w_qkv, *b_qkv, *sinks, *w_o, *b_o, *w1, *w2;
    float* out; unsigned char* ws;
    float inv_freq[8];
};

__device__ __forceinline__ float wave_sum(float v) {
#pragma unroll
    for (int o = 1; o < 64; o <<= 1) v += __shfl_xor(v, o);
    return v;
}
__device__ __forceinline__ unsigned f2bf(float f) { unsigned u = __builtin_bit_cast(unsigned, f); return (u + 0x7fffu + ((u >> 16) & 1u)) >> 16; }
__device__ __forceinline__ unsigned pk2(float lo, float hi) { return f2bf(lo) | (f2bf(hi) << 16); }
__device__ __forceinline__ float bflo(unsigned w) { return __builtin_bit_cast(float, w << 16); }
__device__ __forceinline__ float bfhi(unsigned w) { return __builtin_bit_cast(float, w & 0xffff0000u); }
__device__ __forceinline__ int mapcol(int n) { const int hl = n & 63; return hl < 16 ? (n & ~63) + (hl >> 1) + 8 * (hl & 1) : n; }

__device__ __forceinline__ void p0_transpose_item(const float* W, int K, int N, bf16* WT, LAS float* scr, int item, int lane, int perm_lo, int perm_hi, const float* g) {
    const int nblk = N / 32, kb = item / nblk, nb = item % nblk, k0 = 64 * kb, n0 = 32 * nb;
    int ncol = n0 + (lane & 31); if (ncol >= perm_lo && ncol < perm_hi) ncol = mapcol(ncol);
    if (perm_lo == 1536 && ncol >= 512 && ncol < 1536) { const int w_ = (ncol - 512) & 255, tt_ = (ncol - 512) >> 8; ncol = (w_ < 128 ? 512 : 1024 - 128) + 128 * tt_ + w_; }
    float wv[32];
#pragma unroll
    for (int i = 0; i < 32; ++i) { const int kk = 2 * i + (lane >> 5); wv[i] = __builtin_nontemporal_load(W + (size_t)(k0 + kk) * N + ncol); }
    if (g) {
#pragma unroll
        for (int i = 0; i < 32; ++i) { const int kk = 2 * i + (lane >> 5); wv[i] *= g[k0 + kk]; } }
#pragma unroll
    for (int i = 0; i < 32; ++i) { const int kk = 2 * i + (lane >> 5); scr[kk * 33 + (lane & 31)] = wv[i]; }
    LDS_WAIT(); asm volatile("" ::: "memory");
    const int c = lane & 7;
#pragma unroll
    for (int j = 0; j < 4; ++j) { const int n = (lane >> 3) + 8 * j; const LAS float* s = scr + (8 * c) * 33 + n;
        v4u o; o.x = pk2(s[0 * 33], s[1 * 33]); o.y = pk2(s[2 * 33], s[3 * 33]); o.z = pk2(s[4 * 33], s[5 * 33]); o.w = pk2(s[6 * 33], s[7 * 33]);
        *(GAS v4u*)(WT + (size_t)(n0 + n) * K + k0 + 8 * c) = o; }
    LDS_WAIT(); asm volatile("" ::: "memory");
}

__device__ __forceinline__ void unpack8(const v4u w, float (&f)[8]) { f[0] = bflo(w.x); f[1] = bfhi(w.x); f[2] = bflo(w.y); f[3] = bfhi(w.y); f[4] = bflo(w.z); f[5] = bfhi(w.z); f[6] = bflo(w.w); f[7] = bfhi(w.w); }
template <int RPI> __device__ __forceinline__ void x_rows_to_bf16(const float* x, bf16* XB, float* rsp, int row0, int lane) {
    f32x4 v[RPI][4];
#pragma unroll
    for (int r = 0; r < RPI; ++r) { const GAS f32x4* xr = (const GAS f32x4*)(x + (size_t)(row0 + r) * DMODEL) + lane;
#pragma unroll
        for (int j = 0; j < 4; ++j) v[r][j] = __builtin_nontemporal_load(xr + 64 * j); }
    float s[RPI];
#pragma unroll
    for (int r = 0; r < RPI; ++r) { s[r] = 0.f; GAS unsigned long long* o8 = (GAS unsigned long long*)(XB + (size_t)(row0 + r) * DMODEL) + lane;
#pragma unroll
        for (int j = 0; j < 4; ++j) { s[r] += (v[r][j].x * v[r][j].x + v[r][j].y * v[r][j].y) + (v[r][j].z * v[r][j].z + v[r][j].w * v[r][j].w);
            o8[64 * j] = (unsigned long long)pk2(v[r][j].x, v[r][j].y) | ((unsigned long long)pk2(v[r][j].z, v[r][j].w) << 32); } }
#pragma unroll
    for (int o = 1; o < 64; o <<= 1)
#pragma unroll
        for (int r = 0; r < RPI; ++r) s[r] += __shfl_xor(s[r], o);
#pragma unroll
    for (int r = 0; r < RPI; ++r) if (lane == r) rsp[row0 + r] = 1.f / sqrtf(s[r] * (1.f / DMODEL) + RMS_EPS);
}

template <int RPI> __device__ __forceinline__ void nr_pass(int gw, int NGW, int lane_, const bf16* H, bf16* XB, const float* wpost, float* rsout, float* outf) {
    int lane = lane_; asm volatile("" : "+v"(lane));
    f32x4 wp[2][2];
#pragma unroll
    for (int j = 0; j < 2; ++j)
#pragma unroll
        for (int e = 0; e < 2; ++e) wp[j][e] = *(const f32x4*)(wpost + 8 * lane + 512 * j + 4 * e);
    for (int row0 = gw * RPI; row0 < M; row0 += NGW * RPI) {
        v4u hw[RPI][2], xw[RPI][2];
#pragma unroll
        for (int r = 0; r < RPI; ++r)
#pragma unroll
            for (int j = 0; j < 2; ++j) { hw[r][j] = __builtin_nontemporal_load((const GAS v4u*)(H + (size_t)(row0 + r) * DMODEL + 8 * lane + 512 * j)); xw[r][j] = *(const GAS v4u*)(XB + (size_t)(row0 + r) * DMODEL + 8 * lane + 512 * j); }
        float ss[RPI];
#pragma unroll
        for (int r = 0; r < RPI; ++r) { ss[r] = 0.f;
#pragma unroll
            for (int j = 0; j < 2; ++j) { float f[8]; unpack8(hw[r][j], f);
#pragma unroll
                for (int e = 0; e < 8; ++e) ss[r] += f[e] * f[e]; } }
#pragma unroll
        for (int o = 1; o < 64; o <<= 1)
#pragma unroll
            for (int r = 0; r < RPI; ++r) ss[r] += __shfl_xor(ss[r], o);
        float s2[RPI];
#pragma unroll
        for (int r = 0; r < RPI; ++r) { const float rs = 1.f / sqrtf(ss[r] * (1.f / DMODEL) + RMS_EPS); s2[r] = 0.f;
#pragma unroll
            for (int j = 0; j < 2; ++j) { float f[8], x[8]; unpack8(hw[r][j], f); unpack8(xw[r][j], x);
                f32x4 x0 = (f32x4){x[0], x[1], x[2], x[3]} + (f32x4){f[0], f[1], f[2], f[3]} * rs * wp[j][0], x1 = (f32x4){x[4], x[5], x[6], x[7]} + (f32x4){f[4], f[5], f[6], f[7]} * rs * wp[j][1];
                s2[r] += ((x0.x * x0.x + x0.y * x0.y) + (x0.z * x0.z + x0.w * x0.w)) + ((x1.x * x1.x + x1.y * x1.y) + (x1.z * x1.z + x1.w * x1.w));
                if (outf) { *(GAS f32x4*)(outf + (size_t)(row0 + r) * DMODEL + 8 * lane + 512 * j) = x0; *(GAS f32x4*)(outf + (size_t)(row0 + r) * DMODEL + 8 * lane + 512 * j + 4) = x1; }
                else { v4u o; o.x = pk2(x0.x, x0.y); o.y = pk2(x0.z, x0.w); o.z = pk2(x1.x, x1.y); o.w = pk2(x1.z, x1.w); *(GAS v4u*)(XB + (size_t)(row0 + r) * DMODEL + 8 * lane + 512 * j) = o; } } }
        if (rsout) {
#pragma unroll
            for (int o = 1; o < 64; o <<= 1)
#pragma unroll
                for (int r = 0; r < RPI; ++r) s2[r] += __shfl_xor(s2[r], o);
#pragma unroll
            for (int r = 0; r < RPI; ++r) if (lane == r) rsout[row0 + r] = 1.f / sqrtf(s2[r] * (1.f / DMODEL) + RMS_EPS);
        }
    }
}


__device__ __forceinline__ void mix_pass(int gw, int NGW, int lane_, const bf16* PROJ, const bf16* ATT, bf16* A2, const float* conv_w, const float* subln, float lam) {
    int lane = lane_; asm volatile("" : "+v"(lane));
    float cw[3][8], sw[8];
#pragma unroll
    for (int i = 0; i < 3; ++i)
#pragma unroll
        for (int e = 0; e < 8; ++e) cw[i][e] = conv_w[i * 512 + 8 * lane + e];
#pragma unroll
    for (int e = 0; e < 8; ++e) sw[e] = subln[(lane & 15) * 8 + e] * (1.0f - LAM_INIT0);
    for (int row0 = gw * 2; row0 < M; row0 += NGW * 2) {
        const int t0 = row0 & (SEQ - 1);
        const bf16* pr = PROJ + (size_t)row0 * EVEN_IN + 8 * lane;
        const bf16* ar = ATT + (size_t)row0 * DMODEL + (lane >> 4) * 256 + (lane & 15) * 8;
        v4u gbw[2], uw[4], o0w[2], o1w[2];
#pragma unroll
        for (int r = 0; r < 2; ++r) { gbw[r] = *(const GAS v4u*)(pr + r * EVEN_IN); o0w[r] = *(const GAS v4u*)(ar + r * DMODEL); o1w[r] = *(const GAS v4u*)(ar + r * DMODEL + 128); }
#pragma unroll
        for (int r = 0; r < 4; ++r) { if (r >= 2 || t0 > 0) uw[r] = *(const GAS v4u*)(pr + (r - 2) * EVEN_IN + 512);
            else uw[r] = (v4u){0u, 0u, 0u, 0u}; }
        float u[4][8];
#pragma unroll
        for (int r = 0; r < 4; ++r) unpack8(uw[r], u[r]);
#pragma unroll
        for (int r = 0; r < 2; ++r) { float gb[8], co[8]; unpack8(gbw[r], gb);
#pragma unroll
            for (int e = 0; e < 8; ++e) co[e] = gb[e] * (cw[0][e] * u[r][e] + cw[1][e] * u[r + 1][e] + cw[2][e] * u[r + 2][e]);
            v4u o; o.x = pk2(co[0], co[1]); o.y = pk2(co[2], co[3]); o.z = pk2(co[4], co[5]); o.w = pk2(co[6], co[7]);
            *(GAS v4u*)(A2 + (size_t)(row0 + r) * DMODEL + 8 * lane) = o; }
#pragma unroll
        for (int r = 0; r < 2; ++r) { float o0[8], o1[8], d[8]; unpack8(o0w[r], o0); unpack8(o1w[r], o1);
            float ss = 0.f;
#pragma unroll
            for (int e = 0; e < 8; ++e) { d[e] = o0[e] - lam * o1[e]; ss += d[e] * d[e]; }
            ss += __shfl_xor(ss, 1); ss += __shfl_xor(ss, 2); ss += __shfl_xor(ss, 4); ss += __shfl_xor(ss, 8);
            const float rs = 1.f / sqrtf(ss * (1.f / 128.f) + DIFF_EPS);
#pragma unroll
            for (int e = 0; e < 8; ++e) d[e] = d[e] * rs * sw[e];
            v4u o; o.x = pk2(d[0], d[1]); o.y = pk2(d[2], d[3]); o.z = pk2(d[4], d[5]); o.w = pk2(d[6], d[7]);
            *(GAS v4u*)(A2 + (size_t)(row0 + r) * DMODEL + 512 + 8 * lane) = o; }
    }
}

__device__ __forceinline__ int crow16(int r, int hi) { return (r & 3) + 8 * (r >> 2) + 4 * hi; }
__device__ __forceinline__ unsigned cvtpk(float lo, float hi) { typedef float f2 __attribute__((ext_vector_type(2))); typedef __bf16 b2 __attribute__((ext_vector_type(2))); f2 v = {lo, hi}; b2 b = __builtin_convertvector(v, b2); return __builtin_bit_cast(unsigned, b); }

constexpr int VTP = 264;
__device__ __forceinline__ void swa_phase(int vcu, int G, LAS unsigned char* lds, const bf16* QKV, const float* sinks, bf16* ATT) {
    int tid_ = threadIdx.x; asm volatile("" : "+v"(tid_)); const int tid = tid_, lane = tid & 63, q = lane & 31, hi = lane >> 5; const int wid = __builtin_amdgcn_readfirstlane(tid >> 6);
    LAS unsigned char* Kl = lds; LAS bf16* Vt = (LAS bf16*)(lds + 32768);
    for (int unit = vcu; unit < BATCH * 32 * 2; unit += G) {
        const int b = unit >> 6, blk = (unit & 63) >> 1, kvh = unit & 1;
        __syncthreads();
        v4u kvr[4], vvr[4];
#pragma unroll
        for (int i = 0; i < 4; ++i) { const int idx = tid + 512 * i, row = idx >> 3, ch = idx & 7; const int t = blk * 128 - 128 + row;
            kvr[i] = (v4u){0u, 0u, 0u, 0u}; if (t >= 0) kvr[i] = *(const GAS v4u*)(QKV + (size_t)(b * SEQ + t) * ODD_IN + 1024 + kvh * 64 + ch * 8);
            const int row2 = idx & 255, ch2 = idx >> 8; const int t2 = blk * 128 - 128 + row2;
            vvr[i] = (v4u){0u, 0u, 0u, 0u}; if (t2 >= 0) vvr[i] = *(const GAS v4u*)(QKV + (size_t)(b * SEQ + t2) * ODD_IN + 1152 + kvh * 64 + ch2 * 8); }
#pragma unroll
        for (int i = 0; i < 4; ++i) { const int idx = tid + 512 * i, row = idx >> 3, ch = idx & 7; const v4u kv = kvr[i], vv = vvr[i];
            *(LAS v4u*)(Kl + ch * 4096 + row * 16) = kv;
            const int kvi = idx & 255, kc = kvi & 15, kpos = (kvi & ~15) + ((kc & 3) | ((kc & 4) << 1) | ((kc & 8) >> 1));
            LAS bf16* vp = Vt + ((idx >> 8) * 8) * VTP + kpos;
            vp[0 * VTP] = (bf16)(vv.x & 0xffffu); vp[1 * VTP] = (bf16)(vv.x >> 16); vp[2 * VTP] = (bf16)(vv.y & 0xffffu); vp[3 * VTP] = (bf16)(vv.y >> 16);
            vp[4 * VTP] = (bf16)(vv.z & 0xffffu); vp[5 * VTP] = (bf16)(vv.z >> 16); vp[6 * VTP] = (bf16)(vv.w & 0xffffu); vp[7 * VTP] = (bf16)(vv.w >> 16); }
        __syncthreads();
        const int head = kvh * 8 + wid; const float sink2 = sinks[head] * LOG2E;
        bf16x8 qn[4];
        { const size_t tok0 = (size_t)b * SEQ + blk * 128 + q;
#pragma unroll
            for (int ks = 0; ks < 4; ++ks) qn[ks] = *(const GAS bf16x8*)(QKV + tok0 * ODD_IN + head * 64 + 16 * ks + 8 * hi); }
        for (int ci = 0; ci < 4; ++ci) {
            const int r0 = 32 * ci; const size_t tok = (size_t)b * SEQ + blk * 128 + r0 + q;
            bf16x8 qf[4];
#pragma unroll
            for (int ks = 0; ks < 4; ++ks) qf[ks] = qn[ks];
            if (ci < 3) {
#pragma unroll
                for (int ks = 0; ks < 4; ++ks) qn[ks] = *(const GAS bf16x8*)(QKV + (tok + 32) * ODD_IN + head * 64 + 16 * ks + 8 * hi); }
            f32x16 p[5];
#pragma unroll
            for (int jt = 0; jt < 5; ++jt) p[jt] = (f32x16){};
#pragma unroll
            for (int ks = 0; ks < 4; ++ks)
#pragma unroll
                for (int jt = 0; jt < 5; ++jt) { const bf16x8 kf = *(const LAS bf16x8*)(Kl + (2 * ks + hi) * 4096 + (r0 + 32 * jt + q) * 16); p[jt] = __builtin_amdgcn_mfma_f32_32x32x16_bf16(kf, qf[ks], p[jt], 0, 0, 0); }
            float mx = -INFINITY;
            if (blk == 0) {
#pragma unroll
                for (int jt = 0; jt < 5; ++jt)
#pragma unroll
                    for (int r = 0; r < 16; ++r) { const int j = r0 + 32 * jt + crow16(r, hi); const bool valid = (j >= r0 + q + 1) && (j <= r0 + q + 128) && (j >= 128);
                        p[jt][r] = valid ? p[jt][r] : -INFINITY; }
            } else {
#pragma unroll
                for (int r = 0; r < 16; ++r) { const int c = crow16(r, hi); p[0][r] = (c > q) ? p[0][r] : -INFINITY; p[4][r] = (c <= q) ? p[4][r] : -INFINITY; }
            }
#pragma unroll
            for (int jt = 0; jt < 5; ++jt)
#pragma unroll
                for (int r = 0; r < 16; ++r) mx = fmaxf(mx, p[jt][r]);
            mx = fmaxf(mx, __shfl_xor(mx, 32)); mx = fmaxf(mx, sink2);
            float l = 0.f;
#pragma unroll
            for (int jt = 0; jt < 5; ++jt)
#pragma unroll
                for (int r = 0; r < 16; ++r) { p[jt][r] = __builtin_amdgcn_exp2f(p[jt][r] - mx); l += p[jt][r]; }
            l += __shfl_xor(l, 32); l += __builtin_amdgcn_exp2f(sink2 - mx);
            f32x16 o[2]; o[0] = (f32x16){}; o[1] = (f32x16){};
#pragma unroll
            for (int jt = 0; jt < 5; ++jt)
#pragma unroll
                for (int kb = 0; kb < 2; ++kb) { v4u pw; pw.x = cvtpk(p[jt][8 * kb + 0], p[jt][8 * kb + 1]); pw.y = cvtpk(p[jt][8 * kb + 2], p[jt][8 * kb + 3]); pw.z = cvtpk(p[jt][8 * kb + 4], p[jt][8 * kb + 5]); pw.w = cvtpk(p[jt][8 * kb + 6], p[jt][8 * kb + 7]);
                    const bf16x8 pf = __builtin_bit_cast(bf16x8, pw);
#pragma unroll
                    for (int dt = 0; dt < 2; ++dt) { const bf16x8 vf = *(const LAS bf16x8*)(Vt + (32 * dt + q) * VTP + r0 + 32 * jt + 16 * kb + 8 * hi);
                        o[dt] = __builtin_amdgcn_mfma_f32_32x32x16_bf16(vf, pf, o[dt], 0, 0, 0); } }
            const float il = 1.f / l;
            bf16* op = ATT + tok * DMODEL + head * 64 + 8 * hi;
#pragma unroll
            for (int dt = 0; dt < 2; ++dt)
#pragma unroll
                for (int rp = 0; rp < 2; ++rp) {
                    v2u y, x; y.x = cvtpk(o[dt][8 * rp] * il, o[dt][8 * rp + 1] * il); y.y = cvtpk(o[dt][8 * rp + 2] * il, o[dt][8 * rp + 3] * il);
                    x.x = cvtpk(o[dt][8 * rp + 4] * il, o[dt][8 * rp + 5] * il); x.y = cvtpk(o[dt][8 * rp + 6] * il, o[dt][8 * rp + 7] * il);
                    const v2u snd = hi ? y : x;
                    v2u rcv; rcv.x = __shfl_xor(snd.x, 32); rcv.y = __shfl_xor(snd.y, 32);
                    v4u w; if (hi) { w.x = rcv.x; w.y = rcv.y; w.z = x.x; w.w = x.y; } else { w.x = y.x; w.y = y.y; w.z = rcv.x; w.w = rcv.y; }
                    *(GAS v4u*)(op + 32 * dt + 16 * rp) = w; }
        }
    }
}
#define RLX_AGENT __ATOMIC_RELAXED, __HIP_MEMORY_SCOPE_AGENT
#define XB_TMO      128
#define XB_XCNT(j)  (256  + 64 * (j))
#define XB_XSUB(j)  (1280 + 64 * (j))
#define XB_XGEN(j)  (2304 + 64 * (j))
#define XB_TOP      3328
#define XB_TOPGEN   3392
#define XCD_BAR_WORDS 3456
#define XB_SPIN_CAP (1u << 18)

__device__ __forceinline__ unsigned xb_ld(unsigned* p)              { return __hip_atomic_load(p, __ATOMIC_RELAXED, __HIP_MEMORY_SCOPE_AGENT); }
__device__ __forceinline__ unsigned xb_add(unsigned* p, unsigned v) { return __hip_atomic_fetch_add(p, v, __ATOMIC_RELAXED, __HIP_MEMORY_SCOPE_AGENT); }
__device__ __forceinline__ unsigned xb_xcc_id() { return (unsigned)__builtin_amdgcn_s_getreg((3 << 11) | 20) & 0xFu; }
#define XB_SPIN(cond, bar) do { unsigned _sp = 0; while (cond) { __builtin_amdgcn_s_sleep(1); \
    if ((++_sp & 255u) == 0u) { if (xb_ld(&(bar)[XB_TMO])) break; if (_sp > XB_SPIN_CAP) { atomicAdd(&(bar)[XB_TMO], 1u); break; } } } } while (0)

struct XcdBarrier {
    unsigned* bar; unsigned x;
    volatile LAS unsigned* st;
};

__device__ __forceinline__ XcdBarrier xcd_barrier_post(unsigned* bar, volatile LAS unsigned* st) {
    XcdBarrier b; b.bar = bar; b.x = xb_xcc_id(); b.st = st;
    if (threadIdx.x == 0) (void)xb_add(&bar[XB_XCNT(b.x)], 1u);
    return b;
}
__device__ __forceinline__ void xcd_barrier_complete(unsigned* bar, unsigned x, unsigned& nloc, unsigned& nx) {
    const unsigned G = gridDim.x * gridDim.y * gridDim.z;
    unsigned sum, cnt, mine, sp = 0u;
    for (;;) {
        sum = 0u; cnt = 0u; mine = 0u;
#pragma unroll
        for (unsigned j = 0; j < 16; ++j) { const unsigned c = xb_ld(&bar[XB_XCNT(j)]); sum += c; cnt += (c > 0u) ? 1u : 0u; mine = (j == x) ? c : mine; }
        if (sum == G) break;
        __builtin_amdgcn_s_sleep(1);
        if ((++sp & 255u) == 0u) { if (xb_ld(&bar[XB_TMO])) break; if (sp > XB_SPIN_CAP) { atomicAdd(&bar[XB_TMO], 1u); break; } }
    }
    nloc = mine > 0u ? mine : 1u; nx = cnt > 0u ? cnt : 1u;
}

__device__ __forceinline__ void xcd_barrier(const XcdBarrier& b) {
    asm volatile("s_waitcnt vmcnt(0)" ::: "memory");
    __syncthreads();
    if (threadIdx.x == 0) {
        unsigned* bar = b.bar;
        __builtin_amdgcn_s_waitcnt(0);
        unsigned nloc = b.st[0], nx = b.st[1];
        if (nloc == 0u) { xcd_barrier_complete(bar, b.x, nloc, nx); b.st[0] = nloc; b.st[1] = nx; }
        const unsigned old = xb_add(&bar[XB_XSUB(b.x)], 1u);
        const unsigned gen = old / nloc;
        if (old + 1u == (gen + 1u) * nloc) {
            __builtin_amdgcn_fence(__ATOMIC_RELEASE, "agent");
            asm volatile("s_waitcnt vmcnt(0)" ::: "memory");
            const unsigned og = xb_add(&bar[XB_TOP], 1u);
            const unsigned tg = og / nx;
            if (og + 1u == (tg + 1u) * nx) xb_add(&bar[XB_TOPGEN], 1u);
            else XB_SPIN(xb_ld(&bar[XB_TOPGEN]) == tg, bar);
            __builtin_amdgcn_fence(__ATOMIC_ACQUIRE, "agent");
            xb_add(&bar[XB_XGEN(b.x)], 1u);
            asm volatile("s_waitcnt vmcnt(0)" ::: "memory");
        } else {
            XB_SPIN(xb_ld(&bar[XB_XGEN(b.x)]) == gen, bar);
            __builtin_amdgcn_fence(__ATOMIC_ACQUIRE, "agent");
            asm volatile("s_waitcnt vmcnt(0)" ::: "memory");
        }
    }
    __syncthreads();
}
__global__ void __launch_bounds__(NWAVES * 64, 2) fwd_kernel(Args a) {
    extern __shared__ __attribute__((aligned(16))) unsigned char lds_raw[];
    cg::grid_group grid = cg::this_grid();
    LAS unsigned char* lds = (LAS unsigned char*)lds_raw;
    const int tid = threadIdx.x, lane = tid & 63, wave = __builtin_amdgcn_readfirstlane(tid >> 6);
    const int G = gridDim.x, bx = blockIdx.x, vcu = (G % 8 == 0) ? (bx % 8) * (G / 8) + bx / 8 : bx;
    const int gw = vcu * NWAVES + wave, NGW = G * NWAVES;
    unsigned char* ws = a.ws;
    bf16* Win_t = (bf16*)(ws + WS_WIN); bf16* Wout_t = (bf16*)(ws + WS_WOUT); bf16* Wqkv_t = (bf16*)(ws + WS_WQKV); bf16* Wo_t = (bf16*)(ws + WS_WO);
    bf16* W1_t = (bf16*)(ws + WS_W1); bf16* W2_t = (bf16*)(ws + WS_W2);
    float* cs = (float*)(ws + WS_CS); float* bqkv_p = (float*)(ws + WS_BQKV);
    bf16* XB = (bf16*)(ws + WS_XN); bf16* A2 = (bf16*)(ws + WS_A2); bf16* H = (bf16*)(ws + WS_H); float* RS = (float*)(ws + WS_RS); bf16* PROJ = (bf16*)(ws + WS_PROJ); bf16* ATT = (bf16*)(ws + WS_ATT); bf16* HF = (bf16*)(ws + WS_HF);

    unsigned* barw = (unsigned*)(ws + WS_BAR);
    volatile LAS unsigned* MISC = (volatile LAS unsigned*)(lds + MISC_OFF);
    if (tid < 32) MISC[tid] = 0u;
    if (bx == 0) for (int i = tid; i < XCD_BAR_WORDS; i += NWAVES * 64) barw[i] = 0u;
    {
        LAS float* scr = (LAS float*)(lds + wave * 16384);
        constexpr int I_IN = 16 * 96, I_SQ = 16 * 32, I_QKV = 16 * 40, I_W1 = 16 * 128, I_W2 = 64 * 32;
        constexpr int NITEMS = I_IN + I_SQ + I_QKV + I_SQ + 2 * I_W1 + 2 * I_W2;
        for (int it = gw; it < NITEMS; it += NGW) {
            int r = it;
            if (r < I_IN) { p0_transpose_item(a.w_in, 1024, EVEN_IN, Win_t, scr, r, lane, 1536, 2560, a.npre_mix); continue; } r -= I_IN;
            if (r < I_SQ) { p0_transpose_item(a.w_out, 1024, 1024, Wout_t, scr, r, lane, 0, 0, nullptr); continue; } r -= I_SQ;
            if (r < I_QKV) { p0_transpose_item(a.w_qkv, 1024, ODD_IN, Wqkv_t, scr, r, lane, 0, 1152, a.npre_mix + 1024); continue; } r -= I_QKV;
            if (r < I_SQ) { p0_transpose_item(a.w_o, 1024, 1024, Wo_t, scr, r, lane, 0, 0, nullptr); continue; } r -= I_SQ;
            if (r < I_W1) { p0_transpose_item(a.w1, 1024, FF, W1_t, scr, r, lane, 0, 0, a.npre_mlp); continue; } r -= I_W1;
            if (r < I_W1) { p0_transpose_item(a.w1 + (size_t)1024 * FF, 1024, FF, W1_t + (size_t)1024 * FF, scr, r, lane, 0, 0, a.npre_mlp + 1024); continue; } r -= I_W1;
            if (r < I_W2) { p0_transpose_item(a.w2, FF, 1024, W2_t, scr, r, lane, 0, 0, nullptr); continue; } r -= I_W2;
            p0_transpose_item(a.w2 + (size_t)1024 * FF, FF, 1024, W2_t + (size_t)1024 * FF, scr, r, lane, 0, 0, nullptr);
        }
        const int gtid = vcu * (NWAVES * 64) + tid, nthr = G * NWAVES * 64;
        for (int i = gtid; i < ODD_IN; i += nthr) bqkv_p[i] = a.b_qkv[i < 1152 ? mapcol(i) : i];
        for (int row = gtid; row < M; row += nthr) { const float pf = (float)a.pos[row];
#pragma unroll
            for (int i = 0; i < 8; ++i) { const float ang = pf * a.inv_freq[i]; const double t = (double)ang * 0.15915494309189535; const float fr = (float)(t - floor(t));
                cs[(size_t)row * 16 + 2 * i] = __builtin_amdgcn_cosf(fr); cs[(size_t)row * 16 + 2 * i + 1] = __builtin_amdgcn_sinf(fr); } }
        for (int m = gw * 4; m < M; m += NGW * 4) x_rows_to_bf16<4>(a.x, XB, RS, m, lane);
    }
    grid.sync();
    const XcdBarrier bar = xcd_barrier_post(barw, MISC + 8);
#define GRID_BAR() xcd_barrier(bar)

    {
        pg8::Gemm g{XB, Win_t, M, EVEN_IN, 1024};
        pg8::StaticOrder S; S.init(M, EVEN_IN, G, bx);
        pg8::EpiInProj E{{PROJ, EVEN_IN, nullptr, cs, 1536, 2048, 2048, 2560, C2, RS, 0}, {PROJ, EVEN_IN, RS}};
        pg8::gemm_phase<pg8::EpiInProj, pg8::StaticOrder, true, true>(lds, g, S, E);
    }
    GRID_BAR();
    {
        for (int p = vcu; p < BATCH * 16 * 8; p += G) {
            const int bvh = p >> 3, s = p & 7, b = bvh >> 4, vh = bvh & 15, h = vh >> 2, c = (vh >> 1) & 1, half = vh & 1;
            const attn_body::bf16* Q = (const attn_body::bf16*)PROJ + 1536 + (h * 2 + c) * 64;
            const attn_body::bf16* K = (const attn_body::bf16*)PROJ + 2048 + (h * 2 + c) * 64;
            const attn_body::bf16* V = (const attn_body::bf16*)PROJ + 2560 + h * 128 + half * 64;
            attn_body::bf16* O = (attn_body::bf16*)ATT + vh * 64;
            attn_body::attn_unit<8>(b, 15 - s, Q, K, V, O, (char*)lds_raw);
            attn_body::attn_unit<8>(b, s, Q, K, V, O, (char*)lds_raw);
        }
    }
    GRID_BAR();
    {
        const float s1 = wave_sum(a.lq1[lane] * a.lk1[lane]), s2 = wave_sum(a.lq2[lane] * a.lk2[lane]);
        const float lam = expf(s1) - expf(s2) + LAM_INIT0;
        mix_pass(gw, NGW, lane, PROJ, ATT, A2, a.conv_w, a.subln, lam);
    }
    GRID_BAR();
    {
        pg8::Gemm g{A2, Wout_t, M, 1024, 1024}; pg8::StaticOrder S; S.init(M, 1024, G, bx);
        pg8::EpiX<0> E{H, 1024, nullptr, nullptr, 0, 0, 0, 0, 1.f, nullptr, 0};
        pg8::gemm_phase<pg8::EpiX<0>, pg8::StaticOrder, true, true>(lds, g, S, E);
    }
    GRID_BAR();
    nr_pass<4>(gw, NGW, lane, H, XB, a.npost_mix, RS, nullptr);
    GRID_BAR();
#define MLP_PHASES(l) \
    {     \
        pg8::Gemm g{XB, W1_t + (size_t)(l) * 1024 * FF, M, FF, 1024}; pg8::StaticOrder S; S.init(M, FF, G, bx); \
        pg8::EpiX<1> E{HF, FF, nullptr, nullptr, 0, 0, 0, 0, 1.f, RS, 16}; \
        pg8::gemm_phase<pg8::EpiX<1>, pg8::StaticOrder, true, true>(lds, g, S, E); \
    } \
    GRID_BAR(); \
    {     \
        pg8::Gemm g{HF, W2_t + (size_t)(l) * 1024 * FF, M, 1024, FF}; pg8::RevOrder S; S.so.init(M, 1024, G, bx); S.nrounds = (S.so.nwg + G - 1) / G; \
        pg8::EpiX<0> E{H, 1024, nullptr, nullptr, 0, 0, 0, 0, 1.f, nullptr, 0}; \
        pg8::gemm_phase<pg8::EpiX<0>, pg8::RevOrder, true, true, true>(lds, g, S, E); \
    } \
    GRID_BAR();
    MLP_PHASES(0)
    nr_pass<4>(gw, NGW, lane, H, XB, a.npost_mlp, RS, nullptr);
    GRID_BAR();
    {
        pg8::Gemm g{XB, Wqkv_t, M, ODD_IN, 1024}; pg8::StaticOrder S; S.init(M, ODD_IN, G, bx);
        pg8::EpiX<2> E{PROJ, ODD_IN, bqkv_p, cs, 0, 1024, 1024, 1152, C2, RS, 0};
        pg8::gemm_phase<pg8::EpiX<2>, pg8::StaticOrder, true, true>(lds, g, S, E);
    }
    GRID_BAR();
    swa_phase(vcu, G, lds, PROJ, a.sinks, ATT);
    GRID_BAR();
    {
        pg8::Gemm g{ATT, Wo_t, M, 1024, 1024}; pg8::StaticOrder S; S.init(M, 1024, G, bx);
        pg8::EpiX<0> E{H, 1024, a.b_o, nullptr, 0, 0, 0, 0, 1.f, nullptr, 0};
        pg8::gemm_phase<pg8::EpiX<0>, pg8::StaticOrder, true, true>(lds, g, S, E);
    }
    GRID_BAR();
    nr_pass<4>(gw, NGW, lane, H, XB, a.npost_mix + 1024, RS, nullptr);
    GRID_BAR();
    MLP_PHASES(1)
    nr_pass<4>(gw, NGW, lane, H, XB, a.npost_mlp + 1024, nullptr, a.out);
#undef MLP_PHASES
}

extern "C" void kernel_launch(void* const* d_in, const int* in_sizes, int n_in, void* d_out, int out_size, void* d_ws, size_t ws_size, hipStream_t stream) {
    static int grid_blocks = 0;
    if (grid_blocks == 0) {
        if (n_in != 21 || in_sizes[0] != M * DMODEL || out_size != M * DMODEL || ws_size < WS_END) { fprintf(stderr, "kernel_launch: unexpected problem shape / workspace (n_in %d, ws %zu)\n", n_in, ws_size); grid_blocks = -1; return; }
        int dev = 0, cus = 0, per_cu = 0;
        if (hipGetDevice(&dev) != hipSuccess || hipDeviceGetAttribute(&cus, hipDeviceAttributeMultiprocessorCount, dev) != hipSuccess) { grid_blocks = -1; return; }
        if (hipFuncSetAttribute((const void*)fwd_kernel, hipFuncAttributeMaxDynamicSharedMemorySize, LDS_BYTES) != hipSuccess) { fprintf(stderr, "kernel_launch: hipFuncSetAttribute failed\n"); grid_blocks = -1; return; }
        if (hipOccupancyMaxActiveBlocksPerMultiprocessor(&per_cu, (const void*)fwd_kernel, NWAVES * 64, LDS_BYTES) != hipSuccess || per_cu < 1) { fprintf(stderr, "kernel_launch: occupancy query says %d blocks per CU\n", per_cu); grid_blocks = -1; (void)hipGetLastError(); return; }
        grid_blocks = cus;
    }
    if (grid_blocks < 0) return;
    Args a{};
    a.x = (const float*)d_in[0]; a.pos = (const int*)d_in[1];
    a.npre_mix = (const float*)d_in[2]; a.npost_mix = (const float*)d_in[3]; a.npre_mlp = (const float*)d_in[4]; a.npost_mlp = (const float*)d_in[5];
    a.w_in = (const float*)d_in[6]; a.conv_w = (const float*)d_in[7]; a.lq1 = (const float*)d_in[8]; a.lk1 = (const float*)d_in[9]; a.lq2 = (const float*)d_in[10]; a.lk2 = (const float*)d_in[11];
    a.subln = (const float*)d_in[12]; a.w_out = (const float*)d_in[13]; a.w_qkv = (const float*)d_in[14]; a.b_qkv = (const float*)d_in[15]; a.sinks = (const float*)d_in[16];
    a.w_o = (const float*)d_in[17]; a.b_o = (const float*)d_in[18]; a.w1 = (const float*)d_in[19]; a.w2 = (const float*)d_in[20];
    a.out = (float*)d_out; a.ws = (unsigned char*)d_ws;
    for (int i = 0; i < 8; ++i) a.inv_freq[i] = (float)pow(500000.0, -(double)i / 8.0);
    void* args[] = {&a};
    hipError_t e = hipLaunchCooperativeKernel((const void*)fwd_kernel, dim3(grid_blocks), dim3(NWAVES * 64), args, LDS_BYTES, stream);
    if (e != hipSuccess) fprintf(stderr, "kernel_launch: cooperative launch failed: %s (grid %d)\n", hipGetErrorString(e), grid_blocks);
}
```

```cpp
#include <hip/hip_runtime.h>
#include <hip/hip_cooperative_groups.h>
#include <cstdio>
#include <cstdint>
#include <cmath>
namespace cg = cooperative_groups;
namespace pg8 {
#define PG8_LAS __attribute__((address_space(3)))
typedef unsigned short bf16_t;
typedef short bf16x8 __attribute__((ext_vector_type(8)));
typedef float f32x4 __attribute__((ext_vector_type(4)));
typedef unsigned u32x4 __attribute__((ext_vector_type(4)));
constexpr int BM = 256, BK = 64, HALF = 128, HTB = HALF * BK * 2  , STAGE_BYTES = 8 * HTB, NXCD = 8, WGM = 8;

__host__ __device__ __forceinline__ int lds_byte(int r, int c) { const int st = (r >> 4) * 2 + (c >> 5), rr = r & 15, cc = c & 31, ob = rr * 64 + cc * 2; return st * 1024 + (ob ^ (((ob >> 9) & 1) << 5)); }
__host__ __device__ __forceinline__ void stage_rc(int b, int& R, int& C) { const int st = b / 1024, sb = b % 1024, swz = sb ^ (((sb >> 9) & 1) << 5); R = (st >> 1) * 16 + swz / 64; C = (st & 1) * 32 + (swz % 64) / 2; }
__host__ __device__ __forceinline__ int perm32(int rho) { const int n = rho >> 4, i = rho & 15; return 8 * (i >> 2) + 4 * n + (i & 3); }

struct Unit { int pm, pn; };
struct Gemm { const bf16_t* A; const bf16_t* Bt; int M, N, K; };

struct StaticOrder {
    int nM, nN, nwg, G, c;
    __host__ __device__ void init(int M, int N, int G_, int c_) { nM = M / BM; nN = N / BM; nwg = nM * nN; G = G_; c = c_; }
    __host__ __device__ bool next(int i, Unit& u) const {
        const long L = (long)i * G + c; if (L >= nwg) return false;
        int wgid = (int)L; { const int q = nwg / NXCD, r = nwg % NXCD, xcd = wgid % NXCD, off = wgid / NXCD; wgid = (xcd < r ? xcd * (q + 1) : r * (q + 1) + (xcd - r) * q) + off; }
        const int nig = WGM * nN, gid = wgid / nig, fm = gid * WGM, gsz = (nM - fm) < WGM ? (nM - fm) : WGM;
        u.pm = fm + ((wgid % nig) % gsz); u.pn = (wgid % nig) / gsz; return true;
    }
    __device__ __forceinline__ void a_ready(const Unit&) const {}
    __device__ __forceinline__ void done(const Unit&) const {}
};

__device__ __forceinline__ unsigned cvt_pk_bf16(float lo, float hi) { unsigned r; asm volatile("v_cvt_pk_bf16_f32 %0, %1, %2" : "=v"(r) : "v"(lo), "v"(hi)); return r; }
typedef float f32x2 __attribute__((ext_vector_type(2)));
struct RevOrder {
    StaticOrder so; int nrounds;
    __host__ __device__ bool next(int i, Unit& u) const { return i < nrounds && so.next(nrounds - 1 - i, u); }
    __device__ __forceinline__ void a_ready(const Unit&) const {}
    __device__ __forceinline__ void done(const Unit&) const {}
};
template <int MODE> struct EpiX {
    static constexpr bool PERM = true, AFTER_DRAIN = false;
    bf16_t* O; int ldc; const float* bias; const float* cs; int q_lo, q_hi, k_lo, k_hi; float qscale; const float* rs; int blk;
    __device__ __forceinline__ void operator()(const f32x4 (&acc)[2][2][4][2], const Unit& u, int wr, int wc, int fr, int fq) const {
        const int row0 = u.pm * BM + wr * 64 + fr; const int col0 = u.pn * BM + wc * 32 + 8 * fq;
        f32x4 bv[2][2];
#pragma unroll
        for (int bj = 0; bj < 2; ++bj)
#pragma unroll
            for (int n = 0; n < 2; ++n) bv[bj][n] = bias ? *(const f32x4*)(bias + col0 + bj * HALF + 4 * n) : (f32x4){0.f, 0.f, 0.f, 0.f};
        const bool ropelane = (MODE == 2) && ((wc & 1) == 0) && (fq < 2);
#pragma unroll
        for (int ai = 0; ai < 2; ++ai)
#pragma unroll
            for (int m = 0; m < 4; ++m) { const int row = row0 + ai * HALF + m * 16; bf16_t* rowp = blk ? O + ((size_t)u.pm * blk + u.pn) * 65536 + (size_t)(row - u.pm * BM) * 256 + (col0 - u.pn * BM) : O + (size_t)row * ldc + col0;
                const float rsv = rs ? rs[row] : 1.0f;
                f32x4 c01 = (f32x4){1.f, 0.f, 1.f, 0.f}, c23 = (f32x4){1.f, 0.f, 1.f, 0.f};
                if (MODE == 2) { if (ropelane) { const float* cp = cs + (size_t)row * 16 + fq * 8; c01 = *(const f32x4*)cp; c23 = *(const f32x4*)(cp + 4); } }
#pragma unroll
                for (int bj = 0; bj < 2; ++bj) { f32x4 v0 = acc[ai][bj][m][0] * rsv + bv[bj][0], v1 = acc[ai][bj][m][1] * rsv + bv[bj][1];
                    if (MODE == 1) { v0 = __builtin_elementwise_max(v0, (f32x4){0.f, 0.f, 0.f, 0.f}); v1 = __builtin_elementwise_max(v1, (f32x4){0.f, 0.f, 0.f, 0.f}); v0 = v0 * v0; v1 = v1 * v1; }
                    if (MODE == 2) { const int cb = u.pn * BM + bj * HALF + wc * 32; const bool isq = cb >= q_lo && cb < q_hi, isk = cb >= k_lo && cb < k_hi;
                        if (ropelane && (isq || isk)) {
                            f32x4 r0, r1;
                            r0[0] = v0[0] * c01[0] - v0[1] * c01[1]; r0[1] = v0[1] * c01[0] + v0[0] * c01[1];
                            r0[2] = v0[2] * c01[2] - v0[3] * c01[3]; r0[3] = v0[3] * c01[2] + v0[2] * c01[3];
                            r1[0] = v1[0] * c23[0] - v1[1] * c23[1]; r1[1] = v1[1] * c23[0] + v1[0] * c23[1];
                            r1[2] = v1[2] * c23[2] - v1[3] * c23[3]; r1[3] = v1[3] * c23[2] + v1[2] * c23[3];
                            v0 = r0; v1 = r1; }
                        if (isq) { v0 = v0 * qscale; v1 = v1 * qscale; } }
                    u32x4 w; w.x = cvt_pk_bf16(v0[0], v0[1]); w.y = cvt_pk_bf16(v0[2], v0[3]); w.z = cvt_pk_bf16(v1[0], v1[1]); w.w = cvt_pk_bf16(v1[2], v1[3]);
                    *(u32x4*)(rowp + bj * HALF) = w; } }
    }
};
struct EpiU {
    static constexpr bool PERM = true, AFTER_DRAIN = false;
    bf16_t* O; int ldc; const float* rs;
    __device__ __forceinline__ void operator()(const f32x4 (&acc)[2][2][4][2], const Unit& u, int wr, int wc, int fr, int fq) const {
        const int row0 = u.pm * BM + wr * 64 + fr; bf16_t* base = O + 512 + (u.pn - 2) * 128 + wc * 32 + 8 * fq;
#pragma unroll
        for (int ai = 0; ai < 2; ++ai)
#pragma unroll
            for (int m = 0; m < 4; ++m) { const int row = row0 + ai * HALF + m * 16; const float r2 = rs[row] * rs[row];
                const f32x4 p0 = acc[ai][0][m][0] * acc[ai][1][m][0] * r2, p1 = acc[ai][0][m][1] * acc[ai][1][m][1] * r2;
                u32x4 w; w.x = cvt_pk_bf16(p0[0], p0[1]); w.y = cvt_pk_bf16(p0[2], p0[3]); w.z = cvt_pk_bf16(p1[0], p1[1]); w.w = cvt_pk_bf16(p1[2], p1[3]);
                *(u32x4*)(base + (size_t)row * ldc) = w; }
    }
};
struct EpiInProj {
    static constexpr bool PERM = true, AFTER_DRAIN = false;
    EpiX<2> ex; EpiU eu;
    __device__ __forceinline__ void operator()(const f32x4 (&acc)[2][2][4][2], const Unit& u, int wr, int wc, int fr, int fq) const {
        if (u.pn >= 2 && u.pn < 6) eu(acc, u, wr, wc, fr, fq); else ex(acc, u, wr, wc, fr, fq);
    }
};
struct SubsetOrder {
    StaticOrder so; int keep, skip;
    __host__ __device__ bool next(int i, Unit& u) const { if (!so.next(i, u)) return false; if (u.pn >= keep) u.pn += skip; return true; }
    __device__ __forceinline__ void a_ready(const Unit&) const {}
    __device__ __forceinline__ void done(const Unit&) const {}
};
template <class Epi, class Sched, bool ALIGN_EPI = false, bool SP2 = false, bool ABLK = false>
__device__ __forceinline__ void gemm_phase(PG8_LAS unsigned char* lds, const Gemm g, const Sched& S, const Epi& E) {
    int tid_ = threadIdx.x; asm volatile("" : "+v"(tid_));
    const int tid = tid_, wid = __builtin_amdgcn_readfirstlane(tid >> 6), lane = tid & 63, wr = wid >> 2, wc = wid & 3, fr = lane & 15, fq = lane >> 4;
    const int K = g.K, nt = K / BK;
    unsigned voffA[2], voffB[2];
#pragma unroll
    for (int i = 0; i < 2; ++i) { int R, C; stage_rc(tid * 16 + i * 8192, R, C); const int Rb = Epi::PERM ? ((R & ~31) + perm32(R & 31)) : R;
        voffA[i] = (unsigned)(R * (ABLK ? 256 : K) + C) * 2u; voffB[i] = (unsigned)(Rb * K + C) * 2u; }
    const size_t kstep = (size_t)(BK * 2);
    const size_t hstep = (size_t)HALF * K * 2;
    const size_t tstep = 2 * hstep;
    const size_t hstepA = ABLK ? (size_t)HALF * 256 * 2 : hstep;
#define PG8_KA(t) (ABLK ? ((size_t)((t) >> 2) * 131072 + (size_t)(((t) >> 1) & 1) * 256) : (size_t)(t) * kstep)
    const unsigned ldsw = (unsigned)wid * 1024u;
    const int aoff = lds_byte(wr * 64 + fr, fq * 8), boff = lds_byte(wc * 32 + fr, fq * 8);
#define PG8_SA(b, h) (((b) * 2 + (h)) * HTB)
#define PG8_SB(b, h) ((4 + (b) * 2 + (h)) * HTB)
#define PG8_STAGE(bufoff, gbase, voff) do { _Pragma("unroll") for (int _i = 0; _i < 2; ++_i) \
        __builtin_amdgcn_global_load_lds((const unsigned*)((const char*)(gbase) + (voff)[_i]), (PG8_LAS unsigned*)(lds + (bufoff) + ldsw + _i * 8192), 16, 0, 0); } while (0)
#define PG8_LDA(dst, b, h) do { _Pragma("unroll") for (int m = 0; m < 4; ++m) _Pragma("unroll") for (int k = 0; k < 2; ++k) dst[m][k] = *(const PG8_LAS bf16x8*)(lds + PG8_SA(b, h) + aoff + m * 2048 + k * 1024); } while (0)
#define PG8_LDB(dst, b, h) do { _Pragma("unroll") for (int n = 0; n < 2; ++n) _Pragma("unroll") for (int k = 0; k < 2; ++k) dst[n][k] = *(const PG8_LAS bf16x8*)(lds + PG8_SB(b, h) + boff + n * 2048 + k * 1024); } while (0)
#define PG8_MMA(ai, bj, At, Bt) do { __builtin_amdgcn_s_setprio(1); _Pragma("unroll") for (int m = 0; m < 4; ++m) _Pragma("unroll") for (int n = 0; n < 2; ++n) _Pragma("unroll") for (int k = 0; k < 2; ++k) \
        acc[ai][bj][m][n] = __builtin_amdgcn_mfma_f32_16x16x32_bf16(Bt[n][k], At[m][k], acc[ai][bj][m][n], 0, 0, 0); __builtin_amdgcn_s_setprio(0); } while (0)
#define PG8_WAIT_V(n) asm volatile("s_waitcnt vmcnt(" #n ")" ::: "memory")
#define PG8_WAIT_L(n) asm volatile("s_waitcnt lgkmcnt(" #n ")" ::: "memory")
#define PG8_BAR __builtin_amdgcn_s_barrier()
#define PG8_SCHED __builtin_amdgcn_sched_barrier(0)
    Unit cur, nxt; int ui = 0;
    if (!S.next(0, cur)) return;
    f32x4 acc[2][2][4][2];
#pragma unroll
    for (int a = 0; a < 2; ++a)
#pragma unroll
        for (int b = 0; b < 2; ++b)
#pragma unroll
            for (int m = 0; m < 4; ++m)
#pragma unroll
                for (int n = 0; n < 2; ++n) acc[a][b][m][n] = (f32x4){0.f, 0.f, 0.f, 0.f};
    bf16x8 At[4][2], B0[2][2], B1[2][2];
    const char* cA = (const char*)g.A + (size_t)cur.pm * tstep; const char* cB = (const char*)g.Bt + (size_t)cur.pn * tstep;
    S.a_ready(cur);
    if constexpr (SP2) {
        PG8_STAGE(PG8_SB(0, 0), cB, voffB); PG8_STAGE(PG8_SB(0, 1), cB + hstep, voffB); PG8_STAGE(PG8_SA(0, 0), cA, voffA); PG8_STAGE(PG8_SA(0, 1), cA + hstepA, voffA);
        if (wr == 1) PG8_BAR;
        PG8_WAIT_V(2); PG8_BAR;
        PG8_STAGE(PG8_SB(1, 0), cB + kstep, voffB); PG8_STAGE(PG8_SA(1, 0), cA + kstep, voffA); PG8_STAGE(PG8_SB(1, 1), cB + hstep + kstep, voffB);
        PG8_WAIT_V(6); PG8_BAR;
    } else {
        PG8_STAGE(PG8_SB(0, 0), cB, voffB); PG8_STAGE(PG8_SA(0, 0), cA, voffA); PG8_STAGE(PG8_SB(0, 1), cB + hstep, voffB); PG8_STAGE(PG8_SA(0, 1), cA + hstepA, voffA);
        if (wr == 1) PG8_BAR;
        PG8_WAIT_V(4); PG8_BAR;
        PG8_STAGE(PG8_SB(1, 0), cB + kstep, voffB); PG8_STAGE(PG8_SA(1, 0), cA + kstep, voffA); PG8_STAGE(PG8_SB(1, 1), cB + hstep + kstep, voffB);
        PG8_WAIT_V(6); PG8_BAR;
    }
    for (;;) {
        const bool has_next = S.next(ui + 1, nxt);
        const char* nA = has_next ? (const char*)g.A + (size_t)nxt.pm * tstep : cA; const char* nB = has_next ? (const char*)g.Bt + (size_t)nxt.pn * tstep : cB;
        for (int t = 0; t < nt; t += 2) {
            const bool last = (t == nt - 2);
            const char* a1 = cA + PG8_KA(t) + kstep;
            const char* a2 = last ? nA : cA + PG8_KA(t + 2); const char* b2 = last ? nB : cB + (size_t)(t + 2) * kstep;
            const char* a3 = a2 + kstep; const char* b3 = b2 + kstep;
            if (last && has_next) S.a_ready(nxt);
            if constexpr (SP2) {
            PG8_LDB(B0, 0, 0); PG8_LDB(B1, 0, 1); PG8_SCHED; PG8_LDA(At, 0, 0); PG8_STAGE(PG8_SA(1, 1), a1 + hstepA, voffA);
            PG8_WAIT_V(8); PG8_WAIT_L(0); PG8_BAR; PG8_MMA(0, 0, At, B0); PG8_MMA(0, 1, At, B1); PG8_BAR; PG8_SCHED;
            PG8_LDA(At, 0, 1); PG8_STAGE(PG8_SB(0, 0), b2, voffB); PG8_STAGE(PG8_SB(0, 1), b2 + hstep, voffB); PG8_STAGE(PG8_SA(0, 0), a2, voffA);
            PG8_WAIT_V(8); PG8_WAIT_L(0); PG8_BAR; PG8_MMA(1, 0, At, B0); PG8_MMA(1, 1, At, B1); PG8_BAR; PG8_SCHED;
            PG8_LDB(B0, 1, 0); PG8_LDB(B1, 1, 1); PG8_SCHED; PG8_LDA(At, 1, 0); PG8_STAGE(PG8_SA(0, 1), a2 + hstepA, voffA);
            PG8_WAIT_V(8); PG8_WAIT_L(0); PG8_BAR; PG8_MMA(0, 0, At, B0); PG8_MMA(0, 1, At, B1); PG8_BAR; PG8_SCHED;
            PG8_LDA(At, 1, 1); PG8_STAGE(PG8_SB(1, 0), b3, voffB); PG8_STAGE(PG8_SB(1, 1), b3 + hstep, voffB); PG8_STAGE(PG8_SA(1, 0), a3, voffA);
            PG8_WAIT_V(8); PG8_WAIT_L(0); PG8_BAR; PG8_MMA(1, 0, At, B0); PG8_MMA(1, 1, At, B1); PG8_BAR; PG8_SCHED;
            } else {
            PG8_LDB(B0, 0, 0); PG8_SCHED; PG8_LDA(At, 0, 0); PG8_STAGE(PG8_SA(1, 1), a1 + hstepA, voffA);
            PG8_WAIT_L(8); PG8_BAR; PG8_WAIT_L(0); PG8_MMA(0, 0, At, B0); PG8_BAR; PG8_SCHED;
            PG8_LDB(B1, 0, 1); PG8_STAGE(PG8_SB(0, 0), b2, voffB);
            PG8_BAR; PG8_WAIT_L(0); PG8_MMA(0, 1, At, B1); PG8_BAR;
            PG8_LDA(At, 0, 1); PG8_STAGE(PG8_SA(0, 0), a2, voffA);
            PG8_BAR; PG8_WAIT_L(0); PG8_MMA(1, 0, At, B0); PG8_BAR; PG8_SCHED;
            PG8_STAGE(PG8_SB(0, 1), b2 + hstep, voffB);
            PG8_WAIT_V(6); PG8_BAR; PG8_MMA(1, 1, At, B1); PG8_BAR;
            PG8_LDB(B0, 1, 0); PG8_SCHED; PG8_LDA(At, 1, 0); PG8_STAGE(PG8_SA(0, 1), a2 + hstepA, voffA);
            PG8_WAIT_L(8); PG8_BAR; PG8_WAIT_L(0); PG8_MMA(0, 0, At, B0); PG8_BAR; PG8_SCHED;
            PG8_LDB(B1, 1, 1); PG8_STAGE(PG8_SB(1, 0), b3, voffB);
            PG8_BAR; PG8_WAIT_L(0); PG8_MMA(0, 1, At, B1); PG8_BAR;
            PG8_LDA(At, 1, 1); PG8_STAGE(PG8_SA(1, 0), a3, voffA);
            PG8_BAR; PG8_WAIT_L(0); PG8_MMA(1, 0, At, B0); PG8_BAR; PG8_SCHED;
            PG8_STAGE(PG8_SB(1, 1), b3 + hstep, voffB);
            PG8_WAIT_V(6); PG8_BAR; PG8_MMA(1, 1, At, B1); PG8_BAR;
            }
        }
        if constexpr (ALIGN_EPI) { if (wr == 0) PG8_BAR; }
        if constexpr (!Epi::AFTER_DRAIN) { E(acc, cur, wr, wc, fr, fq); S.done(cur); }
        if (!has_next) break;
#pragma unroll
        for (int a = 0; a < 2; ++a)
#pragma unroll
            for (int b = 0; b < 2; ++b)
#pragma unroll
                for (int m = 0; m < 4; ++m)
#pragma unroll
                    for (int n = 0; n < 2; ++n) acc[a][b][m][n] = (f32x4){0.f, 0.f, 0.f, 0.f};
        cur = nxt; cA = nA; cB = nB; ++ui;
        if constexpr (ALIGN_EPI) { if (wr == 1) PG8_BAR; }
    }
    PG8_WAIT_V(0);
    if constexpr (!ALIGN_EPI) { if (wr == 0) PG8_BAR; }
    PG8_BAR;
    if constexpr (Epi::AFTER_DRAIN) { E.fused(acc, cur, wr, wc, fr, fq, lds, wid, lane); S.done(cur); }
#undef PG8_KA
#undef PG8_SA
#undef PG8_SB
#undef PG8_STAGE
#undef PG8_LDA
#undef PG8_LDB
#undef PG8_MMA
#undef PG8_WAIT_V
#undef PG8_WAIT_L
#undef PG8_BAR
#undef PG8_SCHED
}
}
#include <hip/hip_bf16.h>
#include <cmath>
namespace attn_body {
using bf16=__hip_bfloat16;
using bf16x8=__attribute__((ext_vector_type(8)))short;
using s16x4=__attribute__((ext_vector_type(4)))short;
using f32x16=__attribute__((ext_vector_type(16)))float;
using u32x4=__attribute__((ext_vector_type(4)))unsigned;
constexpr int SEQ=4096,D=64,PQ=3072,PO=1024;
constexpr int NW=8,QBLK=32,QB=QBLK*NW,KVBLK=64,NQB=SEQ/QB;
constexpr int ATTN_UNIT_ROWS=QB;
__device__ __forceinline__ int crow(int r,int hi){return (r&3)+8*(r>>2)+4*hi;}
#define SBAR() __builtin_amdgcn_sched_barrier(0)
__device__ __forceinline__ void cmask(f32x16&p0,f32x16&p1,int jb,int qrel,int hi){
  const float NEG=-INFINITY; int kb=64*jb+4*hi;
  #pragma unroll
  for(int r=0;r<16;++r){int kv=kb+(r&3)+8*(r>>2); if(kv>qrel)p0[r]=NEG; if(kv+32>qrel)p1[r]=NEG;}
}

constexpr int NSLOT=3, SLOTB=8192;
constexpr int LDS_K=0, LDS_V=NSLOT*SLOTB, LDS_WS=2*NSLOT*SLOTB, LDS_OST=LDS_WS+NW*64*4, LDS_BYTES=LDS_OST+NW*4096;
constexpr float C2=0.125f*1.4426950408889634f;
__device__ __forceinline__ void glds16(const void*gsrc,unsigned lds_dst){unsigned keep;
  asm volatile("s_mov_b32 %0, m0\n\ts_mov_b32 m0, %2\n\ts_nop 0\n\tglobal_load_lds_dwordx4 %1, off\n\ts_mov_b32 m0, %0":"=&s"(keep):"v"(gsrc),"s"(lds_dst):"memory");}
__device__ __forceinline__ float max3f(float a,float b,float c){float r;asm("v_max3_f32 %0, %1, %2, %3":"=v"(r):"v"(a),"v"(b),"v"(c));return r;}
__device__ __forceinline__ float max2f(float a,float b){float r;asm("v_max_f32_e32 %0, %1, %2":"=v"(r):"v"(a),"v"(b));return r;}
__device__ __forceinline__ float fadd_s(float a,float b){float r;asm("v_add_f32_e32 %0, %1, %2":"=v"(r):"v"(a),"v"(b));return r;}
__device__ __forceinline__ float fsub_s(float a,float b){float r;asm("v_sub_f32_e32 %0, %1, %2":"=v"(r):"v"(a),"v"(b));return r;}
typedef float f32x2_t __attribute__((ext_vector_type(2))); typedef __bf16 bf16x2_t __attribute__((ext_vector_type(2)));
__device__ __forceinline__ unsigned cvtpk_s(float lo,float hi){f32x2_t v={lo,hi};bf16x2_t b=__builtin_convertvector(v,bf16x2_t);return __builtin_bit_cast(unsigned,b);}
#define WAIT_BAR(N) asm volatile("s_waitcnt vmcnt(" #N ") lgkmcnt(0)\n\ts_barrier":::"memory")

__device__ __forceinline__ void qkt(f32x16&p0,f32x16&p1,const char*Kslot,const bf16x8*qr,const f32x16&negm,int r32,int hi){
  const char*kb=Kslot+hi*1024+r32*16;
  #pragma unroll
  for(int d0=0;d0<4;++d0){
    const bf16x8 b0=*reinterpret_cast<const bf16x8*>(kb+d0*2048);
    const bf16x8 b1=*reinterpret_cast<const bf16x8*>(kb+d0*2048+512);
    if(d0==0){p0=__builtin_amdgcn_mfma_f32_32x32x16_bf16(b0,qr[0],negm,0,0,0);p1=__builtin_amdgcn_mfma_f32_32x32x16_bf16(b1,qr[0],negm,0,0,0);}
    else{p0=__builtin_amdgcn_mfma_f32_32x32x16_bf16(b0,qr[d0],p0,0,0,0);p1=__builtin_amdgcn_mfma_f32_32x32x16_bf16(b1,qr[d0],p1,0,0,0);}}
}
typedef __attribute__((address_space(3))) const char* lds_cptr;
typedef short v4i16_t __attribute__((ext_vector_type(4)));
__device__ __forceinline__ void kload8(bf16x8*kf,lds_cptr kp){
  kf[0]=*(const __attribute__((address_space(3))) bf16x8*)(kp);      kf[1]=*(const __attribute__((address_space(3))) bf16x8*)(kp+512);
  kf[2]=*(const __attribute__((address_space(3))) bf16x8*)(kp+2048); kf[3]=*(const __attribute__((address_space(3))) bf16x8*)(kp+2560);
  kf[4]=*(const __attribute__((address_space(3))) bf16x8*)(kp+4096); kf[5]=*(const __attribute__((address_space(3))) bf16x8*)(kp+4608);
  kf[6]=*(const __attribute__((address_space(3))) bf16x8*)(kp+6144); kf[7]=*(const __attribute__((address_space(3))) bf16x8*)(kp+6656);
}
__device__ __forceinline__ void kload2(bf16x8*kf,lds_cptr kp,int j){ kf[2*j]=*(const __attribute__((address_space(3))) bf16x8*)(kp+j*2048); kf[2*j+1]=*(const __attribute__((address_space(3))) bf16x8*)(kp+j*2048+512); }
__device__ __forceinline__ s16x4 vtr(lds_cptr p){ return __builtin_bit_cast(s16x4,__builtin_amdgcn_ds_read_tr16_b64_v4i16((__attribute__((address_space(3))) v4i16_t*)p)); }
__device__ __forceinline__ float rowmax(const f32x16&p0,const f32x16&p1){
  float a=max3f(p0[0],p0[1],p1[0]),b=max3f(p0[2],p0[3],p1[1]);a=max3f(a,p1[2],p1[3]);
  #pragma unroll
  for(int r=4;r<16;r+=4){a=max3f(a,p0[r],p0[r+1]);b=max3f(b,p0[r+2],p0[r+3]);a=max3f(a,p1[r],p1[r+1]);b=max3f(b,p1[r+2],p1[r+3]);}
  const float m=max2f(a,b);
  auto rr=__builtin_amdgcn_permlane32_swap(__float_as_uint(m),__float_as_uint(m),false,false);
  return max2f(__uint_as_float(rr[0]),__uint_as_float(rr[1]));
}
__device__ __forceinline__ void pv(f32x16*o,int vb,bf16x8 pa0,bf16x8 pa1,bf16x8 pa2,bf16x8 pa3){
  #pragma unroll
  for(int d0=0;d0<2;++d0){s16x4 lo[4],hi[4];
    #pragma unroll
    for(int ks=0;ks<4;++ks){
      asm volatile("ds_read_b64_tr_b16 %0,%1 offset:%c2":"=&v"(lo[ks]):"v"(vb),"i"(d0*4096+ks*1024):"memory");
      asm volatile("ds_read_b64_tr_b16 %0,%1 offset:%c2":"=&v"(hi[ks]):"v"(vb),"i"(d0*4096+ks*1024+512):"memory");}
    asm volatile("s_waitcnt lgkmcnt(0)":::"memory");SBAR();
    #define PK(k) (bf16x8){lo[k][0],lo[k][1],lo[k][2],lo[k][3],hi[k][0],hi[k][1],hi[k][2],hi[k][3]}
    o[d0]=__builtin_amdgcn_mfma_f32_32x32x16_bf16(pa0,PK(0),o[d0],0,0,0);
    o[d0]=__builtin_amdgcn_mfma_f32_32x32x16_bf16(pa1,PK(1),o[d0],0,0,0);
    o[d0]=__builtin_amdgcn_mfma_f32_32x32x16_bf16(pa2,PK(2),o[d0],0,0,0);
    o[d0]=__builtin_amdgcn_mfma_f32_32x32x16_bf16(pa3,PK(3),o[d0],0,0,0);
    #undef PK
  }
}

#ifndef ATTN_STORE16
#define ATTN_STORE16(p,v) (*(u32x4*)(p)=(v))
#endif
template<int THRL> __device__ __forceinline__ void attn_unit(int b,int qb,const bf16*Q,const bf16*__restrict__ K,const bf16*__restrict__ V,bf16*O,char*shm){
  int tid_=threadIdx.x; asm volatile("":"+v"(tid_)); const int tid=tid_,lane=tid&63,r32=lane&31,hi=lane>>5; const int wid=__builtin_amdgcn_readfirstlane(tid>>6);
  const long rowbase=(long)b*SEQ; const int q0=qb*QB;
  const bf16*Qw=Q+(rowbase+q0+wid*QBLK)*PQ;
  const bf16*Kh=K+rowbase*PQ,*Vh=V+rowbase*PQ;
  const unsigned lds0=(unsigned)(uintptr_t)shm;
  float*wsf=(float*)(shm+LDS_WS)+wid*64;
  const bf16*ksrc=Kh+(long)lane*PQ+wid*8;
  const bf16*vsrc=Vh+(long)(16*(wid&3)+(lane>>2))*PQ+(wid>>2)*32+(lane&3)*8;
  const unsigned kdst=lds0+LDS_K+wid*1024, vdst=lds0+LDS_V+wid*1024;
  #define DMA_K(t,slot) glds16(ksrc+(long)(t)*KVBLK*PQ,(unsigned)__builtin_amdgcn_readfirstlane(kdst+(slot)))
  #define DMA_V(t,slot) glds16(vsrc+(long)(t)*KVBLK*PQ,(unsigned)__builtin_amdgcn_readfirstlane(vdst+(slot)))
  const int vb0=(int)(lds0+LDS_V)+((lane>>4)&1)*32+(lane&3)*8+(4*hi+((lane&15)>>2))*64;
  const char*Kbase=shm+LDS_K; bf16x8 kf[8];
  const lds_cptr shm3=(lds_cptr)shm; const lds_cptr kp0=shm3+LDS_K+hi*1024+r32*16; const lds_cptr vp0=shm3+LDS_V+((lane>>4)&1)*32+(lane&3)*8+(4*hi+((lane&15)>>2))*64;
  const int NT=(q0+QB)/KVBLK;
  DMA_K(0,0);DMA_V(0,0);DMA_K(1,SLOTB);
  bf16x8 qr[4];
  #pragma unroll
  for(int d0=0;d0<4;++d0)qr[d0]=*reinterpret_cast<const bf16x8*>(&Qw[(long)r32*PQ+d0*16+hi*8]);
  float mhat=0.f,l_reg=0.f;f32x16 o[2];o[0]=f32x16{};o[1]=f32x16{};f32x16 negm=f32x16{};asm volatile("":"+v"(negm));
  const int qrel=wid*QBLK+r32;
  #define CMASK(P0,P1,t) do{int jb_=(t)-(NT-4); if(jb_>=0)cmask(P0,P1,jb_,qrel,hi);}while(0)
  bool resc=false;
  #define START(P0,P1) do{ const float rm=rowmax(P0,P1); resc=false; \
    { const float dl=rm; mhat=fadd_s(mhat,dl); \
      _Pragma("unroll") for(int r=0;r<16;++r){P0[r]=fsub_s(P0[r],dl);P1[r]=fsub_s(P1[r],dl);} \
      _Pragma("unroll") for(int r=0;r<16;++r)negm[r]=-mhat; asm volatile("":"+v"(negm)); } \
    _Pragma("unroll") for(int r=0;r<16;++r)P0[r]=__builtin_amdgcn_exp2f(P0[r]); }while(0)
  #define RESC() do{ if(resc){ asm volatile("s_waitcnt lgkmcnt(0)":::"memory"); \
      _Pragma("unroll") for(int d_=0;d_<2;++d_) _Pragma("unroll") for(int r=0;r<16;++r)o[d_][r]*=wsf[crow(r,hi)]; } }while(0)
  f32x16 pA0,pA1,pB0,pB1;
  int sl_prev=0,sl_cur=0,sl_next=SLOTB;
  #define ROT() do{sl_prev=sl_cur;sl_cur=sl_next;sl_next=(sl_next==(NSLOT-1)*SLOTB)?0:sl_next+SLOTB;}while(0)
  DMA_K(2,2*SLOTB);
  WAIT_BAR(3);
  qkt(pA0,pA1,Kbase,qr,negm,r32,hi);asm volatile("s_nop 15\n\ts_nop 7":"+v"(pA0),"+v"(pA1));CMASK(pA0,pA1,0);
  START(pA0,pA1);
  _Pragma("unroll") for(int r=0;r<16;++r)pA1[r]=__builtin_amdgcn_exp2f(pA1[r]);
  WAIT_BAR(0);
  DMA_K(3,0);DMA_V(1,SLOTB);
  ROT();
  kload8(kf,kp0+sl_cur);
  WAIT_BAR(2);
  s16x4 vlo[8],vhi[8]; u32x4 pw0,pw1,pw2,pw3;
  #define PKW(P,B) cvtpk_s(P[B],P[B+1])
  #define PAF(k) __builtin_bit_cast(bf16x8,pw##k)
  #define VFR(i) (bf16x8){vlo[i][0],vlo[i][1],vlo[i][2],vlo[i][3],vhi[i][0],vhi[i][1],vhi[i][2],vhi[i][3]}
  #define PIN(x) asm volatile("":"+v"(x))
  #define MX3(a,b,c) __builtin_fmaxf(__builtin_fmaxf((a),(b)),(c))
  #define GAPA(MF,A0,A1,A2,A3,W0,W1,PW) do{ MF; sacc+=A0; sacc+=A1; sacc+=A2; sacc+=A3; PIN(sacc); W0; W1; PIN(PW); SBAR(); }while(0)
  #define EX(v) __builtin_amdgcn_exp2f(v)
  #define GAPB(MF,X,B) do{ MF; X[B]=EX(X[B]); X[B+1]=EX(X[B+1]); X[B+2]=EX(X[B+2]); X[B+3]=EX(X[B+3]); PIN(X); SBAR(); }while(0)
  #define VRD(i) do{ vlo[i]=vtr(vp_+(((i)>>2)*4096+((i)&3)*1024)); vhi[i]=vtr(vp_+(((i)>>2)*4096+((i)&3)*1024+512)); }while(0)
  #define KRD(G,j) do{ if(G){ kload2(kf,kp0+sl_next,j); SBAR(); } }while(0)
  #define STEP(C0,C1,P0,P1,t,GK,GV,GL) do{ SBAR(); \
    const lds_cptr vp_=vp0+sl_prev; \
    VRD(0); SBAR(); float sacc=(P0[0]+P0[1]); \
    GAPA(C0=__builtin_amdgcn_mfma_f32_32x32x16_bf16(kf[0],qr[0],negm,0,0,0), P0[2],P0[3],P0[4],P0[5],     pw0[0]=PKW(P0,0), pw0[1]=PKW(P0,2), pw0); \
    VRD(4); SBAR(); GAPA(C1=__builtin_amdgcn_mfma_f32_32x32x16_bf16(kf[1],qr[0],negm,0,0,0), P0[6],P0[7],P0[8],P0[9],     pw0[2]=PKW(P0,4), pw0[3]=PKW(P0,6), pw0); \
    VRD(1); SBAR(); GAPA(C0=__builtin_amdgcn_mfma_f32_32x32x16_bf16(kf[2],qr[1],C0,0,0,0),   P0[10],P0[11],P0[12],P0[13], pw1[0]=PKW(P0,8), pw1[1]=PKW(P0,10), pw1); \
    VRD(5); SBAR(); GAPA(C1=__builtin_amdgcn_mfma_f32_32x32x16_bf16(kf[3],qr[1],C1,0,0,0),   P0[14],P0[15],P1[0],P1[1],   pw1[2]=PKW(P0,12),pw1[3]=PKW(P0,14), pw1); \
    VRD(2); SBAR(); GAPA(C0=__builtin_amdgcn_mfma_f32_32x32x16_bf16(kf[4],qr[2],C0,0,0,0),   P1[2],P1[3],P1[4],P1[5],     pw2[0]=PKW(P1,0), pw2[1]=PKW(P1,2), pw2); \
    VRD(6); SBAR(); GAPA(C1=__builtin_amdgcn_mfma_f32_32x32x16_bf16(kf[5],qr[2],C1,0,0,0),   P1[6],P1[7],P1[8],P1[9],     pw2[2]=PKW(P1,4), pw2[3]=PKW(P1,6), pw2); \
    VRD(3); SBAR(); GAPA(C0=__builtin_amdgcn_mfma_f32_32x32x16_bf16(kf[6],qr[3],C0,0,0,0),   P1[10],P1[11],P1[12],P1[13], pw3[0]=PKW(P1,8), pw3[1]=PKW(P1,10), pw3); \
    VRD(7); SBAR(); GAPA(C1=__builtin_amdgcn_mfma_f32_32x32x16_bf16(kf[7],qr[3],C1,0,0,0),   P1[14],P1[15],0.f,0.f,       pw3[2]=PKW(P1,12),pw3[3]=PKW(P1,14), pw3); \
    l_reg+=sacc; \
    if(GK){DMA_K((t)+3,sl_cur);} if(GV){DMA_V((t)+1,sl_next);} \
    CMASK(C0,C1,t); \
    { float a=MX3(C0[0],C0[1],C1[0]),b=MX3(C0[2],C0[3],C1[1]); a=MX3(a,C1[2],C1[3]); \
      _Pragma("unroll") for(int r=4;r<16;r+=4){a=MX3(a,C0[r],C0[r+1]);b=MX3(b,C0[r+2],C0[r+3]);a=MX3(a,C1[r],C1[r+1]);b=MX3(b,C1[r+2],C1[r+3]);} \
      float rm=__builtin_fmaxf(a,b); { auto rr=__builtin_amdgcn_permlane32_swap(__float_as_uint(rm),__float_as_uint(rm),false,false); rm=__builtin_fmaxf(__uint_as_float(rr[0]),__uint_as_float(rr[1])); } \
      resc=false; \
      if(__builtin_expect(__any(rm>(float)THRL),0)){ const float dl=__builtin_fmaxf(rm,0.f); mhat+=dl; \
        _Pragma("unroll") for(int r=0;r<16;++r){C0[r]-=dl;C1[r]-=dl;} \
        _Pragma("unroll") for(int r=0;r<16;++r)negm[r]=-mhat; asm volatile("":"+v"(negm)); \
        const float f=__builtin_amdgcn_exp2f(-dl); l_reg*=f; if(hi==0)wsf[r32]=f; resc=true; } } \
    SBAR(); \
    GAPB(o[0]=__builtin_amdgcn_mfma_f32_32x32x16_bf16(PAF(0),VFR(0),o[0],0,0,0), C0,0); \
    GAPB(o[1]=__builtin_amdgcn_mfma_f32_32x32x16_bf16(PAF(0),VFR(4),o[1],0,0,0), C0,4); \
    KRD(GL,0); GAPB(o[0]=__builtin_amdgcn_mfma_f32_32x32x16_bf16(PAF(1),VFR(1),o[0],0,0,0), C0,8); \
    KRD(GL,1); GAPB(o[1]=__builtin_amdgcn_mfma_f32_32x32x16_bf16(PAF(1),VFR(5),o[1],0,0,0), C0,12); \
    KRD(GL,2); GAPB(o[0]=__builtin_amdgcn_mfma_f32_32x32x16_bf16(PAF(2),VFR(2),o[0],0,0,0), C1,0); \
    KRD(GL,3); GAPB(o[1]=__builtin_amdgcn_mfma_f32_32x32x16_bf16(PAF(2),VFR(6),o[1],0,0,0), C1,4); \
    GAPB(o[0]=__builtin_amdgcn_mfma_f32_32x32x16_bf16(PAF(3),VFR(3),o[0],0,0,0), C1,8); \
    GAPB(o[1]=__builtin_amdgcn_mfma_f32_32x32x16_bf16(PAF(3),VFR(7),o[1],0,0,0), C1,12); \
    }while(0)
  int t=1;
  #undef CMASK
  #define CMASK(P0,P1,t) do{}while(0)
  for(;t+5<NT;t+=2){
    STEP(pB0,pB1,pA0,pA1,t,true,true,true);     WAIT_BAR(2); RESC(); ROT();
    STEP(pA0,pA1,pB0,pB1,t+1,true,true,true);   WAIT_BAR(2); RESC(); ROT();
  }
  #undef CMASK
  #define CMASK(P0,P1,t) do{int jb_=(t)-(NT-4); if(jb_>=0)cmask(P0,P1,jb_,qrel,hi);}while(0)
  #define ENDW(tt) do{ if((tt)+3<NT){WAIT_BAR(2);} else if((tt)+2<NT){WAIT_BAR(1);} else {WAIT_BAR(0);} }while(0)
  for(;t+1<NT;t+=2){
    STEP(pB0,pB1,pA0,pA1,t,(t+3<NT),(t+1<NT),(t+1<NT));       ENDW(t);   RESC(); ROT();
    STEP(pA0,pA1,pB0,pB1,t+1,(t+4<NT),(t+2<NT),(t+2<NT));     ENDW(t+1); RESC(); ROT();
  }
  STEP(pB0,pB1,pA0,pA1,NT-1,false,false,false); RESC();
  { float sacc=pB0[0]+pB0[1]; _Pragma("unroll") for(int r=2;r<16;++r)sacc+=pB0[r]; _Pragma("unroll") for(int r=0;r<16;++r)sacc+=pB1[r]; l_reg+=sacc;
    pw0=(u32x4){PKW(pB0,0),PKW(pB0,2),PKW(pB0,4),PKW(pB0,6)};pw1=(u32x4){PKW(pB0,8),PKW(pB0,10),PKW(pB0,12),PKW(pB0,14)};pw2=(u32x4){PKW(pB1,0),PKW(pB1,2),PKW(pB1,4),PKW(pB1,6)};pw3=(u32x4){PKW(pB1,8),PKW(pB1,10),PKW(pB1,12),PKW(pB1,14)};
    SBAR(); pv(o,vb0+sl_cur,PAF(0),PAF(1),PAF(2),PAF(3)); }
  #undef PKW
  #undef PAF
  #undef VFR
  #undef PIN
  #undef MX3
  #undef GAPA
  #undef GAPB
  #undef EX
  #undef VRD
  #undef KRD
  #undef STEP
  #undef ENDW
  {auto rr=__builtin_amdgcn_permlane32_swap(__float_as_uint(l_reg),__float_as_uint(l_reg),false,false);l_reg=__uint_as_float(rr[0])+__uint_as_float(rr[1]);}
  if(hi==0)wsf[32+r32]=l_reg;asm volatile("s_waitcnt lgkmcnt(0)":::"memory");
  float rli[16];
  #pragma unroll
  for(int r=0;r<16;++r)rli[r]=__builtin_amdgcn_rcpf(wsf[32+crow(r,hi)]);
  bf16*Ow=O+(rowbase+q0+wid*QBLK)*PO;
  { bf16*stg=(bf16*)(shm+LDS_OST)+wid*2048;
    #pragma unroll
    for(int r=0;r<16;++r){const int orow=crow(r,hi);
      #pragma unroll
      for(int d0=0;d0<2;++d0)stg[orow*64+d0*32+r32]=__float2bfloat16(o[d0][r]*rli[r]);}
    asm volatile("s_waitcnt lgkmcnt(0)":::"memory");
    #pragma unroll
    for(int i=0;i<4;++i){const int row=i*8+(lane>>3),ch=lane&7; const u32x4 v=*(const u32x4*)(stg+row*64+ch*8); ATTN_STORE16(Ow+(long)row*PO+ch*8,v);} }
  asm volatile("s_waitcnt lgkmcnt(0)\n\ts_barrier":::"memory");
  #undef DMA_K
  #undef DMA_V
  #undef CMASK
  #undef START
  #undef RESC
  #undef ROT
}
constexpr int ATTN_LDS_BYTES=LDS_BYTES;
#undef SBAR
#undef WAIT_BAR
}
#define GAS __attribute__((address_space(1)))
#define LAS __attribute__((address_space(3)))
typedef unsigned short bf16;
typedef unsigned v4u __attribute__((ext_vector_type(4)));
typedef unsigned v2u __attribute__((ext_vector_type(2)));
typedef float f32x4 __attribute__((ext_vector_type(4)));
typedef float f32x16 __attribute__((ext_vector_type(16)));
typedef short bf16x8 __attribute__((ext_vector_type(8)));
#define LDS_WAIT() asm volatile("s_waitcnt lgkmcnt(0)" ::: "memory")

constexpr int NWAVES = 8;
constexpr int BATCH = 8, SEQ = 4096, DMODEL = 1024, FF = 4096;
constexpr int M = BATCH * SEQ;
constexpr int EVEN_IN = 3072, ODD_IN = 1280;
constexpr float C2 = 0.125f * 1.4426950408889634f;
constexpr float LOG2E = 1.4426950408889634f;
constexpr float RMS_EPS = 1e-6f, DIFF_EPS = 1e-5f;
constexpr float LAM_INIT0 = 0.2f;

constexpr size_t MiB = 1u << 20;
constexpr int RING_BYTES = 131072;
constexpr int LDS_BYTES = 147456;
constexpr size_t WS_WIN = 2 * MiB, WS_WOUT = 8 * MiB, WS_WQKV = 10 * MiB, WS_WO = 13 * MiB, WS_W1 = 16 * MiB  , WS_W2 = 32 * MiB  ;
constexpr size_t WS_CS = 48 * MiB  , WS_BQKV = 50 * MiB, WS_RS = 51 * MiB  ;
constexpr size_t WS_BAR = 0;
constexpr int MISC_OFF = RING_BYTES + 320;
constexpr size_t WS_XN = 64 * MiB;
constexpr size_t WS_A2 = 448 * MiB;
constexpr size_t WS_H = 128 * MiB;
constexpr size_t WS_PROJ = 192 * MiB;
constexpr size_t WS_ATT = 384 * MiB;
constexpr size_t WS_HF = 192 * MiB;
constexpr size_t WS_END = 512 * MiB;


struct Args {
    const float* x; const int* pos;
    const float *npre_mix, *npost_mix, *npre_mlp, *npost_mlp;
    const float *w_in, *conv_w, *lq1, *lk1, *lq2, *lk2, *subln, *w_out;
    const float *w_qkv, *b_qkv, *sinks, *w_o, *b_o, *w1, *w2;
    float* out; unsigned char* ws;
    float inv_freq[8];
};

__device__ __forceinline__ float wave_sum(float v) {
#pragma unroll
    for (int o = 1; o < 64; o <<= 1) v += __shfl_xor(v, o);
    return v;
}
__device__ __forceinline__ unsigned f2bf(float f) { unsigned u = __builtin_bit_cast(unsigned, f); return (u + 0x7fffu + ((u >> 16) & 1u)) >> 16; }
__device__ __forceinline__ unsigned pk2(float lo, float hi) { return f2bf(lo) | (f2bf(hi) << 16); }
__device__ __forceinline__ float bflo(unsigned w) { return __builtin_bit_cast(float, w << 16); }
__device__ __forceinline__ float bfhi(unsigned w) { return __builtin_bit_cast(float, w & 0xffff0000u); }
__device__ __forceinline__ int mapcol(int n) { const int hl = n & 63; return hl < 16 ? (n & ~63) + (hl >> 1) + 8 * (hl & 1) : n; }

__device__ __forceinline__ void p0_transpose_item(const float* W, int K, int N, bf16* WT, LAS float* scr, int item, int lane, int perm_lo, int perm_hi, const float* g) {
    const int nblk = N / 32, kb = item / nblk, nb = item % nblk, k0 = 64 * kb, n0 = 32 * nb;
    int ncol = n0 + (lane & 31); if (ncol >= perm_lo && ncol < perm_hi) ncol = mapcol(ncol);
    if (perm_lo == 1536 && ncol >= 512 && ncol < 1536) { const int w_ = (ncol - 512) & 255, tt_ = (ncol - 512) >> 8; ncol = (w_ < 128 ? 512 : 1024 - 128) + 128 * tt_ + w_; }
    float wv[32];
#pragma unroll
    for (int i = 0; i < 32; ++i) { const int kk = 2 * i + (lane >> 5); wv[i] = __builtin_nontemporal_load(W + (size_t)(k0 + kk) * N + ncol); }
    if (g) {
#pragma unroll
        for (int i = 0; i < 32; ++i) { const int kk = 2 * i + (lane >> 5); wv[i] *= g[k0 + kk]; } }
#pragma unroll
    for (int i = 0; i < 32; ++i) { const int kk = 2 * i + (lane >> 5); scr[kk * 33 + (lane & 31)] = wv[i]; }
    LDS_WAIT(); asm volatile("" ::: "memory");
    const int c = lane & 7;
#pragma unroll
    for (int j = 0; j < 4; ++j) { const int n = (lane >> 3) + 8 * j; const LAS float* s = scr + (8 * c) * 33 + n;
        v4u o; o.x = pk2(s[0 * 33], s[1 * 33]); o.y = pk2(s[2 * 33], s[3 * 33]); o.z = pk2(s[4 * 33], s[5 * 33]); o.w = pk2(s[6 * 33], s[7 * 33]);
        *(GAS v4u*)(WT + (size_t)(n0 + n) * K + k0 + 8 * c) = o; }
    LDS_WAIT(); asm volatile("" ::: "memory");
}

__device__ __forceinline__ void unpack8(const v4u w, float (&f)[8]) { f[0] = bflo(w.x); f[1] = bfhi(w.x); f[2] = bflo(w.y); f[3] = bfhi(w.y); f[4] = bflo(w.z); f[5] = bfhi(w.z); f[6] = bflo(w.w); f[7] = bfhi(w.w); }
template <int RPI> __device__ __forceinline__ void x_rows_to_bf16(const float* x, bf16* XB, float* rsp, int row0, int lane) {
    f32x4 v[RPI][4];
#pragma unroll
    for (int r = 0; r < RPI; ++r) { const GAS f32x4* xr = (const GAS f32x4*)(x + (size_t)(row0 + r) * DMODEL) + lane;
#pragma unroll
        for (int j = 0; j < 4; ++j) v[r][j] = __builtin_nontemporal_load(xr + 64 * j); }
    float s[RPI];
#pragma unroll
    for (int r = 0; r < RPI; ++r) { s[r] = 0.f; GAS unsigned long long* o8 = (GAS unsigned long long*)(XB + (size_t)(row0 + r) * DMODEL) + lane;
#pragma unroll
        for (int j = 0; j < 4; ++j) { s[r] += (v[r][j].x * v[r][j].x + v[r][j].y * v[r][j].y) + (v[r][j].z * v[r][j].z + v[r][j].w * v[r][j].w);
            o8[64 * j] = (unsigned long long)pk2(v[r][j].x, v[r][j].y) | ((unsigned long long)pk2(v[r][j].z, v[r][j].w) << 32); } }
#pragma unroll
    for (int o = 1; o < 64; o <<= 1)
#pragma unroll
        for (int r = 0; r < RPI; ++r) s[r] += __shfl_xor(s[r], o);
#pragma unroll
    for (int r = 0; r < RPI; ++r) if (lane == r) rsp[row0 + r] = 1.f / sqrtf(s[r] * (1.f / DMODEL) + RMS_EPS);
}

template <int RPI> __device__ __forceinline__ void nr_pass(int gw, int NGW, int lane_, const bf16* H, bf16* XB, const float* wpost, float* rsout, float* outf) {
    int lane = lane_; asm volatile("" : "+v"(lane));
    f32x4 wp[2][2];
#pragma unroll
    for (int j = 0; j < 2; ++j)
#pragma unroll
        for (int e = 0; e < 2; ++e) wp[j][e] = *(const f32x4*)(wpost + 8 * lane + 512 * j + 4 * e);
    for (int row0 = gw * RPI; row0 < M; row0 += NGW * RPI) {
        v4u hw[RPI][2], xw[RPI][2];
#pragma unroll
        for (int r = 0; r < RPI; ++r)
#pragma unroll
            for (int j = 0; j < 2; ++j) { hw[r][j] = __builtin_nontemporal_load((const GAS v4u*)(H + (size_t)(row0 + r) * DMODEL + 8 * lane + 512 * j)); xw[r][j] = *(const GAS v4u*)(XB + (size_t)(row0 + r) * DMODEL + 8 * lane + 512 * j); }
        float ss[RPI];
#pragma unroll
        for (int r = 0; r < RPI; ++r) { ss[r] = 0.f;
#pragma unroll
            for (int j = 0; j < 2; ++j) { float f[8]; unpack8(hw[r][j], f);
#pragma unroll
                for (int e = 0; e < 8; ++e) ss[r] += f[e] * f[e]; } }
#pragma unroll
        for (int o = 1; o < 64; o <<= 1)
#pragma unroll
            for (int r = 0; r < RPI; ++r) ss[r] += __shfl_xor(ss[r], o);
        float s2[RPI];
#pragma unroll
        for (int r = 0; r < RPI; ++r) { const float rs = 1.f / sqrtf(ss[r] * (1.f / DMODEL) + RMS_EPS); s2[r] = 0.f;
#pragma unroll
            for (int j = 0; j < 2; ++j) { float f[8], x[8]; unpack8(hw[r][j], f); unpack8(xw[r][j], x);
                f32x4 x0 = (f32x4){x[0], x[1], x[2], x[3]} + (f32x4){f[0], f[1], f[2], f[3]} * rs * wp[j][0], x1 = (f32x4){x[4], x[5], x[6], x[7]} + (f32x4){f[4], f[5], f[6], f[7]} * rs * wp[j][1];
                s2[r] += ((x0.x * x0.x + x0.y * x0.y) + (x0.z * x0.z + x0.w * x0.w)) + ((x1.x * x1.x + x1.y * x1.y) + (x1.z * x1.z + x1.w * x1.w));
                if (outf) { *(GAS f32x4*)(outf + (size_t)(row0 + r) * DMODEL + 8 * lane + 512 * j) = x0; *(GAS f32x4*)(outf + (size_t)(row0 + r) * DMODEL + 8 * lane + 512 * j + 4) = x1; }
                else { v4u o; o.x = pk2(x0.x, x0.y); o.y = pk2(x0.z, x0.w); o.z = pk2(x1.x, x1.y); o.w = pk2(x1.z, x1.w); *(GAS v4u*)(XB + (size_t)(row0 + r) * DMODEL + 8 * lane + 512 * j) = o; } } }
        if (rsout) {
#pragma unroll
            for (int o = 1; o < 64; o <<= 1)
#pragma unroll
                for (int r = 0; r < RPI; ++r) s2[r] += __shfl_xor(s2[r], o);
#pragma unroll
            for (int r = 0; r < RPI; ++r) if (lane == r) rsout[row0 + r] = 1.f / sqrtf(s2[r] * (1.f / DMODEL) + RMS_EPS);
        }
    }
}


__device__ __forceinline__ void mix_pass(int gw, int NGW, int lane_, const bf16* PROJ, const bf16* ATT, bf16* A2, const float* conv_w, const float* subln, float lam) {
    int lane = lane_; asm volatile("" : "+v"(lane));
    float cw[3][8], sw[8];
#pragma unroll
    for (int i = 0; i < 3; ++i)
#pragma unroll
        for (int e = 0; e < 8; ++e) cw[i][e] = conv_w[i * 512 + 8 * lane + e];
#pragma unroll
    for (int e = 0; e < 8; ++e) sw[e] = subln[(lane & 15) * 8 + e] * (1.0f - LAM_INIT0);
    for (int row0 = gw * 2; row0 < M; row0 += NGW * 2) {
        const int t0 = row0 & (SEQ - 1);
        const bf16* pr = PROJ + (size_t)row0 * EVEN_IN + 8 * lane;
        const bf16* ar = ATT + (size_t)row0 * DMODEL + (lane >> 4) * 256 + (lane & 15) * 8;
        v4u gbw[2], uw[4], o0w[2], o1w[2];
#pragma unroll
        for (int r = 0; r < 2; ++r) { gbw[r] = *(const GAS v4u*)(pr + r * EVEN_IN); o0w[r] = *(const GAS v4u*)(ar + r * DMODEL); o1w[r] = *(const GAS v4u*)(ar + r * DMODEL + 128); }
#pragma unroll
        for (int r = 0; r < 4; ++r) { if (r >= 2 || t0 > 0) uw[r] = *(const GAS v4u*)(pr + (r - 2) * EVEN_IN + 512);
            else uw[r] = (v4u){0u, 0u, 0u, 0u}; }
        float u[4][8];
#pragma unroll
        for (int r = 0; r < 4; ++r) unpack8(uw[r], u[r]);
#pragma unroll
        for (int r = 0; r < 2; ++r) { float gb[8], co[8]; unpack8(gbw[r], gb);
#pragma unroll
            for (int e = 0; e < 8; ++e) co[e] = gb[e] * (cw[0][e] * u[r][e] + cw[1][e] * u[r + 1][e] + cw[2][e] * u[r + 2][e]);
            v4u o; o.x = pk2(co[0], co[1]); o.y = pk2(co[2], co[3]); o.z = pk2(co[4], co[5]); o.w = pk2(co[6], co[7]);
            *(GAS v4u*)(A2 + (size_t)(row0 + r) * DMODEL + 8 * lane) = o; }
#pragma unroll
        for (int r = 0; r < 2; ++r) { float o0[8], o1[8], d[8]; unpack8(o0w[r], o0); unpack8(o1w[r], o1);
            float ss = 0.f;
#pragma unroll
            for (int e = 0; e < 8; ++e) { d[e] = o0[e] - lam * o1[e]; ss += d[e] * d[e]; }
            ss += __shfl_xor(ss, 1); ss += __shfl_xor(ss, 2); ss += __shfl_xor(ss, 4); ss += __shfl_xor(ss, 8);
            const float rs = 1.f / sqrtf(ss * (1.f / 128.f) + DIFF_EPS);
#pragma unroll
            for (int e = 0; e < 8; ++e) d[e] = d[e] * rs * sw[e];
            v4u o; o.x = pk2(d[0], d[1]); o.y = pk2(d[2], d[3]); o.z = pk2(d[4], d[5]); o.w = pk2(d[6], d[7]);
            *(GAS v4u*)(A2 + (size_t)(row0 + r) * DMODEL + 512 + 8 * lane) = o; }
    }
}

__device__ __forceinline__ int crow16(int r, int hi) { return (r & 3) + 8 * (r >> 2) + 4 * hi; }
__device__ __forceinline__ unsigned cvtpk(float lo, float hi) { typedef float f2 __attribute__((ext_vector_type(2))); typedef __bf16 b2 __attribute__((ext_vector_type(2))); f2 v = {lo, hi}; b2 b = __builtin_convertvector(v, b2); return __builtin_bit_cast(unsigned, b); }

constexpr int VTP = 264;
__device__ __forceinline__ void swa_phase(int vcu, int G, LAS unsigned char* lds, const bf16* QKV, const float* sinks, bf16* ATT) {
    int tid_ = threadIdx.x; asm volatile("" : "+v"(tid_)); const int tid = tid_, lane = tid & 63, q = lane & 31, hi = lane >> 5; const int wid = __builtin_amdgcn_readfirstlane(tid >> 6);
    LAS unsigned char* Kl = lds; LAS bf16* Vt = (LAS bf16*)(lds + 32768);
    for (int unit = vcu; unit < BATCH * 32 * 2; unit += G) {
        const int b = unit >> 6, blk = (unit & 63) >> 1, kvh = unit & 1;
        __syncthreads();
        v4u kvr[4], vvr[4];
#pragma unroll
        for (int i = 0; i < 4; ++i) { const int idx = tid + 512 * i, row = idx >> 3, ch = idx & 7; const int t = blk * 128 - 128 + row;
            kvr[i] = (v4u){0u, 0u, 0u, 0u}; if (t >= 0) kvr[i] = *(const GAS v4u*)(QKV + (size_t)(b * SEQ + t) * ODD_IN + 1024 + kvh * 64 + ch * 8);
            const int row2 = idx & 255, ch2 = idx >> 8; const int t2 = blk * 128 - 128 + row2;
            vvr[i] = (v4u){0u, 0u, 0u, 0u}; if (t2 >= 0) vvr[i] = *(const GAS v4u*)(QKV + (size_t)(b * SEQ + t2) * ODD_IN + 1152 + kvh * 64 + ch2 * 8); }
#pragma unroll
        for (int i = 0; i < 4; ++i) { const int idx = tid + 512 * i, row = idx >> 3, ch = idx & 7; const v4u kv = kvr[i], vv = vvr[i];
            *(LAS v4u*)(Kl + ch * 4096 + row * 16) = kv;
            const int kvi = idx & 255, kc = kvi & 15, kpos = (kvi & ~15) + ((kc & 3) | ((kc & 4) << 1) | ((kc & 8) >> 1));
            LAS bf16* vp = Vt + ((idx >> 8) * 8) * VTP + kpos;
            vp[0 * VTP] = (bf16)(vv.x & 0xffffu); vp[1 * VTP] = (bf16)(vv.x >> 16); vp[2 * VTP] = (bf16)(vv.y & 0xffffu); vp[3 * VTP] = (bf16)(vv.y >> 16);
            vp[4 * VTP] = (bf16)(vv.z & 0xffffu); vp[5 * VTP] = (bf16)(vv.z >> 16); vp[6 * VTP] = (bf16)(vv.w & 0xffffu); vp[7 * VTP] = (bf16)(vv.w >> 16); }
        __syncthreads();
        const int head = kvh * 8 + wid; const float sink2 = sinks[head] * LOG2E;
        if (wid >= 4) __builtin_amdgcn_s_sleep(90);
        bf16x8 qn[4];
        { const size_t tok0 = (size_t)b * SEQ + blk * 128 + q;
#pragma unroll
            for (int ks = 0; ks < 4; ++ks) qn[ks] = *(const GAS bf16x8*)(QKV + tok0 * ODD_IN + head * 64 + 16 * ks + 8 * hi); }
        for (int ci = 0; ci < 4; ++ci) {
            const int r0 = 32 * ci; const size_t tok = (size_t)b * SEQ + blk * 128 + r0 + q;
            bf16x8 qf[4];
#pragma unroll
            for (int ks = 0; ks < 4; ++ks) qf[ks] = qn[ks];
            if (ci < 3) {
#pragma unroll
                for (int ks = 0; ks < 4; ++ks) qn[ks] = *(const GAS bf16x8*)(QKV + (tok + 32) * ODD_IN + head * 64 + 16 * ks + 8 * hi); }
            f32x16 p[5];
#pragma unroll
            for (int jt = 0; jt < 5; ++jt) p[jt] = (f32x16){};
#pragma unroll
            for (int ks = 0; ks < 4; ++ks)
#pragma unroll
                for (int jt = 0; jt < 5; ++jt) { const bf16x8 kf = *(const LAS bf16x8*)(Kl + (2 * ks + hi) * 4096 + (r0 + 32 * jt + q) * 16); p[jt] = __builtin_amdgcn_mfma_f32_32x32x16_bf16(kf, qf[ks], p[jt], 0, 0, 0); }
            float mx = -INFINITY;
            if (blk == 0) {
#pragma unroll
                for (int jt = 0; jt < 5; ++jt)
#pragma unroll
                    for (int r = 0; r < 16; ++r) { const int j = r0 + 32 * jt + crow16(r, hi); const bool valid = (j >= r0 + q + 1) && (j <= r0 + q + 128) && (j >= 128);
                        p[jt][r] = valid ? p[jt][r] : -INFINITY; }
            } else {
#pragma unroll
                for (int r = 0; r < 16; ++r) { const int c = crow16(r, hi); p[0][r] = (c > q) ? p[0][r] : -INFINITY; p[4][r] = (c <= q) ? p[4][r] : -INFINITY; }
            }
#pragma unroll
            for (int jt = 0; jt < 5; ++jt)
#pragma unroll
                for (int r = 0; r < 16; ++r) mx = fmaxf(mx, p[jt][r]);
            mx = fmaxf(mx, __shfl_xor(mx, 32)); mx = fmaxf(mx, sink2);
            float l = 0.f;
#pragma unroll
            for (int jt = 0; jt < 5; ++jt)
#pragma unroll
                for (int r = 0; r < 16; ++r) { p[jt][r] = __builtin_amdgcn_exp2f(p[jt][r] - mx); l += p[jt][r]; }
            l += __shfl_xor(l, 32); l += __builtin_amdgcn_exp2f(sink2 - mx);
            f32x16 o[2]; o[0] = (f32x16){}; o[1] = (f32x16){};
#pragma unroll
            for (int jt = 0; jt < 5; ++jt)
#pragma unroll
                for (int kb = 0; kb < 2; ++kb) { v4u pw; pw.x = cvtpk(p[jt][8 * kb + 0], p[jt][8 * kb + 1]); pw.y = cvtpk(p[jt][8 * kb + 2], p[jt][8 * kb + 3]); pw.z = cvtpk(p[jt][8 * kb + 4], p[jt][8 * kb + 5]); pw.w = cvtpk(p[jt][8 * kb + 6], p[jt][8 * kb + 7]);
                    const bf16x8 pf = __builtin_bit_cast(bf16x8, pw);
#pragma unroll
                    for (int dt = 0; dt < 2; ++dt) { const bf16x8 vf = *(const LAS bf16x8*)(Vt + (32 * dt + q) * VTP + r0 + 32 * jt + 16 * kb + 8 * hi);
                        o[dt] = __builtin_amdgcn_mfma_f32_32x32x16_bf16(vf, pf, o[dt], 0, 0, 0); } }
            const float il = 1.f / l;
            bf16* op = ATT + tok * DMODEL + head * 64 + 8 * hi;
#pragma unroll
            for (int dt = 0; dt < 2; ++dt)
#pragma unroll
                for (int rp = 0; rp < 2; ++rp) {
                    v2u y, x; y.x = cvtpk(o[dt][8 * rp] * il, o[dt][8 * rp + 1] * il); y.y = cvtpk(o[dt][8 * rp + 2] * il, o[dt][8 * rp + 3] * il);
                    x.x = cvtpk(o[dt][8 * rp + 4] * il, o[dt][8 * rp + 5] * il); x.y = cvtpk(o[dt][8 * rp + 6] * il, o[dt][8 * rp + 7] * il);
                    const v2u snd = hi ? y : x;
                    v2u rcv; rcv.x = __shfl_xor(snd.x, 32); rcv.y = __shfl_xor(snd.y, 32);
                    v4u w; if (hi) { w.x = rcv.x; w.y = rcv.y; w.z = x.x; w.w = x.y; } else { w.x = y.x; w.y = y.y; w.z = rcv.x; w.w = rcv.y; }
                    *(GAS v4u*)(op + 32 * dt + 16 * rp) = w; }
        }
    }
}
#define RLX_AGENT __ATOMIC_RELAXED, __HIP_MEMORY_SCOPE_AGENT
#define XB_TMO      128
#define XB_XCNT(j)  (256  + 64 * (j))
#define XB_XSUB(j)  (1280 + 64 * (j))
#define XB_XGEN(j)  (2304 + 64 * (j))
#define XB_TOP      3328
#define XB_TOPGEN   3392
#define XCD_BAR_WORDS 3456
#define XB_SPIN_CAP (1u << 18)

__device__ __forceinline__ unsigned xb_ld(unsigned* p)              { return __hip_atomic_load(p, __ATOMIC_RELAXED, __HIP_MEMORY_SCOPE_AGENT); }
__device__ __forceinline__ unsigned xb_add(unsigned* p, unsigned v) { return __hip_atomic_fetch_add(p, v, __ATOMIC_RELAXED, __HIP_MEMORY_SCOPE_AGENT); }
__device__ __forceinline__ unsigned xb_xcc_id() { return (unsigned)__builtin_amdgcn_s_getreg((3 << 11) | 20) & 0xFu; }
#define XB_SPIN(cond, bar) do { unsigned _sp = 0; while (cond) { __builtin_amdgcn_s_sleep(1); \
    if ((++_sp & 255u) == 0u) { if (xb_ld(&(bar)[XB_TMO])) break; if (_sp > XB_SPIN_CAP) { atomicAdd(&(bar)[XB_TMO], 1u); break; } } } } while (0)

struct XcdBarrier {
    unsigned* bar; unsigned x;
    volatile LAS unsigned* st;
};

__device__ __forceinline__ XcdBarrier xcd_barrier_post(unsigned* bar, volatile LAS unsigned* st) {
    XcdBarrier b; b.bar = bar; b.x = xb_xcc_id(); b.st = st;
    if (threadIdx.x == 0) (void)xb_add(&bar[XB_XCNT(b.x)], 1u);
    return b;
}
__device__ __forceinline__ void xcd_barrier_complete(unsigned* bar, unsigned x, unsigned& nloc, unsigned& nx) {
    const unsigned G = gridDim.x * gridDim.y * gridDim.z;
    unsigned sum, cnt, mine, sp = 0u;
    for (;;) {
        sum = 0u; cnt = 0u; mine = 0u;
#pragma unroll
        for (unsigned j = 0; j < 16; ++j) { const unsigned c = xb_ld(&bar[XB_XCNT(j)]); sum += c; cnt += (c > 0u) ? 1u : 0u; mine = (j == x) ? c : mine; }
        if (sum == G) break;
        __builtin_amdgcn_s_sleep(1);
        if ((++sp & 255u) == 0u) { if (xb_ld(&bar[XB_TMO])) break; if (sp > XB_SPIN_CAP) { atomicAdd(&bar[XB_TMO], 1u); break; } }
    }
    nloc = mine > 0u ? mine : 1u; nx = cnt > 0u ? cnt : 1u;
}

__device__ __forceinline__ void xcd_barrier(const XcdBarrier& b) {
    asm volatile("s_waitcnt vmcnt(0)" ::: "memory");
    __syncthreads();
    if (threadIdx.x == 0) {
        unsigned* bar = b.bar;
        __builtin_amdgcn_s_waitcnt(0);
        unsigned nloc = b.st[0], nx = b.st[1];
        if (nloc == 0u) { xcd_barrier_complete(bar, b.x, nloc, nx); b.st[0] = nloc; b.st[1] = nx; }
        const unsigned old = xb_add(&bar[XB_XSUB(b.x)], 1u);
        const unsigned gen = old / nloc;
        if (old + 1u == (gen + 1u) * nloc) {
            __builtin_amdgcn_fence(__ATOMIC_RELEASE, "agent");
            asm volatile("s_waitcnt vmcnt(0)" ::: "memory");
            const unsigned og = xb_add(&bar[XB_TOP], 1u);
            const unsigned tg = og / nx;
            if (og + 1u == (tg + 1u) * nx) xb_add(&bar[XB_TOPGEN], 1u);
            else XB_SPIN(xb_ld(&bar[XB_TOPGEN]) == tg, bar);
            __builtin_amdgcn_fence(__ATOMIC_ACQUIRE, "agent");
            xb_add(&bar[XB_XGEN(b.x)], 1u);
            asm volatile("s_waitcnt vmcnt(0)" ::: "memory");
        } else {
            XB_SPIN(xb_ld(&bar[XB_XGEN(b.x)]) == gen, bar);
            __builtin_amdgcn_fence(__ATOMIC_ACQUIRE, "agent");
            asm volatile("s_waitcnt vmcnt(0)" ::: "memory");
        }
    }
    __syncthreads();
}
__global__ void __launch_bounds__(NWAVES * 64, 2) fwd_kernel(Args a) {
    extern __shared__ __attribute__((aligned(16))) unsigned char lds_raw[];
    cg::grid_group grid = cg::this_grid();
    LAS unsigned char* lds = (LAS unsigned char*)lds_raw;
    const int tid = threadIdx.x, lane = tid & 63, wave = __builtin_amdgcn_readfirstlane(tid >> 6);
    const int G = gridDim.x, bx = blockIdx.x, vcu = (G % 8 == 0) ? (bx % 8) * (G / 8) + bx / 8 : bx;
    const int gw = vcu * NWAVES + wave, NGW = G * NWAVES;
    unsigned char* ws = a.ws;
    bf16* Win_t = (bf16*)(ws + WS_WIN); bf16* Wout_t = (bf16*)(ws + WS_WOUT); bf16* Wqkv_t = (bf16*)(ws + WS_WQKV); bf16* Wo_t = (bf16*)(ws + WS_WO);
    bf16* W1_t = (bf16*)(ws + WS_W1); bf16* W2_t = (bf16*)(ws + WS_W2);
    float* cs = (float*)(ws + WS_CS); float* bqkv_p = (float*)(ws + WS_BQKV);
    bf16* XB = (bf16*)(ws + WS_XN); bf16* A2 = (bf16*)(ws + WS_A2); bf16* H = (bf16*)(ws + WS_H); float* RS = (float*)(ws + WS_RS); bf16* PROJ = (bf16*)(ws + WS_PROJ); bf16* ATT = (bf16*)(ws + WS_ATT); bf16* HF = (bf16*)(ws + WS_HF);

    unsigned* barw = (unsigned*)(ws + WS_BAR);
    volatile LAS unsigned* MISC = (volatile LAS unsigned*)(lds + MISC_OFF);
    if (tid < 32) MISC[tid] = 0u;
    if (bx == 0) for (int i = tid; i < XCD_BAR_WORDS; i += NWAVES * 64) barw[i] = 0u;
    {
        LAS float* scr = (LAS float*)(lds + wave * 16384);
        constexpr int I_IN = 16 * 96, I_SQ = 16 * 32, I_QKV = 16 * 40, I_W1 = 16 * 128, I_W2 = 64 * 32;
        constexpr int NITEMS = I_IN + I_SQ + I_QKV + I_SQ + 2 * I_W1 + 2 * I_W2;
        for (int it = gw; it < NITEMS; it += NGW) {
            int r = it;
            if (r < I_IN) { p0_transpose_item(a.w_in, 1024, EVEN_IN, Win_t, scr, r, lane, 1536, 2560, a.npre_mix); continue; } r -= I_IN;
            if (r < I_SQ) { p0_transpose_item(a.w_out, 1024, 1024, Wout_t, scr, r, lane, 0, 0, nullptr); continue; } r -= I_SQ;
            if (r < I_QKV) { p0_transpose_item(a.w_qkv, 1024, ODD_IN, Wqkv_t, scr, r, lane, 0, 1152, a.npre_mix + 1024); continue; } r -= I_QKV;
            if (r < I_SQ) { p0_transpose_item(a.w_o, 1024, 1024, Wo_t, scr, r, lane, 0, 0, nullptr); continue; } r -= I_SQ;
            if (r < I_W1) { p0_transpose_item(a.w1, 1024, FF, W1_t, scr, r, lane, 0, 0, a.npre_mlp); continue; } r -= I_W1;
            if (r < I_W1) { p0_transpose_item(a.w1 + (size_t)1024 * FF, 1024, FF, W1_t + (size_t)1024 * FF, scr, r, lane, 0, 0, a.npre_mlp + 1024); continue; } r -= I_W1;
            if (r < I_W2) { p0_transpose_item(a.w2, FF, 1024, W2_t, scr, r, lane, 0, 0, nullptr); continue; } r -= I_W2;
            p0_transpose_item(a.w2 + (size_t)1024 * FF, FF, 1024, W2_t + (size_t)1024 * FF, scr, r, lane, 0, 0, nullptr);
        }
        const int gtid = vcu * (NWAVES * 64) + tid, nthr = G * NWAVES * 64;
        for (int i = gtid; i < ODD_IN; i += nthr) bqkv_p[i] = a.b_qkv[i < 1152 ? mapcol(i) : i];
        for (int row = gtid; row < M; row += nthr) { const float pf = (float)a.pos[row];
#pragma unroll
            for (int i = 0; i < 8; ++i) { const float ang = pf * a.inv_freq[i]; const double t = (double)ang * 0.15915494309189535; const float fr = (float)(t - floor(t));
                cs[(size_t)row * 16 + 2 * i] = __builtin_amdgcn_cosf(fr); cs[(size_t)row * 16 + 2 * i + 1] = __builtin_amdgcn_sinf(fr); } }
        for (int m = gw * 4; m < M; m += NGW * 4) x_rows_to_bf16<4>(a.x, XB, RS, m, lane);
    }
    grid.sync();
    const XcdBarrier bar = xcd_barrier_post(barw, MISC + 8);
#define GRID_BAR() xcd_barrier(bar)

    {
        pg8::Gemm g{XB, Win_t, M, EVEN_IN, 1024};
        pg8::StaticOrder S; S.init(M, EVEN_IN, G, bx);
        pg8::EpiInProj E{{PROJ, EVEN_IN, nullptr, cs, 1536, 2048, 2048, 2560, C2, RS, 0}, {PROJ, EVEN_IN, RS}};
        pg8::gemm_phase<pg8::EpiInProj, pg8::StaticOrder, true, true>(lds, g, S, E);
    }
    GRID_BAR();
    {
        for (int p = vcu; p < BATCH * 16 * 8; p += G) {
            const int bvh = p >> 3, s = p & 7, b = bvh >> 4, vh = bvh & 15, h = vh >> 2, c = (vh >> 1) & 1, half = vh & 1;
            const attn_body::bf16* Q = (const attn_body::bf16*)PROJ + 1536 + (h * 2 + c) * 64;
            const attn_body::bf16* K = (const attn_body::bf16*)PROJ + 2048 + (h * 2 + c) * 64;
            const attn_body::bf16* V = (const attn_body::bf16*)PROJ + 2560 + h * 128 + half * 64;
            attn_body::bf16* O = (attn_body::bf16*)ATT + vh * 64;
            attn_body::attn_unit<8>(b, 15 - s, Q, K, V, O, (char*)lds_raw);
            attn_body::attn_unit<8>(b, s, Q, K, V, O, (char*)lds_raw);
        }
    }
    GRID_BAR();
    {
        const float s1 = wave_sum(a.lq1[lane] * a.lk1[lane]), s2 = wave_sum(a.lq2[lane] * a.lk2[lane]);
        const float lam = expf(s1) - expf(s2) + LAM_INIT0;
        mix_pass(gw, NGW, lane, PROJ, ATT, A2, a.conv_w, a.subln, lam);
    }
    GRID_BAR();
    {
        pg8::Gemm g{A2, Wout_t, M, 1024, 1024}; pg8::StaticOrder S; S.init(M, 1024, G, bx);
        pg8::EpiX<0> E{H, 1024, nullptr, nullptr, 0, 0, 0, 0, 1.f, nullptr, 0};
        pg8::gemm_phase<pg8::EpiX<0>, pg8::StaticOrder, true, true>(lds, g, S, E);
    }
    GRID_BAR();
    nr_pass<4>(gw, NGW, lane, H, XB, a.npost_mix, RS, nullptr);
    GRID_BAR();
#define MLP_PHASES(l) \
    {     \
        pg8::Gemm g{XB, W1_t + (size_t)(l) * 1024 * FF, M, FF, 1024}; pg8::StaticOrder S; S.init(M, FF, G, bx); \
        pg8::EpiX<1> E{HF, FF, nullptr, nullptr, 0, 0, 0, 0, 1.f, RS, 16}; \
        pg8::gemm_phase<pg8::EpiX<1>, pg8::StaticOrder, true, true>(lds, g, S, E); \
    } \
    GRID_BAR(); \
    {     \
        pg8::Gemm g{HF, W2_t + (size_t)(l) * 1024 * FF, M, 1024, FF}; pg8::RevOrder S; S.so.init(M, 1024, G, bx); S.nrounds = (S.so.nwg + G - 1) / G; \
        pg8::EpiX<0> E{H, 1024, nullptr, nullptr, 0, 0, 0, 0, 1.f, nullptr, 0}; \
        pg8::gemm_phase<pg8::EpiX<0>, pg8::RevOrder, true, true, true>(lds, g, S, E); \
    } \
    GRID_BAR();
    MLP_PHASES(0)
    nr_pass<4>(gw, NGW, lane, H, XB, a.npost_mlp, RS, nullptr);
    GRID_BAR();
    {
        pg8::Gemm g{XB, Wqkv_t, M, ODD_IN, 1024}; pg8::StaticOrder S; S.init(M, ODD_IN, G, bx);
        pg8::EpiX<2> E{PROJ, ODD_IN, bqkv_p, cs, 0, 1024, 1024, 1152, C2, RS, 0};
        pg8::gemm_phase<pg8::EpiX<2>, pg8::StaticOrder, true, true>(lds, g, S, E);
    }
    GRID_BAR();
    swa_phase(vcu, G, lds, PROJ, a.sinks, ATT);
    GRID_BAR();
    {
        pg8::Gemm g{ATT, Wo_t, M, 1024, 1024}; pg8::StaticOrder S; S.init(M, 1024, G, bx);
        pg8::EpiX<0> E{H, 1024, a.b_o, nullptr, 0, 0, 0, 0, 1.f, nullptr, 0};
        pg8::gemm_phase<pg8::EpiX<0>, pg8::StaticOrder, true, true>(lds, g, S, E);
    }
    GRID_BAR();
    nr_pass<4>(gw, NGW, lane, H, XB, a.npost_mix + 1024, RS, nullptr);
    GRID_BAR();
    MLP_PHASES(1)
    nr_pass<4>(gw, NGW, lane, H, XB, a.npost_mlp + 1024, nullptr, a.out);
#undef MLP_PHASES
}

extern "C" void kernel_launch(void* const* d_in, const int* in_sizes, int n_in, void* d_out, int out_size, void* d_ws, size_t ws_size, hipStream_t stream) {
    static int grid_blocks = 0;
    if (grid_blocks == 0) {
        if (n_in != 21 || in_sizes[0] != M * DMODEL || out_size != M * DMODEL || ws_size < WS_END) { fprintf(stderr, "kernel_launch: unexpected problem shape / workspace (n_in %d, ws %zu)\n", n_in, ws_size); grid_blocks = -1; return; }
        int dev = 0, cus = 0, per_cu = 0;
        if (hipGetDevice(&dev) != hipSuccess || hipDeviceGetAttribute(&cus, hipDeviceAttributeMultiprocessorCount, dev) != hipSuccess) { grid_blocks = -1; return; }
        if (hipFuncSetAttribute((const void*)fwd_kernel, hipFuncAttributeMaxDynamicSharedMemorySize, LDS_BYTES) != hipSuccess) { fprintf(stderr, "kernel_launch: hipFuncSetAttribute failed\n"); grid_blocks = -1; return; }
        if (hipOccupancyMaxActiveBlocksPerMultiprocessor(&per_cu, (const void*)fwd_kernel, NWAVES * 64, LDS_BYTES) != hipSuccess || per_cu < 1) { fprintf(stderr, "kernel_launch: occupancy query says %d blocks per CU\n", per_cu); grid_blocks = -1; (void)hipGetLastError(); return; }
        grid_blocks = cus;
    }
    if (grid_blocks < 0) return;
    Args a{};
    a.x = (const float*)d_in[0]; a.pos = (const int*)d_in[1];
    a.npre_mix = (const float*)d_in[2]; a.npost_mix = (const float*)d_in[3]; a.npre_mlp = (const float*)d_in[4]; a.npost_mlp = (const float*)d_in[5];
    a.w_in = (const float*)d_in[6]; a.conv_w = (const float*)d_in[7]; a.lq1 = (const float*)d_in[8]; a.lk1 = (const float*)d_in[9]; a.lq2 = (const float*)d_in[10]; a.lk2 = (const float*)d_in[11];
    a.subln = (const float*)d_in[12]; a.w_out = (const float*)d_in[13]; a.w_qkv = (const float*)d_in[14]; a.b_qkv = (const float*)d_in[15]; a.sinks = (const float*)d_in[16];
    a.w_o = (const float*)d_in[17]; a.b_o = (const float*)d_in[18]; a.w1 = (const float*)d_in[19]; a.w2 = (const float*)d_in[20];
    a.out = (float*)d_out; a.ws = (unsigned char*)d_ws;
    for (int i = 0; i < 8; ++i) a.inv_freq[i] = (float)pow(500000.0, -(double)i / 8.0);
    void* args[] = {&a};
    hipError_t e = hipLaunchCooperativeKernel((const void*)fwd_kernel, dim3(grid_blocks), dim3(NWAVES * 64), args, LDS_BYTES, stream);
    if (e != hipSuccess) fprintf(stderr, "kernel_launch: cooperative launch failed: %s (grid %d)\n", hipGetErrorString(e), grid_blocks);
}
```

```cpp
#include <hip/hip_runtime.h>
#include <hip/hip_cooperative_groups.h>
#include <cstdio>
#include <cstdint>
#include <cmath>
namespace cg = cooperative_groups;
namespace pg8 {
#define PG8_LAS __attribute__((address_space(3)))
typedef unsigned short bf16_t;
typedef short bf16x8 __attribute__((ext_vector_type(8)));
typedef float f32x4 __attribute__((ext_vector_type(4)));
typedef unsigned u32x4 __attribute__((ext_vector_type(4)));
constexpr int BM = 256, BK = 64, HALF = 128, HTB = HALF * BK * 2  , STAGE_BYTES = 8 * HTB, NXCD = 8, WGM = 8;

__host__ __device__ __forceinline__ int lds_byte(int r, int c) { const int st = (r >> 4) * 2 + (c >> 5), rr = r & 15, cc = c & 31, ob = rr * 64 + cc * 2; return st * 1024 + (ob ^ (((ob >> 9) & 1) << 5)); }
__host__ __device__ __forceinline__ void stage_rc(int b, int& R, int& C) { const int st = b / 1024, sb = b % 1024, swz = sb ^ (((sb >> 9) & 1) << 5); R = (st >> 1) * 16 + swz / 64; C = (st & 1) * 32 + (swz % 64) / 2; }
__host__ __device__ __forceinline__ int perm32(int rho) { const int n = rho >> 4, i = rho & 15; return 8 * (i >> 2) + 4 * n + (i & 3); }

struct Unit { int pm, pn; };
struct Gemm { const bf16_t* A; const bf16_t* Bt; int M, N, K; };

struct StaticOrder {
    int nM, nN, nwg, G, c;
    __host__ __device__ void init(int M, int N, int G_, int c_) { nM = M / BM; nN = N / BM; nwg = nM * nN; G = G_; c = c_; }
    __host__ __device__ bool next(int i, Unit& u) const {
        const long L = (long)i * G + c; if (L >= nwg) return false;
        int wgid = (int)L; { const int q = nwg / NXCD, r = nwg % NXCD, xcd = wgid % NXCD, off = wgid / NXCD; wgid = (xcd < r ? xcd * (q + 1) : r * (q + 1) + (xcd - r) * q) + off; }
        const int nig = WGM * nN, gid = wgid / nig, fm = gid * WGM, gsz = (nM - fm) < WGM ? (nM - fm) : WGM;
        u.pm = fm + ((wgid % nig) % gsz); u.pn = (wgid % nig) / gsz; return true;
    }
    __device__ __forceinline__ void a_ready(const Unit&) const {}
    __device__ __forceinline__ void done(const Unit&) const {}
};

__device__ __forceinline__ unsigned cvt_pk_bf16(float lo, float hi) { unsigned r; asm volatile("v_cvt_pk_bf16_f32 %0, %1, %2" : "=v"(r) : "v"(lo), "v"(hi)); return r; }
typedef float f32x2 __attribute__((ext_vector_type(2)));
struct RevOrder {
    StaticOrder so; int nrounds;
    __host__ __device__ bool next(int i, Unit& u) const { return i < nrounds && so.next(nrounds - 1 - i, u); }
    __device__ __forceinline__ void a_ready(const Unit&) const {}
    __device__ __forceinline__ void done(const Unit&) const {}
};
template <int MODE> struct EpiX {
    static constexpr bool PERM = true, AFTER_DRAIN = false;
    bf16_t* O; int ldc; const float* bias; const float* cs; int q_lo, q_hi, k_lo, k_hi; float qscale; const float* rs; int blk;
    __device__ __forceinline__ void operator()(const f32x4 (&acc)[2][2][4][2], const Unit& u, int wr, int wc, int fr, int fq) const {
        const int row0 = u.pm * BM + wr * 64 + fr; const int col0 = u.pn * BM + wc * 32 + 8 * fq;
        f32x4 bv[2][2];
#pragma unroll
        for (int bj = 0; bj < 2; ++bj)
#pragma unroll
            for (int n = 0; n < 2; ++n) bv[bj][n] = bias ? *(const f32x4*)(bias + col0 + bj * HALF + 4 * n) : (f32x4){0.f, 0.f, 0.f, 0.f};
        const bool ropelane = (MODE == 2) && ((wc & 1) == 0) && (fq < 2);
#pragma unroll
        for (int ai = 0; ai < 2; ++ai)
#pragma unroll
            for (int m = 0; m < 4; ++m) { const int row = row0 + ai * HALF + m * 16; bf16_t* rowp = blk ? O + ((size_t)u.pm * blk + u.pn) * 65536 + (size_t)(row - u.pm * BM) * 256 + (col0 - u.pn * BM) : O + (size_t)row * ldc + col0;
                const float rsv = rs ? rs[row] : 1.0f;
                f32x4 c01 = (f32x4){1.f, 0.f, 1.f, 0.f}, c23 = (f32x4){1.f, 0.f, 1.f, 0.f};
                if (MODE == 2) { if (ropelane) { const float* cp = cs + (size_t)row * 16 + fq * 8; c01 = *(const f32x4*)cp; c23 = *(const f32x4*)(cp + 4); } }
#pragma unroll
                for (int bj = 0; bj < 2; ++bj) { f32x4 v0 = acc[ai][bj][m][0] * rsv + bv[bj][0], v1 = acc[ai][bj][m][1] * rsv + bv[bj][1];
                    if (MODE == 1) { v0 = __builtin_elementwise_max(v0, (f32x4){0.f, 0.f, 0.f, 0.f}); v1 = __builtin_elementwise_max(v1, (f32x4){0.f, 0.f, 0.f, 0.f}); v0 = v0 * v0; v1 = v1 * v1; }
                    if (MODE == 2) { const int cb = u.pn * BM + bj * HALF + wc * 32; const bool isq = cb >= q_lo && cb < q_hi, isk = cb >= k_lo && cb < k_hi;
                        if (ropelane && (isq || isk)) {
                            f32x4 r0, r1;
                            r0[0] = v0[0] * c01[0] - v0[1] * c01[1]; r0[1] = v0[1] * c01[0] + v0[0] * c01[1];
                            r0[2] = v0[2] * c01[2] - v0[3] * c01[3]; r0[3] = v0[3] * c01[2] + v0[2] * c01[3];
                            r1[0] = v1[0] * c23[0] - v1[1] * c23[1]; r1[1] = v1[1] * c23[0] + v1[0] * c23[1];
                            r1[2] = v1[2] * c23[2] - v1[3] * c23[3]; r1[3] = v1[3] * c23[2] + v1[2] * c23[3];
                            v0 = r0; v1 = r1; }
                        if (isq) { v0 = v0 * qscale; v1 = v1 * qscale; } }
                    u32x4 w; w.x = cvt_pk_bf16(v0[0], v0[1]); w.y = cvt_pk_bf16(v0[2], v0[3]); w.z = cvt_pk_bf16(v1[0], v1[1]); w.w = cvt_pk_bf16(v1[2], v1[3]);
                    *(u32x4*)(rowp + bj * HALF) = w; } }
    }
};
struct EpiU {
    static constexpr bool PERM = true, AFTER_DRAIN = false;
    bf16_t* O; int ldc; const float* rs;
    __device__ __forceinline__ void operator()(const f32x4 (&acc)[2][2][4][2], const Unit& u, int wr, int wc, int fr, int fq) const {
        const int row0 = u.pm * BM + wr * 64 + fr; bf16_t* base = O + 512 + (u.pn - 2) * 128 + wc * 32 + 8 * fq;
#pragma unroll
        for (int ai = 0; ai < 2; ++ai)
#pragma unroll
            for (int m = 0; m < 4; ++m) { const int row = row0 + ai * HALF + m * 16; const float r2 = rs[row] * rs[row];
                const f32x4 p0 = acc[ai][0][m][0] * acc[ai][1][m][0] * r2, p1 = acc[ai][0][m][1] * acc[ai][1][m][1] * r2;
                u32x4 w; w.x = cvt_pk_bf16(p0[0], p0[1]); w.y = cvt_pk_bf16(p0[2], p0[3]); w.z = cvt_pk_bf16(p1[0], p1[1]); w.w = cvt_pk_bf16(p1[2], p1[3]);
                *(u32x4*)(base + (size_t)row * ldc) = w; }
    }
};
struct EpiInProj {
    static constexpr bool PERM = true, AFTER_DRAIN = false;
    EpiX<2> ex; EpiU eu;
    __device__ __forceinline__ void operator()(const f32x4 (&acc)[2][2][4][2], const Unit& u, int wr, int wc, int fr, int fq) const {
        if (u.pn >= 2 && u.pn < 6) eu(acc, u, wr, wc, fr, fq); else ex(acc, u, wr, wc, fr, fq);
    }
};
struct SubsetOrder {
    StaticOrder so; int keep, skip;
    __host__ __device__ bool next(int i, Unit& u) const { if (!so.next(i, u)) return false; if (u.pn >= keep) u.pn += skip; return true; }
    __device__ __forceinline__ void a_ready(const Unit&) const {}
    __device__ __forceinline__ void done(const Unit&) const {}
};
template <class Epi, class Sched, bool ALIGN_EPI = false, bool SP2 = false, bool ABLK = false>
__device__ __forceinline__ void gemm_phase(PG8_LAS unsigned char* lds, const Gemm g, const Sched& S, const Epi& E) {
    int tid_ = threadIdx.x; asm volatile("" : "+v"(tid_));
    const int tid = tid_, wid = __builtin_amdgcn_readfirstlane(tid >> 6), lane = tid & 63, wr = wid >> 2, wc = wid & 3, fr = lane & 15, fq = lane >> 4;
    const int K = g.K, nt = K / BK;
    unsigned voffA[2], voffB[2];
#pragma unroll
    for (int i = 0; i < 2; ++i) { int R, C; stage_rc(tid * 16 + i * 8192, R, C); const int Rb = Epi::PERM ? ((R & ~31) + perm32(R & 31)) : R;
        voffA[i] = (unsigned)(R * (ABLK ? 256 : K) + C) * 2u; voffB[i] = (unsigned)(Rb * K + C) * 2u; }
    const size_t kstep = (size_t)(BK * 2);
    const size_t hstep = (size_t)HALF * K * 2;
    const size_t tstep = 2 * hstep;
    const size_t hstepA = ABLK ? (size_t)HALF * 256 * 2 : hstep;
#define PG8_KA(t) (ABLK ? ((size_t)((t) >> 2) * 131072 + (size_t)(((t) >> 1) & 1) * 256) : (size_t)(t) * kstep)
    const unsigned ldsw = (unsigned)wid * 1024u;
    const int aoff = lds_byte(wr * 64 + fr, fq * 8), boff = lds_byte(wc * 32 + fr, fq * 8);
#define PG8_SA(b, h) (((b) * 2 + (h)) * HTB)
#define PG8_SB(b, h) ((4 + (b) * 2 + (h)) * HTB)
#define PG8_STAGE(bufoff, gbase, voff) do { _Pragma("unroll") for (int _i = 0; _i < 2; ++_i) \
        __builtin_amdgcn_global_load_lds((const unsigned*)((const char*)(gbase) + (voff)[_i]), (PG8_LAS unsigned*)(lds + (bufoff) + ldsw + _i * 8192), 16, 0, 0); } while (0)
#define PG8_LDA(dst, b, h) do { _Pragma("unroll") for (int m = 0; m < 4; ++m) _Pragma("unroll") for (int k = 0; k < 2; ++k) dst[m][k] = *(const PG8_LAS bf16x8*)(lds + PG8_SA(b, h) + aoff + m * 2048 + k * 1024); } while (0)
#define PG8_LDB(dst, b, h) do { _Pragma("unroll") for (int n = 0; n < 2; ++n) _Pragma("unroll") for (int k = 0; k < 2; ++k) dst[n][k] = *(const PG8_LAS bf16x8*)(lds + PG8_SB(b, h) + boff + n * 2048 + k * 1024); } while (0)
#define PG8_MMA(ai, bj, At, Bt) do { __builtin_amdgcn_s_setprio(1); _Pragma("unroll") for (int m = 0; m < 4; ++m) _Pragma("unroll") for (int n = 0; n < 2; ++n) _Pragma("unroll") for (int k = 0; k < 2; ++k) \
        acc[ai][bj][m][n] = __builtin_amdgcn_mfma_f32_16x16x32_bf16(Bt[n][k], At[m][k], acc[ai][bj][m][n], 0, 0, 0); __builtin_amdgcn_s_setprio(0); } while (0)
#define PG8_WAIT_V(n) asm volatile("s_waitcnt vmcnt(" #n ")" ::: "memory")
#define PG8_WAIT_L(n) asm volatile("s_waitcnt lgkmcnt(" #n ")" ::: "memory")
#define PG8_BAR __builtin_amdgcn_s_barrier()
#define PG8_SCHED __builtin_amdgcn_sched_barrier(0)
    Unit cur, nxt; int ui = 0;
    if (!S.next(0, cur)) return;
    f32x4 acc[2][2][4][2];
#pragma unroll
    for (int a = 0; a < 2; ++a)
#pragma unroll
        for (int b = 0; b < 2; ++b)
#pragma unroll
            for (int m = 0; m < 4; ++m)
#pragma unroll
                for (int n = 0; n < 2; ++n) acc[a][b][m][n] = (f32x4){0.f, 0.f, 0.f, 0.f};
    bf16x8 At[4][2], B0[2][2], B1[2][2];
    const char* cA = (const char*)g.A + (size_t)cur.pm * tstep; const char* cB = (const char*)g.Bt + (size_t)cur.pn * tstep;
    S.a_ready(cur);
    if constexpr (SP2) {
        PG8_STAGE(PG8_SB(0, 0), cB, voffB); PG8_STAGE(PG8_SB(0, 1), cB + hstep, voffB); PG8_STAGE(PG8_SA(0, 0), cA, voffA); PG8_STAGE(PG8_SA(0, 1), cA + hstepA, voffA);
        if (wr == 1) PG8_BAR;
        PG8_WAIT_V(2); PG8_BAR;
        PG8_STAGE(PG8_SB(1, 0), cB + kstep, voffB); PG8_STAGE(PG8_SA(1, 0), cA + kstep, voffA); PG8_STAGE(PG8_SB(1, 1), cB + hstep + kstep, voffB);
        PG8_WAIT_V(6); PG8_BAR;
    } else {
        PG8_STAGE(PG8_SB(0, 0), cB, voffB); PG8_STAGE(PG8_SA(0, 0), cA, voffA); PG8_STAGE(PG8_SB(0, 1), cB + hstep, voffB); PG8_STAGE(PG8_SA(0, 1), cA + hstepA, voffA);
        if (wr == 1) PG8_BAR;
        PG8_WAIT_V(4); PG8_BAR;
        PG8_STAGE(PG8_SB(1, 0), cB + kstep, voffB); PG8_STAGE(PG8_SA(1, 0), cA + kstep, voffA); PG8_STAGE(PG8_SB(1, 1), cB + hstep + kstep, voffB);
        PG8_WAIT_V(6); PG8_BAR;
    }
    for (;;) {
        const bool has_next = S.next(ui + 1, nxt);
        const char* nA = has_next ? (const char*)g.A + (size_t)nxt.pm * tstep : cA; const char* nB = has_next ? (const char*)g.Bt + (size_t)nxt.pn * tstep : cB;
        for (int t = 0; t < nt; t += 2) {
            const bool last = (t == nt - 2);
            const char* a1 = cA + PG8_KA(t) + kstep;
            const char* a2 = last ? nA : cA + PG8_KA(t + 2); const char* b2 = last ? nB : cB + (size_t)(t + 2) * kstep;
            const char* a3 = a2 + kstep; const char* b3 = b2 + kstep;
            if (last && has_next) S.a_ready(nxt);
            if constexpr (SP2) {
            PG8_LDB(B0, 0, 0); PG8_LDB(B1, 0, 1); PG8_SCHED; PG8_LDA(At, 0, 0); PG8_STAGE(PG8_SA(1, 1), a1 + hstepA, voffA);
            PG8_WAIT_V(8); PG8_WAIT_L(0); PG8_BAR; PG8_MMA(0, 0, At, B0); PG8_MMA(0, 1, At, B1); PG8_BAR; PG8_SCHED;
            PG8_LDA(At, 0, 1); PG8_STAGE(PG8_SB(0, 0), b2, voffB); PG8_STAGE(PG8_SB(0, 1), b2 + hstep, voffB); PG8_STAGE(PG8_SA(0, 0), a2, voffA);
            PG8_WAIT_V(8); PG8_WAIT_L(0); PG8_BAR; PG8_MMA(1, 0, At, B0); PG8_MMA(1, 1, At, B1); PG8_BAR; PG8_SCHED;
            PG8_LDB(B0, 1, 0); PG8_LDB(B1, 1, 1); PG8_SCHED; PG8_LDA(At, 1, 0); PG8_STAGE(PG8_SA(0, 1), a2 + hstepA, voffA);
            PG8_WAIT_V(8); PG8_WAIT_L(0); PG8_BAR; PG8_MMA(0, 0, At, B0); PG8_MMA(0, 1, At, B1); PG8_BAR; PG8_SCHED;
            PG8_LDA(At, 1, 1); PG8_STAGE(PG8_SB(1, 0), b3, voffB); PG8_STAGE(PG8_SB(1, 1), b3 + hstep, voffB); PG8_STAGE(PG8_SA(1, 0), a3, voffA);
            PG8_WAIT_V(8); PG8_WAIT_L(0); PG8_BAR; PG8_MMA(1, 0, At, B0); PG8_MMA(1, 1, At, B1); PG8_BAR; PG8_SCHED;
            } else {
            PG8_LDB(B0, 0, 0); PG8_SCHED; PG8_LDA(At, 0, 0); PG8_STAGE(PG8_SA(1, 1), a1 + hstepA, voffA);
            PG8_WAIT_L(8); PG8_BAR; PG8_WAIT_L(0); PG8_MMA(0, 0, At, B0); PG8_BAR; PG8_SCHED;
            PG8_LDB(B1, 0, 1); PG8_STAGE(PG8_SB(0, 0), b2, voffB);
            PG8_BAR; PG8_WAIT_L(0); PG8_MMA(0, 1, At, B1); PG8_BAR;
            PG8_LDA(At, 0, 1); PG8_STAGE(PG8_SA(0, 0), a2, voffA);
            PG8_BAR; PG8_WAIT_L(0); PG8_MMA(1, 0, At, B0); PG8_BAR; PG8_SCHED;
            PG8_STAGE(PG8_SB(0, 1), b2 + hstep, voffB);
            PG8_WAIT_V(6); PG8_BAR; PG8_MMA(1, 1, At, B1); PG8_BAR;
            PG8_LDB(B0, 1, 0); PG8_SCHED; PG8_LDA(At, 1, 0); PG8_STAGE(PG8_SA(0, 1), a2 + hstepA, voffA);
            PG8_WAIT_L(8); PG8_BAR; PG8_WAIT_L(0); PG8_MMA(0, 0, At, B0); PG8_BAR; PG8_SCHED;
            PG8_LDB(B1, 1, 1); PG8_STAGE(PG8_SB(1, 0), b3, voffB);
            PG8_BAR; PG8_WAIT_L(0); PG8_MMA(0, 1, At, B1); PG8_BAR;
            PG8_LDA(At, 1, 1); PG8_STAGE(PG8_SA(1, 0), a3, voffA);
            PG8_BAR; PG8_WAIT_L(0); PG8_MMA(1, 0, At, B0); PG8_BAR; PG8_SCHED;
            PG8_STAGE(PG8_SB(1, 1), b3 + hstep, voffB);
            PG8_WAIT_V(6); PG8_BAR; PG8_MMA(1, 1, At, B1); PG8_BAR;
            }
        }
        if constexpr (ALIGN_EPI) { if (wr == 0) PG8_BAR; }
        if constexpr (!Epi::AFTER_DRAIN) { E(acc, cur, wr, wc, fr, fq); S.done(cur); }
        if (!has_next) break;
#pragma unroll
        for (int a = 0; a < 2; ++a)
#pragma unroll
            for (int b = 0; b < 2; ++b)
#pragma unroll
                for (int m = 0; m < 4; ++m)
#pragma unroll
                    for (int n = 0; n < 2; ++n) acc[a][b][m][n] = (f32x4){0.f, 0.f, 0.f, 0.f};
        cur = nxt; cA = nA; cB = nB; ++ui;
        if constexpr (ALIGN_EPI) { if (wr == 1) PG8_BAR; }
    }
    PG8_WAIT_V(0);
    if constexpr (!ALIGN_EPI) { if (wr == 0) PG8_BAR; }
    PG8_BAR;
    if constexpr (Epi::AFTER_DRAIN) { E.fused(acc, cur, wr, wc, fr, fq, lds, wid, lane); S.done(cur); }
#undef PG8_KA
#undef PG8_SA
#undef PG8_SB
#undef PG8_STAGE
#undef PG8_LDA
#undef PG8_LDB
#undef PG8_MMA
#undef PG8_WAIT_V
#undef PG8_WAIT_L
#undef PG8_BAR
#undef PG8_SCHED
}
}
#include <hip/hip_bf16.h>
#include <cmath>
namespace attn_body {
using bf16=__hip_bfloat16;
using bf16x8=__attribute__((ext_vector_type(8)))short;
using s16x4=__attribute__((ext_vector_type(4)))short;
using f32x16=__attribute__((ext_vector_type(16)))float;
using u32x4=__attribute__((ext_vector_type(4)))unsigned;
constexpr int SEQ=4096,D=64,PQ=3072,PO=1024;
constexpr int NW=8,QBLK=32,QB=QBLK*NW,KVBLK=64,NQB=SEQ/QB;
constexpr int ATTN_UNIT_ROWS=QB;
__device__ __forceinline__ int crow(int r,int hi){return (r&3)+8*(r>>2)+4*hi;}
#define SBAR() __builtin_amdgcn_sched_barrier(0)
__device__ __forceinline__ void cmask(f32x16&p0,f32x16&p1,int jb,int qrel,int hi){
  const float NEG=-INFINITY; int kb=64*jb+4*hi;
  #pragma unroll
  for(int r=0;r<16;++r){int kv=kb+(r&3)+8*(r>>2); if(kv>qrel)p0[r]=NEG; if(kv+32>qrel)p1[r]=NEG;}
}

constexpr int NSLOT=3, SLOTB=8192;
constexpr int LDS_K=0, LDS_V=NSLOT*SLOTB, LDS_WS=2*NSLOT*SLOTB, LDS_OST=LDS_WS+NW*64*4, LDS_BYTES=LDS_OST+NW*4096;
constexpr float C2=0.125f*1.4426950408889634f;
__device__ __forceinline__ void glds16(const void*gsrc,unsigned lds_dst){unsigned keep;
  asm volatile("s_mov_b32 %0, m0\n\ts_mov_b32 m0, %2\n\ts_nop 0\n\tglobal_load_lds_dwordx4 %1, off\n\ts_mov_b32 m0, %0":"=&s"(keep):"v"(gsrc),"s"(lds_dst):"memory");}
__device__ __forceinline__ float max3f(float a,float b,float c){float r;asm("v_max3_f32 %0, %1, %2, %3":"=v"(r):"v"(a),"v"(b),"v"(c));return r;}
__device__ __forceinline__ float max2f(float a,float b){float r;asm("v_max_f32_e32 %0, %1, %2":"=v"(r):"v"(a),"v"(b));return r;}
__device__ __forceinline__ float fadd_s(float a,float b){float r;asm("v_add_f32_e32 %0, %1, %2":"=v"(r):"v"(a),"v"(b));return r;}
__device__ __forceinline__ float fsub_s(float a,float b){float r;asm("v_sub_f32_e32 %0, %1, %2":"=v"(r):"v"(a),"v"(b));return r;}
typedef float f32x2_t __attribute__((ext_vector_type(2))); typedef __bf16 bf16x2_t __attribute__((ext_vector_type(2)));
__device__ __forceinline__ unsigned cvtpk_s(float lo,float hi){f32x2_t v={lo,hi};bf16x2_t b=__builtin_convertvector(v,bf16x2_t);return __builtin_bit_cast(unsigned,b);}
#define WAIT_BAR(N) asm volatile("s_waitcnt vmcnt(" #N ") lgkmcnt(0)\n\ts_barrier":::"memory")

__device__ __forceinline__ void qkt(f32x16&p0,f32x16&p1,const char*Kslot,const bf16x8*qr,const f32x16&negm,int r32,int hi){
  const char*kb=Kslot+hi*1024+r32*16;
  #pragma unroll
  for(int d0=0;d0<4;++d0){
    const bf16x8 b0=*reinterpret_cast<const bf16x8*>(kb+d0*2048);
    const bf16x8 b1=*reinterpret_cast<const bf16x8*>(kb+d0*2048+512);
    if(d0==0){p0=__builtin_amdgcn_mfma_f32_32x32x16_bf16(b0,qr[0],negm,0,0,0);p1=__builtin_amdgcn_mfma_f32_32x32x16_bf16(b1,qr[0],negm,0,0,0);}
    else{p0=__builtin_amdgcn_mfma_f32_32x32x16_bf16(b0,qr[d0],p0,0,0,0);p1=__builtin_amdgcn_mfma_f32_32x32x16_bf16(b1,qr[d0],p1,0,0,0);}}
}
typedef __attribute__((address_space(3))) const char* lds_cptr;
typedef short v4i16_t __attribute__((ext_vector_type(4)));
__device__ __forceinline__ void kload8(bf16x8*kf,lds_cptr kp){
  kf[0]=*(const __attribute__((address_space(3))) bf16x8*)(kp);      kf[1]=*(const __attribute__((address_space(3))) bf16x8*)(kp+512);
  kf[2]=*(const __attribute__((address_space(3))) bf16x8*)(kp+2048); kf[3]=*(const __attribute__((address_space(3))) bf16x8*)(kp+2560);
  kf[4]=*(const __attribute__((address_space(3))) bf16x8*)(kp+4096); kf[5]=*(const __attribute__((address_space(3))) bf16x8*)(kp+4608);
  kf[6]=*(const __attribute__((address_space(3))) bf16x8*)(kp+6144); kf[7]=*(const __attribute__((address_space(3))) bf16x8*)(kp+6656);
}
__device__ __forceinline__ void kload2(bf16x8*kf,lds_cptr kp,int j){ kf[2*j]=*(const __attribute__((address_space(3))) bf16x8*)(kp+j*2048); kf[2*j+1]=*(const __attribute__((address_space(3))) bf16x8*)(kp+j*2048+512); }
__device__ __forceinline__ s16x4 vtr(lds_cptr p){ return __builtin_bit_cast(s16x4,__builtin_amdgcn_ds_read_tr16_b64_v4i16((__attribute__((address_space(3))) v4i16_t*)p)); }
__device__ __forceinline__ float rowmax(const f32x16&p0,const f32x16&p1){
  float a=max3f(p0[0],p0[1],p1[0]),b=max3f(p0[2],p0[3],p1[1]);a=max3f(a,p1[2],p1[3]);
  #pragma unroll
  for(int r=4;r<16;r+=4){a=max3f(a,p0[r],p0[r+1]);b=max3f(b,p0[r+2],p0[r+3]);a=max3f(a,p1[r],p1[r+1]);b=max3f(b,p1[r+2],p1[r+3]);}
  const float m=max2f(a,b);
  auto rr=__builtin_amdgcn_permlane32_swap(__float_as_uint(m),__float_as_uint(m),false,false);
  return max2f(__uint_as_float(rr[0]),__uint_as_float(rr[1]));
}
__device__ __forceinline__ void pv(f32x16*o,int vb,bf16x8 pa0,bf16x8 pa1,bf16x8 pa2,bf16x8 pa3){
  #pragma unroll
  for(int d0=0;d0<2;++d0){s16x4 lo[4],hi[4];
    #pragma unroll
    for(int ks=0;ks<4;++ks){
      asm volatile("ds_read_b64_tr_b16 %0,%1 offset:%c2":"=&v"(lo[ks]):"v"(vb),"i"(d0*4096+ks*1024):"memory");
      asm volatile("ds_read_b64_tr_b16 %0,%1 offset:%c2":"=&v"(hi[ks]):"v"(vb),"i"(d0*4096+ks*1024+512):"memory");}
    asm volatile("s_waitcnt lgkmcnt(0)":::"memory");SBAR();
    #define PK(k) (bf16x8){lo[k][0],lo[k][1],lo[k][2],lo[k][3],hi[k][0],hi[k][1],hi[k][2],hi[k][3]}
    o[d0]=__builtin_amdgcn_mfma_f32_32x32x16_bf16(pa0,PK(0),o[d0],0,0,0);
    o[d0]=__builtin_amdgcn_mfma_f32_32x32x16_bf16(pa1,PK(1),o[d0],0,0,0);
    o[d0]=__builtin_amdgcn_mfma_f32_32x32x16_bf16(pa2,PK(2),o[d0],0,0,0);
    o[d0]=__builtin_amdgcn_mfma_f32_32x32x16_bf16(pa3,PK(3),o[d0],0,0,0);
    #undef PK
  }
}

#ifndef ATTN_STORE16
#define ATTN_STORE16(p,v) (*(u32x4*)(p)=(v))
#endif
template<int THRL> __device__ __forceinline__ void attn_unit(int b,int qb,const bf16*Q,const bf16*__restrict__ K,const bf16*__restrict__ V,bf16*O,char*shm){
  int tid_=threadIdx.x; asm volatile("":"+v"(tid_)); const int tid=tid_,lane=tid&63,r32=lane&31,hi=lane>>5; const int wid=__builtin_amdgcn_readfirstlane(tid>>6);
  const long rowbase=(long)b*SEQ; const int q0=qb*QB;
  const bf16*Qw=Q+(rowbase+q0+wid*QBLK)*PQ;
  const bf16*Kh=K+rowbase*PQ,*Vh=V+rowbase*PQ;
  const unsigned lds0=(unsigned)(uintptr_t)shm;
  float*wsf=(float*)(shm+LDS_WS)+wid*64;
  const bf16*ksrc=Kh+(long)lane*PQ+wid*8;
  const bf16*vsrc=Vh+(long)(16*(wid&3)+(lane>>2))*PQ+(wid>>2)*32+(lane&3)*8;
  const unsigned kdst=lds0+LDS_K+wid*1024, vdst=lds0+LDS_V+wid*1024;
  #define DMA_K(t,slot) glds16(ksrc+(long)(t)*KVBLK*PQ,(unsigned)__builtin_amdgcn_readfirstlane(kdst+(slot)))
  #define DMA_V(t,slot) glds16(vsrc+(long)(t)*KVBLK*PQ,(unsigned)__builtin_amdgcn_readfirstlane(vdst+(slot)))
  const int vb0=(int)(lds0+LDS_V)+((lane>>4)&1)*32+(lane&3)*8+(4*hi+((lane&15)>>2))*64;
  const char*Kbase=shm+LDS_K; bf16x8 kf[8];
  const lds_cptr shm3=(lds_cptr)shm; const lds_cptr kp0=shm3+LDS_K+hi*1024+r32*16; const lds_cptr vp0=shm3+LDS_V+((lane>>4)&1)*32+(lane&3)*8+(4*hi+((lane&15)>>2))*64;
  const int NT=(q0+QB)/KVBLK;
  DMA_K(0,0);DMA_V(0,0);DMA_K(1,SLOTB);
  bf16x8 qr[4];
  #pragma unroll
  for(int d0=0;d0<4;++d0)qr[d0]=*reinterpret_cast<const bf16x8*>(&Qw[(long)r32*PQ+d0*16+hi*8]);
  float mhat=0.f,l_reg=0.f;f32x16 o[2];o[0]=f32x16{};o[1]=f32x16{};f32x16 negm=f32x16{};asm volatile("":"+v"(negm));
  const int qrel=wid*QBLK+r32;
  #define CMASK(P0,P1,t) do{int jb_=(t)-(NT-4); if(jb_>=0)cmask(P0,P1,jb_,qrel,hi);}while(0)
  bool resc=false;
  #define START(P0,P1) do{ const float rm=rowmax(P0,P1); resc=false; \
    { const float dl=rm; mhat=fadd_s(mhat,dl); \
      _Pragma("unroll") for(int r=0;r<16;++r){P0[r]=fsub_s(P0[r],dl);P1[r]=fsub_s(P1[r],dl);} \
      _Pragma("unroll") for(int r=0;r<16;++r)negm[r]=-mhat; asm volatile("":"+v"(negm)); } \
    _Pragma("unroll") for(int r=0;r<16;++r)P0[r]=__builtin_amdgcn_exp2f(P0[r]); }while(0)
  #define RESC() do{ if(resc){ asm volatile("s_waitcnt lgkmcnt(0)":::"memory"); \
      _Pragma("unroll") for(int d_=0;d_<2;++d_) _Pragma("unroll") for(int r=0;r<16;++r)o[d_][r]*=wsf[crow(r,hi)]; } }while(0)
  f32x16 pA0,pA1,pB0,pB1;
  int sl_prev=0,sl_cur=0,sl_next=SLOTB;
  #define ROT() do{sl_prev=sl_cur;sl_cur=sl_next;sl_next=(sl_next==(NSLOT-1)*SLOTB)?0:sl_next+SLOTB;}while(0)
  DMA_K(2,2*SLOTB);
  WAIT_BAR(3);
  qkt(pA0,pA1,Kbase,qr,negm,r32,hi);asm volatile("s_nop 15\n\ts_nop 7":"+v"(pA0),"+v"(pA1));CMASK(pA0,pA1,0);
  START(pA0,pA1);
  _Pragma("unroll") for(int r=0;r<16;++r)pA1[r]=__builtin_amdgcn_exp2f(pA1[r]);
  WAIT_BAR(0);
  DMA_K(3,0);DMA_V(1,SLOTB);
  ROT();
  kload8(kf,kp0+sl_cur);
  WAIT_BAR(2);
  s16x4 vlo[8],vhi[8]; u32x4 pw0,pw1,pw2,pw3;
  #define PKW(P,B) cvtpk_s(P[B],P[B+1])
  #define PAF(k) __builtin_bit_cast(bf16x8,pw##k)
  #define VFR(i) (bf16x8){vlo[i][0],vlo[i][1],vlo[i][2],vlo[i][3],vhi[i][0],vhi[i][1],vhi[i][2],vhi[i][3]}
  #define PIN(x) asm volatile("":"+v"(x))
  #define MX3(a,b,c) __builtin_fmaxf(__builtin_fmaxf((a),(b)),(c))
  #define GAPA(MF,A0,A1,A2,A3,W0,W1,PW) do{ MF; sacc+=A0; sacc+=A1; sacc+=A2; sacc+=A3; PIN(sacc); W0; W1; PIN(PW); SBAR(); }while(0)
  #define EX(v) __builtin_amdgcn_exp2f(v)
  #define GAPB(MF,X,B) do{ MF; X[B]=EX(X[B]); X[B+1]=EX(X[B+1]); X[B+2]=EX(X[B+2]); X[B+3]=EX(X[B+3]); PIN(X); SBAR(); }while(0)
  #define VRD(i) do{ vlo[i]=vtr(vp_+(((i)>>2)*4096+((i)&3)*1024)); vhi[i]=vtr(vp_+(((i)>>2)*4096+((i)&3)*1024+512)); }while(0)
  #define KRD(G,j) do{ if(G){ kload2(kf,kp0+sl_next,j); SBAR(); } }while(0)
  #define STEP(C0,C1,P0,P1,t,GK,GV,GL) do{ SBAR(); \
    const lds_cptr vp_=vp0+sl_prev; \
    VRD(0); SBAR(); float sacc=(P0[0]+P0[1]); \
    GAPA(C0=__builtin_amdgcn_mfma_f32_32x32x16_bf16(kf[0],qr[0],negm,0,0,0), P0[2],P0[3],P0[4],P0[5],     pw0[0]=PKW(P0,0), pw0[1]=PKW(P0,2), pw0); \
    VRD(4); SBAR(); GAPA(C1=__builtin_amdgcn_mfma_f32_32x32x16_bf16(kf[1],qr[0],negm,0,0,0), P0[6],P0[7],P0[8],P0[9],     pw0[2]=PKW(P0,4), pw0[3]=PKW(P0,6), pw0); \
    VRD(1); SBAR(); GAPA(C0=__builtin_amdgcn_mfma_f32_32x32x16_bf16(kf[2],qr[1],C0,0,0,0),   P0[10],P0[11],P0[12],P0[13], pw1[0]=PKW(P0,8), pw1[1]=PKW(P0,10), pw1); \
    VRD(5); SBAR(); GAPA(C1=__builtin_amdgcn_mfma_f32_32x32x16_bf16(kf[3],qr[1],C1,0,0,0),   P0[14],P0[15],P1[0],P1[1],   pw1[2]=PKW(P0,12),pw1[3]=PKW(P0,14), pw1); \
    VRD(2); SBAR(); GAPA(C0=__builtin_amdgcn_mfma_f32_32x32x16_bf16(kf[4],qr[2],C0,0,0,0),   P1[2],P1[3],P1[4],P1[5],     pw2[0]=PKW(P1,0), pw2[1]=PKW(P1,2), pw2); \
    VRD(6); SBAR(); GAPA(C1=__builtin_amdgcn_mfma_f32_32x32x16_bf16(kf[5],qr[2],C1,0,0,0),   P1[6],P1[7],P1[8],P1[9],     pw2[2]=PKW(P1,4), pw2[3]=PKW(P1,6), pw2); \
    VRD(3); SBAR(); GAPA(C0=__builtin_amdgcn_mfma_f32_32x32x16_bf16(kf[6],qr[3],C0,0,0,0),   P1[10],P1[11],P1[12],P1[13], pw3[0]=PKW(P1,8), pw3[1]=PKW(P1,10), pw3); \
    VRD(7); SBAR(); GAPA(C1=__builtin_amdgcn_mfma_f32_32x32x16_bf16(kf[7],qr[3],C1,0,0,0),   P1[14],P1[15],0.f,0.f,       pw3[2]=PKW(P1,12),pw3[3]=PKW(P1,14), pw3); \
    l_reg+=sacc; \
    if(GK){DMA_K((t)+3,sl_cur);} if(GV){DMA_V((t)+1,sl_next);} \
    CMASK(C0,C1,t); \
    { float a=MX3(C0[0],C0[1],C1[0]),b=MX3(C0[2],C0[3],C1[1]); a=MX3(a,C1[2],C1[3]); \
      _Pragma("unroll") for(int r=4;r<16;r+=4){a=MX3(a,C0[r],C0[r+1]);b=MX3(b,C0[r+2],C0[r+3]);a=MX3(a,C1[r],C1[r+1]);b=MX3(b,C1[r+2],C1[r+3]);} \
      float rm=__builtin_fmaxf(a,b); { auto rr=__builtin_amdgcn_permlane32_swap(__float_as_uint(rm),__float_as_uint(rm),false,false); rm=__builtin_fmaxf(__uint_as_float(rr[0]),__uint_as_float(rr[1])); } \
      resc=false; \
      if(__builtin_expect(__any(rm>(float)THRL),0)){ const float dl=__builtin_fmaxf(rm,0.f); mhat+=dl; \
        _Pragma("unroll") for(int r=0;r<16;++r){C0[r]-=dl;C1[r]-=dl;} \
        _Pragma("unroll") for(int r=0;r<16;++r)negm[r]=-mhat; asm volatile("":"+v"(negm)); \
        const float f=__builtin_amdgcn_exp2f(-dl); l_reg*=f; if(hi==0)wsf[r32]=f; resc=true; } } \
    SBAR(); \
    GAPB(o[0]=__builtin_amdgcn_mfma_f32_32x32x16_bf16(PAF(0),VFR(0),o[0],0,0,0), C0,0); \
    GAPB(o[1]=__builtin_amdgcn_mfma_f32_32x32x16_bf16(PAF(0),VFR(4),o[1],0,0,0), C0,4); \
    KRD(GL,0); GAPB(o[0]=__builtin_amdgcn_mfma_f32_32x32x16_bf16(PAF(1),VFR(1),o[0],0,0,0), C0,8); \
    KRD(GL,1); GAPB(o[1]=__builtin_amdgcn_mfma_f32_32x32x16_bf16(PAF(1),VFR(5),o[1],0,0,0), C0,12); \
    KRD(GL,2); GAPB(o[0]=__builtin_amdgcn_mfma_f32_32x32x16_bf16(PAF(2),VFR(2),o[0],0,0,0), C1,0); \
    KRD(GL,3); GAPB(o[1]=__builtin_amdgcn_mfma_f32_32x32x16_bf16(PAF(2),VFR(6),o[1],0,0,0), C1,4); \
    GAPB(o[0]=__builtin_amdgcn_mfma_f32_32x32x16_bf16(PAF(3),VFR(3),o[0],0,0,0), C1,8); \
    GAPB(o[1]=__builtin_amdgcn_mfma_f32_32x32x16_bf16(PAF(3),VFR(7),o[1],0,0,0), C1,12); \
    }while(0)
  int t=1;
  #undef CMASK
  #define CMASK(P0,P1,t) do{}while(0)
  for(;t+5<NT;t+=2){
    STEP(pB0,pB1,pA0,pA1,t,true,true,true);     WAIT_BAR(2); RESC(); ROT();
    STEP(pA0,pA1,pB0,pB1,t+1,true,true,true);   WAIT_BAR(2); RESC(); ROT();
  }
  #undef CMASK
  #define CMASK(P0,P1,t) do{int jb_=(t)-(NT-4); if(jb_>=0)cmask(P0,P1,jb_,qrel,hi);}while(0)
  #define ENDW(tt) do{ if((tt)+3<NT){WAIT_BAR(2);} else if((tt)+2<NT){WAIT_BAR(1);} else {WAIT_BAR(0);} }while(0)
  for(;t+1<NT;t+=2){
    STEP(pB0,pB1,pA0,pA1,t,(t+3<NT),(t+1<NT),(t+1<NT));       ENDW(t);   RESC(); ROT();
    STEP(pA0,pA1,pB0,pB1,t+1,(t+4<NT),(t+2<NT),(t+2<NT));     ENDW(t+1); RESC(); ROT();
  }
  STEP(pB0,pB1,pA0,pA1,NT-1,false,false,false); RESC();
  { float sacc=pB0[0]+pB0[1]; _Pragma("unroll") for(int r=2;r<16;++r)sacc+=pB0[r]; _Pragma("unroll") for(int r=0;r<16;++r)sacc+=pB1[r]; l_reg+=sacc;
    pw0=(u32x4){PKW(pB0,0),PKW(pB0,2),PKW(pB0,4),PKW(pB0,6)};pw1=(u32x4){PKW(pB0,8),PKW(pB0,10),PKW(pB0,12),PKW(pB0,14)};pw2=(u32x4){PKW(pB1,0),PKW(pB1,2),PKW(pB1,4),PKW(pB1,6)};pw3=(u32x4){PKW(pB1,8),PKW(pB1,10),PKW(pB1,12),PKW(pB1,14)};
    SBAR(); pv(o,vb0+sl_cur,PAF(0),PAF(1),PAF(2),PAF(3)); }
  #undef PKW
  #undef PAF
  #undef VFR
  #undef PIN
  #undef MX3
  #undef GAPA
  #undef GAPB
  #undef EX
  #undef VRD
  #undef KRD
  #undef STEP
  #undef ENDW
  {auto rr=__builtin_amdgcn_permlane32_swap(__float_as_uint(l_reg),__float_as_uint(l_reg),false,false);l_reg=__uint_as_float(rr[0])+__uint_as_float(rr[1]);}
  if(hi==0)wsf[32+r32]=l_reg;asm volatile("s_waitcnt lgkmcnt(0)":::"memory");
  float rli[16];
  #pragma unroll
  for(int r=0;r<16;++r)rli[r]=__builtin_amdgcn_rcpf(wsf[32+crow(r,hi)]);
  bf16*Ow=O+(rowbase+q0+wid*QBLK)*PO;
  { bf16*stg=(bf16*)(shm+LDS_OST)+wid*2048;
    #pragma unroll
    for(int r=0;r<16;++r){const int orow=crow(r,hi);
      #pragma unroll
      for(int d0=0;d0<2;++d0)stg[orow*64+d0*32+r32]=__float2bfloat16(o[d0][r]*rli[r]);}
    asm volatile("s_waitcnt lgkmcnt(0)":::"memory");
    #pragma unroll
    for(int i=0;i<4;++i){const int row=i*8+(lane>>3),ch=lane&7; const u32x4 v=*(const u32x4*)(stg+row*64+ch*8); ATTN_STORE16(Ow+(long)row*PO+ch*8,v);} }
  asm volatile("s_waitcnt lgkmcnt(0)\n\ts_barrier":::"memory");
  #undef DMA_K
  #undef DMA_V
  #undef CMASK
  #undef START
  #undef RESC
  #undef ROT
}
constexpr int ATTN_LDS_BYTES=LDS_BYTES;
#undef SBAR
#undef WAIT_BAR
}
#define GAS __attribute__((address_space(1)))
#define LAS __attribute__((address_space(3)))
typedef unsigned short bf16;
typedef unsigned v4u __attribute__((ext_vector_type(4)));
typedef unsigned v2u __attribute__((ext_vector_type(2)));
typedef float f32x4 __attribute__((ext_vector_type(4)));
typedef float f32x16 __attribute__((ext_vector_type(16)));
typedef short bf16x8 __attribute__((ext_vector_type(8)));
#define LDS_WAIT() asm volatile("s_waitcnt lgkmcnt(0)" ::: "memory")

constexpr int NWAVES = 8;
constexpr int BATCH = 8, SEQ = 4096, DMODEL = 1024, FF = 4096;
constexpr int M = BATCH * SEQ;
constexpr int EVEN_IN = 3072, ODD_IN = 1280;
constexpr float C2 = 0.125f * 1.4426950408889634f;
constexpr float LOG2E = 1.4426950408889634f;
constexpr float RMS_EPS = 1e-6f, DIFF_EPS = 1e-5f;
constexpr float LAM_INIT0 = 0.2f;

constexpr size_t MiB = 1u << 20;
constexpr int RING_BYTES = 131072;
constexpr int LDS_BYTES = 147456;
constexpr size_t WS_WIN = 2 * MiB, WS_WOUT = 8 * MiB, WS_WQKV = 10 * MiB, WS_WO = 13 * MiB, WS_W1 = 16 * MiB  , WS_W2 = 32 * MiB  ;
constexpr size_t WS_CS = 48 * MiB  , WS_BQKV = 50 * MiB, WS_RS = 51 * MiB  ;
constexpr size_t WS_BAR = 0;
constexpr int MISC_OFF = RING_BYTES + 320;
constexpr size_t WS_XN = 64 * MiB;
constexpr size_t WS_A2 = 448 * MiB;
constexpr size_t WS_H = 128 * MiB;
constexpr size_t WS_PROJ = 192 * MiB;
constexpr size_t WS_ATT = 384 * MiB;
constexpr size_t WS_HF = 192 * MiB;
constexpr size_t WS_END = 512 * MiB;


struct Args {
    const float* x; const int* pos;
    const float *npre_mix, *npost_mix, *npre_mlp, *npost_mlp;
    const float *w_in, *conv_w, *lq1, *lk1, *lq2, *lk2, *subln, *w_out;
    const float *w_qkv, *b_qkv, *sinks, *w_o, *b_o, *w1, *w2;
    float* out; unsigned char* ws;
    float inv_freq[8];
};

__device__ __forceinline__ float wave_sum(float v) {
#pragma unroll
    for (int o = 1; o < 64; o <<= 1) v += __shfl_xor(v, o);
    return v;
}
__device__ __forceinline__ unsigned f2bf(float f) { unsigned u = __builtin_bit_cast(unsigned, f); return (u + 0x7fffu + ((u >> 16) & 1u)) >> 16; }
__device__ __forceinline__ unsigned pk2(float lo, float hi) { return f2bf(lo) | (f2bf(hi) << 16); }
__device__ __forceinline__ float bflo(unsigned w) { return __builtin_bit_cast(float, w << 16); }
__device__ __forceinline__ float bfhi(unsigned w) { return __builtin_bit_cast(float, w & 0xffff0000u); }
__device__ __forceinline__ int mapcol(int n) { const int hl = n & 63; return hl < 16 ? (n & ~63) + (hl >> 1) + 8 * (hl & 1) : n; }

__device__ __forceinline__ void p0_transpose_item(const float* W, int K, int N, bf16* WT, LAS float* scr, int item, int lane, int perm_lo, int perm_hi, const float* g) {
    const int nblk = N / 32, kb = item / nblk, nb = item % nblk, k0 = 64 * kb, n0 = 32 * nb;
    int ncol = n0 + (lane & 31); if (ncol >= perm_lo && ncol < perm_hi) ncol = mapcol(ncol);
    if (perm_lo == 1536 && ncol >= 512 && ncol < 1536) { const int w_ = (ncol - 512) & 255, tt_ = (ncol - 512) >> 8; ncol = (w_ < 128 ? 512 : 1024 - 128) + 128 * tt_ + w_; }
    float wv[32];
#pragma unroll
    for (int i = 0; i < 32; ++i) { const int kk = 2 * i + (lane >> 5); wv[i] = __builtin_nontemporal_load(W + (size_t)(k0 + kk) * N + ncol); }
    if (g) {
#pragma unroll
        for (int i = 0; i < 32; ++i) { const int kk = 2 * i + (lane >> 5); wv[i] *= g[k0 + kk]; } }
#pragma unroll
    for (int i = 0; i < 32; ++i) { const int kk = 2 * i + (lane >> 5); scr[kk * 33 + (lane & 31)] = wv[i]; }
    LDS_WAIT(); asm volatile("" ::: "memory");
    const int c = lane & 7;
#pragma unroll
    for (int j = 0; j < 4; ++j) { const int n = (lane >> 3) + 8 * j; const LAS float* s = scr + (8 * c) * 33 + n;
        v4u o; o.x = pk2(s[0 * 33], s[1 * 33]); o.y = pk2(s[2 * 33], s[3 * 33]); o.z = pk2(s[4 * 33], s[5 * 33]); o.w = pk2(s[6 * 33], s[7 * 33]);
        *(GAS v4u*)(WT + (size_t)(n0 + n) * K + k0 + 8 * c) = o; }
    LDS_WAIT(); asm volatile("" ::: "memory");
}

__device__ __forceinline__ void unpack8(const v4u w, float (&f)[8]) { f[0] = bflo(w.x); f[1] = bfhi(w.x); f[2] = bflo(w.y); f[3] = bfhi(w.y); f[4] = bflo(w.z); f[5] = bfhi(w.z); f[6] = bflo(w.w); f[7] = bfhi(w.w); }
template <int RPI> __device__ __forceinline__ void x_rows_to_bf16(const float* x, bf16* XB, float* rsp, int row0, int lane) {
    f32x4 v[RPI][4];
#pragma unroll
    for (int r = 0; r < RPI; ++r) { const GAS f32x4* xr = (const GAS f32x4*)(x + (size_t)(row0 + r) * DMODEL) + lane;
#pragma unroll
        for (int j = 0; j < 4; ++j) v[r][j] = __builtin_nontemporal_load(xr + 64 * j); }
    float s[RPI];
#pragma unroll
    for (int r = 0; r < RPI; ++r) { s[r] = 0.f; GAS unsigned long long* o8 = (GAS unsigned long long*)(XB + (size_t)(row0 + r) * DMODEL) + lane;
#pragma unroll
        for (int j = 0; j < 4; ++j) { s[r] += (v[r][j].x * v[r][j].x + v[r][j].y * v[r][j].y) + (v[r][j].z * v[r][j].z + v[r][j].w * v[r][j].w);
            o8[64 * j] = (unsigned long long)pk2(v[r][j].x, v[r][j].y) | ((unsigned long long)pk2(v[r][j].z, v[r][j].w) << 32); } }
#pragma unroll
    for (int o = 1; o < 64; o <<= 1)
#pragma unroll
        for (int r = 0; r < RPI; ++r) s[r] += __shfl_xor(s[r], o);
#pragma unroll
    for (int r = 0; r < RPI; ++r) if (lane == r) rsp[row0 + r] = 1.f / sqrtf(s[r] * (1.f / DMODEL) + RMS_EPS);
}

template <int RPI> __device__ __forceinline__ void nr_pass(int gw, int NGW, int lane_, const bf16* H, bf16* XB, const float* wpost, float* rsout, float* outf) {
    int lane = lane_; asm volatile("" : "+v"(lane));
    f32x4 wp[2][2];
#pragma unroll
    for (int j = 0; j < 2; ++j)
#pragma unroll
        for (int e = 0; e < 2; ++e) wp[j][e] = *(const f32x4*)(wpost + 8 * lane + 512 * j + 4 * e);
    for (int row0 = gw * RPI; row0 < M; row0 += NGW * RPI) {
        v4u hw[RPI][2], xw[RPI][2];
#pragma unroll
        for (int r = 0; r < RPI; ++r)
#pragma unroll
            for (int j = 0; j < 2; ++j) { hw[r][j] = __builtin_nontemporal_load((const GAS v4u*)(H + (size_t)(row0 + r) * DMODEL + 8 * lane + 512 * j)); xw[r][j] = *(const GAS v4u*)(XB + (size_t)(row0 + r) * DMODEL + 8 * lane + 512 * j); }
        float ss[RPI];
#pragma unroll
        for (int r = 0; r < RPI; ++r) { ss[r] = 0.f;
#pragma unroll
            for (int j = 0; j < 2; ++j) { float f[8]; unpack8(hw[r][j], f);
#pragma unroll
                for (int e = 0; e < 8; ++e) ss[r] += f[e] * f[e]; } }
#pragma unroll
        for (int o = 1; o < 64; o <<= 1)
#pragma unroll
            for (int r = 0; r < RPI; ++r) ss[r] += __shfl_xor(ss[r], o);
        float s2[RPI];
#pragma unroll
        for (int r = 0; r < RPI; ++r) { const float rs = 1.f / sqrtf(ss[r] * (1.f / DMODEL) + RMS_EPS); s2[r] = 0.f;
#pragma unroll
            for (int j = 0; j < 2; ++j) { float f[8], x[8]; unpack8(hw[r][j], f); unpack8(xw[r][j], x);
                f32x4 x0 = (f32x4){x[0], x[1], x[2], x[3]} + (f32x4){f[0], f[1], f[2], f[3]} * rs * wp[j][0], x1 = (f32x4){x[4], x[5], x[6], x[7]} + (f32x4){f[4], f[5], f[6], f[7]} * rs * wp[j][1];
                s2[r] += ((x0.x * x0.x + x0.y * x0.y) + (x0.z * x0.z + x0.w * x0.w)) + ((x1.x * x1.x + x1.y * x1.y) + (x1.z * x1.z + x1.w * x1.w));
                if (outf) { *(GAS f32x4*)(outf + (size_t)(row0 + r) * DMODEL + 8 * lane + 512 * j) = x0; *(GAS f32x4*)(outf + (size_t)(row0 + r) * DMODEL + 8 * lane + 512 * j + 4) = x1; }
                else { v4u o; o.x = pk2(x0.x, x0.y); o.y = pk2(x0.z, x0.w); o.z = pk2(x1.x, x1.y); o.w = pk2(x1.z, x1.w); *(GAS v4u*)(XB + (size_t)(row0 + r) * DMODEL + 8 * lane + 512 * j) = o; } } }
        if (rsout) {
#pragma unroll
            for (int o = 1; o < 64; o <<= 1)
#pragma unroll
                for (int r = 0; r < RPI; ++r) s2[r] += __shfl_xor(s2[r], o);
#pragma unroll
            for (int r = 0; r < RPI; ++r) if (lane == r) rsout[row0 + r] = 1.f / sqrtf(s2[r] * (1.f / DMODEL) + RMS_EPS);
        }
    }
}


__device__ __forceinline__ void mix_pass(int gw, int NGW, int lane_, const bf16* PROJ, const bf16* ATT, bf16* A2, const float* conv_w, const float* subln, float lam) {
    int lane = lane_; asm volatile("" : "+v"(lane));
    float cw[3][8], sw[8];
#pragma unroll
    for (int i = 0; i < 3; ++i)
#pragma unroll
        for (int e = 0; e < 8; ++e) cw[i][e] = conv_w[i * 512 + 8 * lane + e];
#pragma unroll
    for (int e = 0; e < 8; ++e) sw[e] = subln[(lane & 15) * 8 + e] * (1.0f - LAM_INIT0);
    for (int row0 = gw * 2; row0 < M; row0 += NGW * 2) {
        const int t0 = row0 & (SEQ - 1);
        const bf16* pr = PROJ + (size_t)row0 * EVEN_IN + 8 * lane;
        const bf16* ar = ATT + (size_t)row0 * DMODEL + (lane >> 4) * 256 + (lane & 15) * 8;
        v4u gbw[2], uw[4], o0w[2], o1w[2];
#pragma unroll
        for (int r = 0; r < 2; ++r) { gbw[r] = *(const GAS v4u*)(pr + r * EVEN_IN); o0w[r] = *(const GAS v4u*)(ar + r * DMODEL); o1w[r] = *(const GAS v4u*)(ar + r * DMODEL + 128); }
#pragma unroll
        for (int r = 0; r < 4; ++r) { if (r >= 2 || t0 > 0) uw[r] = *(const GAS v4u*)(pr + (r - 2) * EVEN_IN + 512);
            else uw[r] = (v4u){0u, 0u, 0u, 0u}; }
        float u[4][8];
#pragma unroll
        for (int r = 0; r < 4; ++r) unpack8(uw[r], u[r]);
#pragma unroll
        for (int r = 0; r < 2; ++r) { float gb[8], co[8]; unpack8(gbw[r], gb);
#pragma unroll
            for (int e = 0; e < 8; ++e) co[e] = gb[e] * (cw[0][e] * u[r][e] + cw[1][e] * u[r + 1][e] + cw[2][e] * u[r + 2][e]);
            v4u o; o.x = pk2(co[0], co[1]); o.y = pk2(co[2], co[3]); o.z = pk2(co[4], co[5]); o.w = pk2(co[6], co[7]);
            *(GAS v4u*)(A2 + (size_t)(row0 + r) * DMODEL + 8 * lane) = o; }
#pragma unroll
        for (int r = 0; r < 2; ++r) { float o0[8], o1[8], d[8]; unpack8(o0w[r], o0); unpack8(o1w[r], o1);
            float ss = 0.f;
#pragma unroll
            for (int e = 0; e < 8; ++e) { d[e] = o0[e] - lam * o1[e]; ss += d[e] * d[e]; }
            ss += __shfl_xor(ss, 1); ss += __shfl_xor(ss, 2); ss += __shfl_xor(ss, 4); ss += __shfl_xor(ss, 8);
            const float rs = 1.f / sqrtf(ss * (1.f / 128.f) + DIFF_EPS);
#pragma unroll
            for (int e = 0; e < 8; ++e) d[e] = d[e] * rs * sw[e];
            v4u o; o.x = pk2(d[0], d[1]); o.y = pk2(d[2], d[3]); o.z = pk2(d[4], d[5]); o.w = pk2(d[6], d[7]);
            *(GAS v4u*)(A2 + (size_t)(row0 + r) * DMODEL + 512 + 8 * lane) = o; }
    }
}

__device__ __forceinline__ int crow16(int r, int hi) { return (r & 3) + 8 * (r >> 2) + 4 * hi; }
__device__ __forceinline__ unsigned cvtpk(float lo, float hi) { typedef float f2 __attribute__((ext_vector_type(2))); typedef __bf16 b2 __attribute__((ext_vector_type(2))); f2 v = {lo, hi}; b2 b = __builtin_convertvector(v, b2); return __builtin_bit_cast(unsigned, b); }

constexpr int VTP = 264;
__device__ __forceinline__ void swa_phase(int vcu, int G, LAS unsigned char* lds, const bf16* QKV, const float* sinks, bf16* ATT) {
    int tid_ = threadIdx.x; asm volatile("" : "+v"(tid_)); const int tid = tid_, lane = tid & 63, q = lane & 31, hi = lane >> 5; const int wid = __builtin_amdgcn_readfirstlane(tid >> 6);
    LAS unsigned char* Kl = lds; LAS bf16* Vt = (LAS bf16*)(lds + 32768);
    for (int unit = vcu; unit < BATCH * 32 * 2; unit += G) {
        const int b = unit >> 6, blk = (unit & 63) >> 1, kvh = unit & 1;
        __syncthreads();
        v4u kvr[4], vvr[4];
#pragma unroll
        for (int i = 0; i < 4; ++i) { const int idx = tid + 512 * i, row = idx >> 3, ch = idx & 7; const int t = blk * 128 - 128 + row;
            kvr[i] = (v4u){0u, 0u, 0u, 0u}; if (t >= 0) kvr[i] = *(const GAS v4u*)(QKV + (size_t)(b * SEQ + t) * ODD_IN + 1024 + kvh * 64 + ch * 8);
            const int row2 = idx & 255, ch2 = idx >> 8; const int t2 = blk * 128 - 128 + row2;
            vvr[i] = (v4u){0u, 0u, 0u, 0u}; if (t2 >= 0) vvr[i] = *(const GAS v4u*)(QKV + (size_t)(b * SEQ + t2) * ODD_IN + 1152 + kvh * 64 + ch2 * 8); }
#pragma unroll
        for (int i = 0; i < 4; ++i) { const int idx = tid + 512 * i, row = idx >> 3, ch = idx & 7; const v4u kv = kvr[i], vv = vvr[i];
            *(LAS v4u*)(Kl + ch * 4096 + row * 16) = kv;
            const int kvi = idx & 255, kc = kvi & 15, kpos = (kvi & ~15) + ((kc & 3) | ((kc & 4) << 1) | ((kc & 8) >> 1));
            LAS bf16* vp = Vt + ((idx >> 8) * 8) * VTP + kpos;
            vp[0 * VTP] = (bf16)(vv.x & 0xffffu); vp[1 * VTP] = (bf16)(vv.x >> 16); vp[2 * VTP] = (bf16)(vv.y & 0xffffu); vp[3 * VTP] = (bf16)(vv.y >> 16);
            vp[4 * VTP] = (bf16)(vv.z & 0xffffu); vp[5 * VTP] = (bf16)(vv.z >> 16); vp[6 * VTP] = (bf16)(vv.w & 0xffffu); vp[7 * VTP] = (bf16)(vv.w >> 16); }
        __syncthreads();
        const int head = kvh * 8 + wid; const float sink2 = sinks[head] * LOG2E;
        if (wid >= 4) __builtin_amdgcn_s_sleep(90);
        bf16x8 qn[4];
        { const size_t tok0 = (size_t)b * SEQ + blk * 128 + q;
#pragma unroll
            for (int ks = 0; ks < 4; ++ks) qn[ks] = *(const GAS bf16x8*)(QKV + tok0 * ODD_IN + head * 64 + 16 * ks + 8 * hi); }
        for (int ci = 0; ci < 4; ++ci) {
            const int r0 = 32 * ci; const size_t tok = (size_t)b * SEQ + blk * 128 + r0 + q;
            bf16x8 qf[4];
#pragma unroll
            for (int ks = 0; ks < 4; ++ks) qf[ks] = qn[ks];
            if (ci < 3) {
#pragma unroll
                for (int ks = 0; ks < 4; ++ks) qn[ks] = *(const GAS bf16x8*)(QKV + (tok + 32) * ODD_IN + head * 64 + 16 * ks + 8 * hi); }
            f32x16 p[5];
#pragma unroll
            for (int jt = 0; jt < 5; ++jt) p[jt] = (f32x16){};
#pragma unroll
            for (int ks = 0; ks < 4; ++ks)
#pragma unroll
                for (int jt = 0; jt < 5; ++jt) { const bf16x8 kf = *(const LAS bf16x8*)(Kl + (2 * ks + hi) * 4096 + (r0 + 32 * jt + q) * 16); p[jt] = __builtin_amdgcn_mfma_f32_32x32x16_bf16(kf, qf[ks], p[jt], 0, 0, 0); }
            float mx = -INFINITY;
            if (blk == 0) {
#pragma unroll
                for (int jt = 0; jt < 5; ++jt)
#pragma unroll
                    for (int r = 0; r < 16; ++r) { const int j = r0 + 32 * jt + crow16(r, hi); const bool valid = (j >= r0 + q + 1) && (j <= r0 + q + 128) && (j >= 128);
                        p[jt][r] = valid ? p[jt][r] : -INFINITY; }
            } else {
#pragma unroll
                for (int r = 0; r < 16; ++r) { const int c = crow16(r, hi); p[0][r] = (c > q) ? p[0][r] : -INFINITY; p[4][r] = (c <= q) ? p[4][r] : -INFINITY; }
            }
#pragma unroll
            for (int jt = 0; jt < 5; ++jt)
#pragma unroll
                for (int r = 0; r < 16; ++r) mx = fmaxf(mx, p[jt][r]);
            mx = fmaxf(mx, __shfl_xor(mx, 32)); mx = fmaxf(mx, sink2);
            float l = 0.f;
#pragma unroll
            for (int jt = 0; jt < 5; ++jt)
#pragma unroll
                for (int r = 0; r < 16; ++r) { p[jt][r] = __builtin_amdgcn_exp2f(p[jt][r] - mx); l += p[jt][r]; }
            l += __shfl_xor(l, 32); l += __builtin_amdgcn_exp2f(sink2 - mx);
            f32x16 o[2]; o[0] = (f32x16){}; o[1] = (f32x16){};
#pragma unroll
            for (int jt = 0; jt < 5; ++jt)
#pragma unroll
                for (int kb = 0; kb < 2; ++kb) { v4u pw; pw.x = cvtpk(p[jt][8 * kb + 0], p[jt][8 * kb + 1]); pw.y = cvtpk(p[jt][8 * kb + 2], p[jt][8 * kb + 3]); pw.z = cvtpk(p[jt][8 * kb + 4], p[jt][8 * kb + 5]); pw.w = cvtpk(p[jt][8 * kb + 6], p[jt][8 * kb + 7]);
                    const bf16x8 pf = __builtin_bit_cast(bf16x8, pw);
#pragma unroll
                    for (int dt = 0; dt < 2; ++dt) { const bf16x8 vf = *(const LAS bf16x8*)(Vt + (32 * dt + q) * VTP + r0 + 32 * jt + 16 * kb + 8 * hi);
                        o[dt] = __builtin_amdgcn_mfma_f32_32x32x16_bf16(vf, pf, o[dt], 0, 0, 0); } }
            const float il = 1.f / l;
            bf16* op = ATT + tok * DMODEL + head * 64 + 8 * hi;
#pragma unroll
            for (int dt = 0; dt < 2; ++dt)
#pragma unroll
                for (int rp = 0; rp < 2; ++rp) {
                    v2u y, x; y.x = cvtpk(o[dt][8 * rp] * il, o[dt][8 * rp + 1] * il); y.y = cvtpk(o[dt][8 * rp + 2] * il, o[dt][8 * rp + 3] * il);
                    x.x = cvtpk(o[dt][8 * rp + 4] * il, o[dt][8 * rp + 5] * il); x.y = cvtpk(o[dt][8 * rp + 6] * il, o[dt][8 * rp + 7] * il);
                    const v2u snd = hi ? y : x;
                    v2u rcv; rcv.x = __shfl_xor(snd.x, 32); rcv.y = __shfl_xor(snd.y, 32);
                    v4u w; if (hi) { w.x = rcv.x; w.y = rcv.y; w.z = x.x; w.w = x.y; } else { w.x = y.x; w.y = y.y; w.z = rcv.x; w.w = rcv.y; }
                    *(GAS v4u*)(op + 32 * dt + 16 * rp) = w; }
        }
    }
}
#define RLX_AGENT __ATOMIC_RELAXED, __HIP_MEMORY_SCOPE_AGENT
#define XB_TMO      128
#define XB_XCNT(j)  (256  + 64 * (j))
#define XB_XSUB(j)  (1280 + 64 * (j))
#define XB_XGEN(j)  (2304 + 64 * (j))
#define XB_TOP      3328
#define XB_TOPGEN   3392
#define XCD_BAR_WORDS 3456
#define XB_SPIN_CAP (1u << 18)

__device__ __forceinline__ unsigned xb_ld(unsigned* p)              { return __hip_atomic_load(p, __ATOMIC_RELAXED, __HIP_MEMORY_SCOPE_AGENT); }
__device__ __forceinline__ unsigned xb_add(unsigned* p, unsigned v) { return __hip_atomic_fetch_add(p, v, __ATOMIC_RELAXED, __HIP_MEMORY_SCOPE_AGENT); }
__device__ __forceinline__ unsigned xb_xcc_id() { return (unsigned)__builtin_amdgcn_s_getreg((3 << 11) | 20) & 0xFu; }
#define XB_SPIN(cond, bar) do { unsigned _sp = 0; while (cond) { __builtin_amdgcn_s_sleep(1); \
    if ((++_sp & 255u) == 0u) { if (xb_ld(&(bar)[XB_TMO])) break; if (_sp > XB_SPIN_CAP) { atomicAdd(&(bar)[XB_TMO], 1u); break; } } } } while (0)

struct XcdBarrier {
    unsigned* bar; unsigned x;
    volatile LAS unsigned* st;
};

__device__ __forceinline__ XcdBarrier xcd_barrier_post(unsigned* bar, volatile LAS unsigned* st) {
    XcdBarrier b; b.bar = bar; b.x = xb_xcc_id(); b.st = st;
    if (threadIdx.x == 0) (void)xb_add(&bar[XB_XCNT(b.x)], 1u);
    return b;
}
__device__ __forceinline__ void xcd_barrier_complete(unsigned* bar, unsigned x, unsigned& nloc, unsigned& nx) {
    const unsigned G = gridDim.x * gridDim.y * gridDim.z;
    unsigned sum, cnt, mine, sp = 0u;
    for (;;) {
        sum = 0u; cnt = 0u; mine = 0u;
#pragma unroll
        for (unsigned j = 0; j < 16; ++j) { const unsigned c = xb_ld(&bar[XB_XCNT(j)]); sum += c; cnt += (c > 0u) ? 1u : 0u; mine = (j == x) ? c : mine; }
        if (sum == G) break;
        __builtin_amdgcn_s_sleep(1);
        if ((++sp & 255u) == 0u) { if (xb_ld(&bar[XB_TMO])) break; if (sp > XB_SPIN_CAP) { atomicAdd(&bar[XB_TMO], 1u); break; } }
    }
    nloc = mine > 0u ? mine : 1u; nx = cnt > 0u ? cnt : 1u;
}

__device__ __forceinline__ void xcd_barrier(const XcdBarrier& b) {
    asm volatile("s_waitcnt vmcnt(0)" ::: "memory");
    __syncthreads();
    if (threadIdx.x == 0) {
        unsigned* bar = b.bar;
        __builtin_amdgcn_s_waitcnt(0);
        unsigned nloc = b.st[0], nx = b.st[1];
        if (nloc == 0u) { xcd_barrier_complete(bar, b.x, nloc, nx); b.st[0] = nloc; b.st[1] = nx; }
        const unsigned old = xb_add(&bar[XB_XSUB(b.x)], 1u);
        const unsigned gen = old / nloc;
        if (old + 1u == (gen + 1u) * nloc) {
            __builtin_amdgcn_fence(__ATOMIC_RELEASE, "agent");
            asm volatile("s_waitcnt vmcnt(0)" ::: "memory");
            const unsigned og = xb_add(&bar[XB_TOP], 1u);
            const unsigned tg = og / nx;
            if (og + 1u == (tg + 1u) * nx) xb_add(&bar[XB_TOPGEN], 1u);
            else XB_SPIN(xb_ld(&bar[XB_TOPGEN]) == tg, bar);
            __builtin_amdgcn_fence(__ATOMIC_ACQUIRE, "agent");
            xb_add(&bar[XB_XGEN(b.x)], 1u);
            asm volatile("s_waitcnt vmcnt(0)" ::: "memory");
        } else {
            XB_SPIN(xb_ld(&bar[XB_XGEN(b.x)]) == gen, bar);
            __builtin_amdgcn_fence(__ATOMIC_ACQUIRE, "agent");
            asm volatile("s_waitcnt vmcnt(0)" ::: "memory");
        }
    }
    __syncthreads();
}
__global__ void __launch_bounds__(NWAVES * 64, 2) fwd_kernel(Args a) {
    extern __shared__ __attribute__((aligned(16))) unsigned char lds_raw[];
    cg::grid_group grid = cg::this_grid();
    LAS unsigned char* lds = (LAS unsigned char*)lds_raw;
    const int tid = threadIdx.x, lane = tid & 63, wave = __builtin_amdgcn_readfirstlane(tid >> 6);
    const int G = gridDim.x, bx = blockIdx.x, vcu = (G % 8 == 0) ? (bx % 8) * (G / 8) + bx / 8 : bx;
    const int gw = vcu * NWAVES + wave, NGW = G * NWAVES;
    unsigned char* ws = a.ws;
    bf16* Win_t = (bf16*)(ws + WS_WIN); bf16* Wout_t = (bf16*)(ws + WS_WOUT); bf16* Wqkv_t = (bf16*)(ws + WS_WQKV); bf16* Wo_t = (bf16*)(ws + WS_WO);
    bf16* W1_t = (bf16*)(ws + WS_W1); bf16* W2_t = (bf16*)(ws + WS_W2);
    float* cs = (float*)(ws + WS_CS); float* bqkv_p = (float*)(ws + WS_BQKV);
    bf16* XB = (bf16*)(ws + WS_XN); bf16* A2 = (bf16*)(ws + WS_A2); bf16* H = (bf16*)(ws + WS_H); float* RS = (float*)(ws + WS_RS); bf16* PROJ = (bf16*)(ws + WS_PROJ); bf16* ATT = (bf16*)(ws + WS_ATT); bf16* HF = (bf16*)(ws + WS_HF);

    unsigned* barw = (unsigned*)(ws + WS_BAR);
    volatile LAS unsigned* MISC = (volatile LAS unsigned*)(lds + MISC_OFF);
    if (tid < 32) MISC[tid] = 0u;
    if (bx == 0) for (int i = tid; i < XCD_BAR_WORDS; i += NWAVES * 64) barw[i] = 0u;
    {
        LAS float* scr = (LAS float*)(lds + wave * 16384);
        constexpr int I_IN = 16 * 96, I_SQ = 16 * 32, I_QKV = 16 * 40, I_W1 = 16 * 128, I_W2 = 64 * 32;
        constexpr int NITEMS = I_IN + I_SQ + I_QKV + I_SQ + I_W1 + I_W2;
        for (int it = gw; it < NITEMS; it += NGW) {
            int r = it;
            if (r < I_IN) { p0_transpose_item(a.w_in, 1024, EVEN_IN, Win_t, scr, r, lane, 1536, 2560, a.npre_mix); continue; } r -= I_IN;
            if (r < I_SQ) { p0_transpose_item(a.w_out, 1024, 1024, Wout_t, scr, r, lane, 0, 0, nullptr); continue; } r -= I_SQ;
            if (r < I_QKV) { p0_transpose_item(a.w_qkv, 1024, ODD_IN, Wqkv_t, scr, r, lane, 0, 1152, a.npre_mix + 1024); continue; } r -= I_QKV;
            if (r < I_SQ) { p0_transpose_item(a.w_o, 1024, 1024, Wo_t, scr, r, lane, 0, 0, nullptr); continue; } r -= I_SQ;
            if (r < I_W1) { p0_transpose_item(a.w1, 1024, FF, W1_t, scr, r, lane, 0, 0, a.npre_mlp); continue; } r -= I_W1;
            p0_transpose_item(a.w2, FF, 1024, W2_t, scr, r, lane, 0, 0, nullptr);
        }
        const int gtid = vcu * (NWAVES * 64) + tid, nthr = G * NWAVES * 64;
        for (int i = gtid; i < ODD_IN; i += nthr) bqkv_p[i] = a.b_qkv[i < 1152 ? mapcol(i) : i];
        for (int row = gtid; row < M; row += nthr) { const float pf = (float)a.pos[row];
#pragma unroll
            for (int i = 0; i < 8; ++i) { const float ang = pf * a.inv_freq[i]; const double t = (double)ang * 0.15915494309189535; const float fr = (float)(t - floor(t));
                cs[(size_t)row * 16 + 2 * i] = __builtin_amdgcn_cosf(fr); cs[(size_t)row * 16 + 2 * i + 1] = __builtin_amdgcn_sinf(fr); } }
        for (int m = gw * 4; m < M; m += NGW * 4) x_rows_to_bf16<4>(a.x, XB, RS, m, lane);
    }
    grid.sync();
    const XcdBarrier bar = xcd_barrier_post(barw, MISC + 8);
#define GRID_BAR() xcd_barrier(bar)

    {
        pg8::Gemm g{XB, Win_t, M, EVEN_IN, 1024};
        pg8::StaticOrder S; S.init(M, EVEN_IN, G, bx);
        pg8::EpiInProj E{{PROJ, EVEN_IN, nullptr, cs, 1536, 2048, 2048, 2560, C2, RS, 0}, {PROJ, EVEN_IN, RS}};
        pg8::gemm_phase<pg8::EpiInProj, pg8::StaticOrder, true, true>(lds, g, S, E);
    }
    GRID_BAR();
    {
        for (int p = vcu; p < BATCH * 16 * 8; p += G) {
            const int bvh = p >> 3, s = p & 7, b = bvh >> 4, vh = bvh & 15, h = vh >> 2, c = (vh >> 1) & 1, half = vh & 1;
            const attn_body::bf16* Q = (const attn_body::bf16*)PROJ + 1536 + (h * 2 + c) * 64;
            const attn_body::bf16* K = (const attn_body::bf16*)PROJ + 2048 + (h * 2 + c) * 64;
            const attn_body::bf16* V = (const attn_body::bf16*)PROJ + 2560 + h * 128 + half * 64;
            attn_body::bf16* O = (attn_body::bf16*)ATT + vh * 64;
            attn_body::attn_unit<8>(b, 15 - s, Q, K, V, O, (char*)lds_raw);
            attn_body::attn_unit<8>(b, s, Q, K, V, O, (char*)lds_raw);
        }
    }
    GRID_BAR();
    {
        const float s1 = wave_sum(a.lq1[lane] * a.lk1[lane]), s2 = wave_sum(a.lq2[lane] * a.lk2[lane]);
        const float lam = expf(s1) - expf(s2) + LAM_INIT0;
        mix_pass(gw, NGW, lane, PROJ, ATT, A2, a.conv_w, a.subln, lam);
    }
    GRID_BAR();
    {
        pg8::Gemm g{A2, Wout_t, M, 1024, 1024}; pg8::StaticOrder S; S.init(M, 1024, G, bx);
        pg8::EpiX<0> E{H, 1024, nullptr, nullptr, 0, 0, 0, 0, 1.f, nullptr, 0};
        pg8::gemm_phase<pg8::EpiX<0>, pg8::StaticOrder, true, true>(lds, g, S, E);
    }
    GRID_BAR();
    nr_pass<4>(gw, NGW, lane, H, XB, a.npost_mix, RS, nullptr);
    GRID_BAR();
#define MLP_PHASES(l) \
    {     \
        pg8::Gemm g{XB, W1_t + (size_t)(l) * 1024 * FF, M, FF, 1024}; pg8::StaticOrder S; S.init(M, FF, G, bx); \
        pg8::EpiX<1> E{HF, FF, nullptr, nullptr, 0, 0, 0, 0, 1.f, RS, 16}; \
        pg8::gemm_phase<pg8::EpiX<1>, pg8::StaticOrder, true, true>(lds, g, S, E); \
    } \
    GRID_BAR(); \
    {     \
        pg8::Gemm g{HF, W2_t + (size_t)(l) * 1024 * FF, M, 1024, FF}; pg8::RevOrder S; S.so.init(M, 1024, G, bx); S.nrounds = (S.so.nwg + G - 1) / G; \
        pg8::EpiX<0> E{H, 1024, nullptr, nullptr, 0, 0, 0, 0, 1.f, nullptr, 0}; \
        pg8::gemm_phase<pg8::EpiX<0>, pg8::RevOrder, true, true, true>(lds, g, S, E); \
    } \
    GRID_BAR();
    MLP_PHASES(0)
    nr_pass<4>(gw, NGW, lane, H, XB, a.npost_mlp, RS, nullptr);
    GRID_BAR();
    {
        pg8::Gemm g{XB, Wqkv_t, M, ODD_IN, 1024}; pg8::StaticOrder S; S.init(M, ODD_IN, G, bx);
        pg8::EpiX<2> E{PROJ, ODD_IN, bqkv_p, cs, 0, 1024, 1024, 1152, C2, RS, 0};
        pg8::gemm_phase<pg8::EpiX<2>, pg8::StaticOrder, true, true>(lds, g, S, E);
        const int nbusy = M / 256 * (ODD_IN / 256) - 2 * G;
        if (nbusy >= 0 && nbusy < G && bx >= nbusy) {
            LAS float* scr = (LAS float*)(lds + wave * 16384);
            constexpr int I_W1 = 16 * 128, I_W2 = 64 * 32;
            for (int it = (bx - nbusy) * NWAVES + wave; it < I_W1 + I_W2; it += (G - nbusy) * NWAVES) {
                if (it < I_W1) p0_transpose_item(a.w1 + (size_t)1024 * FF, 1024, FF, W1_t + (size_t)1024 * FF, scr, it, lane, 0, 0, a.npre_mlp + 1024);
                else p0_transpose_item(a.w2 + (size_t)1024 * FF, FF, 1024, W2_t + (size_t)1024 * FF, scr, it - I_W1, lane, 0, 0, nullptr);
            }
        }
    }
    GRID_BAR();
    swa_phase(vcu, G, lds, PROJ, a.sinks, ATT);
    GRID_BAR();
    {
        pg8::Gemm g{ATT, Wo_t, M, 1024, 1024}; pg8::StaticOrder S; S.init(M, 1024, G, bx);
        pg8::EpiX<0> E{H, 1024, a.b_o, nullptr, 0, 0, 0, 0, 1.f, nullptr, 0};
        pg8::gemm_phase<pg8::EpiX<0>, pg8::StaticOrder, true, true>(lds, g, S, E);
    }
    GRID_BAR();
    nr_pass<4>(gw, NGW, lane, H, XB, a.npost_mix + 1024, RS, nullptr);
    GRID_BAR();
    MLP_PHASES(1)
    nr_pass<4>(gw, NGW, lane, H, XB, a.npost_mlp + 1024, nullptr, a.out);
#undef MLP_PHASES
}

extern "C" void kernel_launch(void* const* d_in, const int* in_sizes, int n_in, void* d_out, int out_size, void* d_ws, size_t ws_size, hipStream_t stream) {
    static int grid_blocks = 0;
    if (grid_blocks == 0) {
        if (n_in != 21 || in_sizes[0] != M * DMODEL || out_size != M * DMODEL || ws_size < WS_END) { fprintf(stderr, "kernel_launch: unexpected problem shape / workspace (n_in %d, ws %zu)\n", n_in, ws_size); grid_blocks = -1; return; }
        int dev = 0, cus = 0, per_cu = 0;
        if (hipGetDevice(&dev) != hipSuccess || hipDeviceGetAttribute(&cus, hipDeviceAttributeMultiprocessorCount, dev) != hipSuccess) { grid_blocks = -1; return; }
        if (hipFuncSetAttribute((const void*)fwd_kernel, hipFuncAttributeMaxDynamicSharedMemorySize, LDS_BYTES) != hipSuccess) { fprintf(stderr, "kernel_launch: hipFuncSetAttribute failed\n"); grid_blocks = -1; return; }
        if (hipOccupancyMaxActiveBlocksPerMultiprocessor(&per_cu, (const void*)fwd_kernel, NWAVES * 64, LDS_BYTES) != hipSuccess || per_cu < 1) { fprintf(stderr, "kernel_launch: occupancy query says %d blocks per CU\n", per_cu); grid_blocks = -1; (void)hipGetLastError(); return; }
        grid_blocks = cus;
    }
    if (grid_blocks < 0) return;
    Args a{};
    a.x = (const float*)d_in[0]; a.pos = (const int*)d_in[1];
    a.npre_mix = (const float*)d_in[2]; a.npost_mix = (const float*)d_in[3]; a.npre_mlp = (const float*)d_in[4]; a.npost_mlp = (const float*)d_in[5];
    a.w_in = (const float*)d_in[6]; a.conv_w = (const float*)d_in[7]; a.lq1 = (const float*)d_in[8]; a.lk1 = (const float*)d_in[9]; a.lq2 = (const float*)d_in[10]; a.lk2 = (const float*)d_in[11];
    a.subln = (const float*)d_in[12]; a.w_out = (const float*)d_in[13]; a.w_qkv = (const float*)d_in[14]; a.b_qkv = (const float*)d_in[15]; a.sinks = (const float*)d_in[16];
    a.w_o = (const float*)d_in[17]; a.b_o = (const float*)d_in[18]; a.w1 = (const float*)d_in[19]; a.w2 = (const float*)d_in[20];
    a.out = (float*)d_out; a.ws = (unsigned char*)d_ws;
    for (int i = 0; i < 8; ++i) a.inv_freq[i] = (float)pow(500000.0, -(double)i / 8.0);
    void* args[] = {&a};
    hipError_t e = hipLaunchCooperativeKernel((const void*)fwd_kernel, dim3(grid_blocks), dim3(NWAVES * 64), args, LDS_BYTES, stream);
    if (e != hipSuccess) fprintf(stderr, "kernel_launch: cooperative launch failed: %s (grid %d)\n", hipGetErrorString(e), grid_blocks);
}
```

```cpp
#include <hip/hip_runtime.h>
#include <hip/hip_cooperative_groups.h>
#include <cstdio>
#include <cstdint>
#include <cmath>
namespace cg = cooperative_groups;
namespace pg8 {
#define PG8_LAS __attribute__((address_space(3)))
typedef unsigned short bf16_t;
typedef short bf16x8 __attribute__((ext_vector_type(8)));
typedef float f32x4 __attribute__((ext_vector_type(4)));
typedef unsigned u32x4 __attribute__((ext_vector_type(4)));
constexpr int BM = 256, BK = 64, HALF = 128, HTB = HALF * BK * 2  , STAGE_BYTES = 8 * HTB, NXCD = 8, WGM = 8;

__host__ __device__ __forceinline__ int lds_byte(int r, int c) { const int st = (r >> 4) * 2 + (c >> 5), rr = r & 15, cc = c & 31, ob = rr * 64 + cc * 2; return st * 1024 + (ob ^ (((ob >> 9) & 1) << 5)); }
__host__ __device__ __forceinline__ void stage_rc(int b, int& R, int& C) { const int st = b / 1024, sb = b % 1024, swz = sb ^ (((sb >> 9) & 1) << 5); R = (st >> 1) * 16 + swz / 64; C = (st & 1) * 32 + (swz % 64) / 2; }
__host__ __device__ __forceinline__ int perm32(int rho) { const int n = rho >> 4, i = rho & 15; return 8 * (i >> 2) + 4 * n + (i & 3); }

struct Unit { int pm, pn; };
struct Gemm { const bf16_t* A; const bf16_t* Bt; int M, N, K; };

struct StaticOrder {
    int nM, nN, nwg, G, c;
    __host__ __device__ void init(int M, int N, int G_, int c_) { nM = M / BM; nN = N / BM; nwg = nM * nN; G = G_; c = c_; }
    __host__ __device__ bool next(int i, Unit& u) const {
        const long L = (long)i * G + c; if (L >= nwg) return false;
        int wgid = (int)L; { const int q = nwg / NXCD, r = nwg % NXCD, xcd = wgid % NXCD, off = wgid / NXCD; wgid = (xcd < r ? xcd * (q + 1) : r * (q + 1) + (xcd - r) * q) + off; }
        const int nig = WGM * nN, gid = wgid / nig, fm = gid * WGM, gsz = (nM - fm) < WGM ? (nM - fm) : WGM;
        u.pm = fm + ((wgid % nig) % gsz); u.pn = (wgid % nig) / gsz; return true;
    }
    __device__ __forceinline__ void a_ready(const Unit&) const {}
    __device__ __forceinline__ void done(const Unit&) const {}
};

__device__ __forceinline__ unsigned cvt_pk_bf16(float lo, float hi) { unsigned r; asm volatile("v_cvt_pk_bf16_f32 %0, %1, %2" : "=v"(r) : "v"(lo), "v"(hi)); return r; }
typedef float f32x2 __attribute__((ext_vector_type(2)));
struct RevOrder {
    StaticOrder so; int nrounds;
    __host__ __device__ bool next(int i, Unit& u) const { return i < nrounds && so.next(nrounds - 1 - i, u); }
    __device__ __forceinline__ void a_ready(const Unit&) const {}
    __device__ __forceinline__ void done(const Unit&) const {}
};
template <int MODE> struct EpiX {
    static constexpr bool PERM = true, AFTER_DRAIN = false;
    bf16_t* O; int ldc; const float* bias; const float* cs; int q_lo, q_hi, k_lo, k_hi; float qscale; const float* rs; int blk;
    __device__ __forceinline__ void operator()(const f32x4 (&acc)[2][2][4][2], const Unit& u, int wr, int wc, int fr, int fq) const {
        const int row0 = u.pm * BM + wr * 64 + fr; const int col0 = u.pn * BM + wc * 32 + 8 * fq;
        f32x4 bv[2][2];
#pragma unroll
        for (int bj = 0; bj < 2; ++bj)
#pragma unroll
            for (int n = 0; n < 2; ++n) bv[bj][n] = bias ? *(const f32x4*)(bias + col0 + bj * HALF + 4 * n) : (f32x4){0.f, 0.f, 0.f, 0.f};
        const bool ropelane = (MODE == 2) && ((wc & 1) == 0) && (fq < 2);
#pragma unroll
        for (int ai = 0; ai < 2; ++ai)
#pragma unroll
            for (int m = 0; m < 4; ++m) { const int row = row0 + ai * HALF + m * 16; bf16_t* rowp = blk ? O + ((size_t)u.pm * blk + u.pn) * 65536 + (size_t)(row - u.pm * BM) * 256 + (col0 - u.pn * BM) : O + (size_t)row * ldc + col0;
                const float rsv = rs ? rs[row] : 1.0f;
                f32x4 c01 = (f32x4){1.f, 0.f, 1.f, 0.f}, c23 = (f32x4){1.f, 0.f, 1.f, 0.f};
                if (MODE == 2) { if (ropelane) { const float* cp = cs + (size_t)row * 16 + fq * 8; c01 = *(const f32x4*)cp; c23 = *(const f32x4*)(cp + 4); } }
#pragma unroll
                for (int bj = 0; bj < 2; ++bj) { f32x4 v0 = acc[ai][bj][m][0] * rsv + bv[bj][0], v1 = acc[ai][bj][m][1] * rsv + bv[bj][1];
                    if (MODE == 1) { v0 = __builtin_elementwise_max(v0, (f32x4){0.f, 0.f, 0.f, 0.f}); v1 = __builtin_elementwise_max(v1, (f32x4){0.f, 0.f, 0.f, 0.f}); v0 = v0 * v0; v1 = v1 * v1; }
                    if (MODE == 2) { const int cb = u.pn * BM + bj * HALF + wc * 32; const bool isq = cb >= q_lo && cb < q_hi, isk = cb >= k_lo && cb < k_hi;
                        if (ropelane && (isq || isk)) {
                            f32x4 r0, r1;
                            r0[0] = v0[0] * c01[0] - v0[1] * c01[1]; r0[1] = v0[1] * c01[0] + v0[0] * c01[1];
                            r0[2] = v0[2] * c01[2] - v0[3] * c01[3]; r0[3] = v0[3] * c01[2] + v0[2] * c01[3];
                            r1[0] = v1[0] * c23[0] - v1[1] * c23[1]; r1[1] = v1[1] * c23[0] + v1[0] * c23[1];
                            r1[2] = v1[2] * c23[2] - v1[3] * c23[3]; r1[3] = v1[3] * c23[2] + v1[2] * c23[3];
                            v0 = r0; v1 = r1; }
                        if (isq) { v0 = v0 * qscale; v1 = v1 * qscale; } }
                    u32x4 w; w.x = cvt_pk_bf16(v0[0], v0[1]); w.y = cvt_pk_bf16(v0[2], v0[3]); w.z = cvt_pk_bf16(v1[0], v1[1]); w.w = cvt_pk_bf16(v1[2], v1[3]);
                    *(u32x4*)(rowp + bj * HALF) = w; } }
    }
};
struct EpiU {
    static constexpr bool PERM = true, AFTER_DRAIN = false;
    bf16_t* O; int ldc; const float* rs;
    __device__ __forceinline__ void operator()(const f32x4 (&acc)[2][2][4][2], const Unit& u, int wr, int wc, int fr, int fq) const {
        const int row0 = u.pm * BM + wr * 64 + fr; bf16_t* base = O + 512 + (u.pn - 2) * 128 + wc * 32 + 8 * fq;
#pragma unroll
        for (int ai = 0; ai < 2; ++ai)
#pragma unroll
            for (int m = 0; m < 4; ++m) { const int row = row0 + ai * HALF + m * 16; const float r2 = rs[row] * rs[row];
                const f32x4 p0 = acc[ai][0][m][0] * acc[ai][1][m][0] * r2, p1 = acc[ai][0][m][1] * acc[ai][1][m][1] * r2;
                u32x4 w; w.x = cvt_pk_bf16(p0[0], p0[1]); w.y = cvt_pk_bf16(p0[2], p0[3]); w.z = cvt_pk_bf16(p1[0], p1[1]); w.w = cvt_pk_bf16(p1[2], p1[3]);
                *(u32x4*)(base + (size_t)row * ldc) = w; }
    }
};
struct EpiInProj {
    static constexpr bool PERM = true, AFTER_DRAIN = false;
    EpiX<2> ex; EpiU eu;
    __device__ __forceinline__ void operator()(const f32x4 (&acc)[2][2][4][2], const Unit& u, int wr, int wc, int fr, int fq) const {
        if (u.pn >= 2 && u.pn < 6) eu(acc, u, wr, wc, fr, fq); else ex(acc, u, wr, wc, fr, fq);
    }
};
struct SubsetOrder {
    StaticOrder so; int keep, skip;
    __host__ __device__ bool next(int i, Unit& u) const { if (!so.next(i, u)) return false; if (u.pn >= keep) u.pn += skip; return true; }
    __device__ __forceinline__ void a_ready(const Unit&) const {}
    __device__ __forceinline__ void done(const Unit&) const {}
};
template <class Epi, class Sched, bool ALIGN_EPI = false, bool SP2 = false, bool ABLK = false>
__device__ __forceinline__ void gemm_phase(PG8_LAS unsigned char* lds, const Gemm g, const Sched& S, const Epi& E) {
    int tid_ = threadIdx.x; asm volatile("" : "+v"(tid_));
    const int tid = tid_, wid = __builtin_amdgcn_readfirstlane(tid >> 6), lane = tid & 63, wr = wid >> 2, wc = wid & 3, fr = lane & 15, fq = lane >> 4;
    const int K = g.K, nt = K / BK;
    unsigned voffA[2], voffB[2];
#pragma unroll
    for (int i = 0; i < 2; ++i) { int R, C; stage_rc(tid * 16 + i * 8192, R, C); const int Rb = Epi::PERM ? ((R & ~31) + perm32(R & 31)) : R;
        voffA[i] = (unsigned)(R * (ABLK ? 256 : K) + C) * 2u; voffB[i] = (unsigned)(Rb * K + C) * 2u; }
    const size_t kstep = (size_t)(BK * 2);
    const size_t hstep = (size_t)HALF * K * 2;
    const size_t tstep = 2 * hstep;
    const size_t hstepA = ABLK ? (size_t)HALF * 256 * 2 : hstep;
#define PG8_KA(t) (ABLK ? ((size_t)((t) >> 2) * 131072 + (size_t)(((t) >> 1) & 1) * 256) : (size_t)(t) * kstep)
    const unsigned ldsw = (unsigned)wid * 1024u;
    const int aoff = lds_byte(wr * 64 + fr, fq * 8), boff = lds_byte(wc * 32 + fr, fq * 8);
#define PG8_SA(b, h) (((b) * 2 + (h)) * HTB)
#define PG8_SB(b, h) ((4 + (b) * 2 + (h)) * HTB)
#define PG8_STAGE(bufoff, gbase, voff) do { _Pragma("unroll") for (int _i = 0; _i < 2; ++_i) \
        __builtin_amdgcn_global_load_lds((const unsigned*)((const char*)(gbase) + (voff)[_i]), (PG8_LAS unsigned*)(lds + (bufoff) + ldsw + _i * 8192), 16, 0, 0); } while (0)
#define PG8_LDA(dst, b, h) do { _Pragma("unroll") for (int m = 0; m < 4; ++m) _Pragma("unroll") for (int k = 0; k < 2; ++k) dst[m][k] = *(const PG8_LAS bf16x8*)(lds + PG8_SA(b, h) + aoff + m * 2048 + k * 1024); } while (0)
#define PG8_LDB(dst, b, h) do { _Pragma("unroll") for (int n = 0; n < 2; ++n) _Pragma("unroll") for (int k = 0; k < 2; ++k) dst[n][k] = *(const PG8_LAS bf16x8*)(lds + PG8_SB(b, h) + boff + n * 2048 + k * 1024); } while (0)
#define PG8_MMA(ai, bj, At, Bt) do { __builtin_amdgcn_s_setprio(1); _Pragma("unroll") for (int m = 0; m < 4; ++m) _Pragma("unroll") for (int n = 0; n < 2; ++n) _Pragma("unroll") for (int k = 0; k < 2; ++k) \
        acc[ai][bj][m][n] = __builtin_amdgcn_mfma_f32_16x16x32_bf16(Bt[n][k], At[m][k], acc[ai][bj][m][n], 0, 0, 0); __builtin_amdgcn_s_setprio(0); } while (0)
#define PG8_WAIT_V(n) asm volatile("s_waitcnt vmcnt(" #n ")" ::: "memory")
#define PG8_WAIT_L(n) asm volatile("s_waitcnt lgkmcnt(" #n ")" ::: "memory")
#define PG8_BAR __builtin_amdgcn_s_barrier()
#define PG8_SCHED __builtin_amdgcn_sched_barrier(0)
    Unit cur, nxt; int ui = 0;
    if (!S.next(0, cur)) return;
    f32x4 acc[2][2][4][2];
#pragma unroll
    for (int a = 0; a < 2; ++a)
#pragma unroll
        for (int b = 0; b < 2; ++b)
#pragma unroll
            for (int m = 0; m < 4; ++m)
#pragma unroll
                for (int n = 0; n < 2; ++n) acc[a][b][m][n] = (f32x4){0.f, 0.f, 0.f, 0.f};
    bf16x8 At[4][2], B0[2][2], B1[2][2];
    const char* cA = (const char*)g.A + (size_t)cur.pm * tstep; const char* cB = (const char*)g.Bt + (size_t)cur.pn * tstep;
    S.a_ready(cur);
    if constexpr (SP2) {
        PG8_STAGE(PG8_SB(0, 0), cB, voffB); PG8_STAGE(PG8_SB(0, 1), cB + hstep, voffB); PG8_STAGE(PG8_SA(0, 0), cA, voffA); PG8_STAGE(PG8_SA(0, 1), cA + hstepA, voffA);
        if (wr == 1) PG8_BAR;
        PG8_WAIT_V(2); PG8_BAR;
        PG8_STAGE(PG8_SB(1, 0), cB + kstep, voffB); PG8_STAGE(PG8_SA(1, 0), cA + kstep, voffA); PG8_STAGE(PG8_SB(1, 1), cB + hstep + kstep, voffB);
        PG8_WAIT_V(6); PG8_BAR;
    } else {
        PG8_STAGE(PG8_SB(0, 0), cB, voffB); PG8_STAGE(PG8_SA(0, 0), cA, voffA); PG8_STAGE(PG8_SB(0, 1), cB + hstep, voffB); PG8_STAGE(PG8_SA(0, 1), cA + hstepA, voffA);
        if (wr == 1) PG8_BAR;
        PG8_WAIT_V(4); PG8_BAR;
        PG8_STAGE(PG8_SB(1, 0), cB + kstep, voffB); PG8_STAGE(PG8_SA(1, 0), cA + kstep, voffA); PG8_STAGE(PG8_SB(1, 1), cB + hstep + kstep, voffB);
        PG8_WAIT_V(6); PG8_BAR;
    }
    for (;;) {
        const bool has_next = S.next(ui + 1, nxt);
        const char* nA = has_next ? (const char*)g.A + (size_t)nxt.pm * tstep : cA; const char* nB = has_next ? (const char*)g.Bt + (size_t)nxt.pn * tstep : cB;
        for (int t = 0; t < nt; t += 2) {
            const bool last = (t == nt - 2);
            const char* a1 = cA + PG8_KA(t) + kstep;
            const char* a2 = last ? nA : cA + PG8_KA(t + 2); const char* b2 = last ? nB : cB + (size_t)(t + 2) * kstep;
            const char* a3 = a2 + kstep; const char* b3 = b2 + kstep;
            if (last && has_next) S.a_ready(nxt);
            if constexpr (SP2) {
            PG8_LDB(B0, 0, 0); PG8_LDB(B1, 0, 1); PG8_SCHED; PG8_LDA(At, 0, 0); PG8_STAGE(PG8_SA(1, 1), a1 + hstepA, voffA);
            PG8_WAIT_V(8); PG8_WAIT_L(0); PG8_BAR; PG8_MMA(0, 0, At, B0); PG8_MMA(0, 1, At, B1); PG8_BAR; PG8_SCHED;
            PG8_LDA(At, 0, 1); PG8_STAGE(PG8_SB(0, 0), b2, voffB); PG8_STAGE(PG8_SB(0, 1), b2 + hstep, voffB); PG8_STAGE(PG8_SA(0, 0), a2, voffA);
            PG8_WAIT_V(8); PG8_WAIT_L(0); PG8_BAR; PG8_MMA(1, 0, At, B0); PG8_MMA(1, 1, At, B1); PG8_BAR; PG8_SCHED;
            PG8_LDB(B0, 1, 0); PG8_LDB(B1, 1, 1); PG8_SCHED; PG8_LDA(At, 1, 0); PG8_STAGE(PG8_SA(0, 1), a2 + hstepA, voffA);
            PG8_WAIT_V(8); PG8_WAIT_L(0); PG8_BAR; PG8_MMA(0, 0, At, B0); PG8_MMA(0, 1, At, B1); PG8_BAR; PG8_SCHED;
            PG8_LDA(At, 1, 1); PG8_STAGE(PG8_SB(1, 0), b3, voffB); PG8_STAGE(PG8_SB(1, 1), b3 + hstep, voffB); PG8_STAGE(PG8_SA(1, 0), a3, voffA);
            PG8_WAIT_V(8); PG8_WAIT_L(0); PG8_BAR; PG8_MMA(1, 0, At, B0); PG8_MMA(1, 1, At, B1); PG8_BAR; PG8_SCHED;
            } else {
            PG8_LDB(B0, 0, 0); PG8_SCHED; PG8_LDA(At, 0, 0); PG8_STAGE(PG8_SA(1, 1), a1 + hstepA, voffA);
            PG8_WAIT_L(8); PG8_BAR; PG8_WAIT_L(0); PG8_MMA(0, 0, At, B0); PG8_BAR; PG8_SCHED;
            PG8_LDB(B1, 0, 1); PG8_STAGE(PG8_SB(0, 0), b2, voffB);
            PG8_BAR; PG8_WAIT_L(0); PG8_MMA(0, 1, At, B1); PG8_BAR;
            PG8_LDA(At, 0, 1); PG8_STAGE(PG8_SA(0, 0), a2, voffA);
            PG8_BAR; PG8_WAIT_L(0); PG8_MMA(1, 0, At, B0); PG8_BAR; PG8_SCHED;
            PG8_STAGE(PG8_SB(0, 1), b2 + hstep, voffB);
            PG8_WAIT_V(6); PG8_BAR; PG8_MMA(1, 1, At, B1); PG8_BAR;
            PG8_LDB(B0, 1, 0); PG8_SCHED; PG8_LDA(At, 1, 0); PG8_STAGE(PG8_SA(0, 1), a2 + hstepA, voffA);
            PG8_WAIT_L(8); PG8_BAR; PG8_WAIT_L(0); PG8_MMA(0, 0, At, B0); PG8_BAR; PG8_SCHED;
            PG8_LDB(B1, 1, 1); PG8_STAGE(PG8_SB(1, 0), b3, voffB);
            PG8_BAR; PG8_WAIT_L(0); PG8_MMA(0, 1, At, B1); PG8_BAR;
            PG8_LDA(At, 1, 1); PG8_STAGE(PG8_SA(1, 0), a3, voffA);
            PG8_BAR; PG8_WAIT_L(0); PG8_MMA(1, 0, At, B0); PG8_BAR; PG8_SCHED;
            PG8_STAGE(PG8_SB(1, 1), b3 + hstep, voffB);
            PG8_WAIT_V(6); PG8_BAR; PG8_MMA(1, 1, At, B1); PG8_BAR;
            }
        }
        if constexpr (ALIGN_EPI) { if (wr == 0) PG8_BAR; }
        if constexpr (!Epi::AFTER_DRAIN) { E(acc, cur, wr, wc, fr, fq); S.done(cur); }
        if (!has_next) break;
#pragma unroll
        for (int a = 0; a < 2; ++a)
#pragma unroll
            for (int b = 0; b < 2; ++b)
#pragma unroll
                for (int m = 0; m < 4; ++m)
#pragma unroll
                    for (int n = 0; n < 2; ++n) acc[a][b][m][n] = (f32x4){0.f, 0.f, 0.f, 0.f};
        cur = nxt; cA = nA; cB = nB; ++ui;
        if constexpr (ALIGN_EPI) { if (wr == 1) PG8_BAR; }
    }
    PG8_WAIT_V(0);
    if constexpr (!ALIGN_EPI) { if (wr == 0) PG8_BAR; }
    PG8_BAR;
    if constexpr (Epi::AFTER_DRAIN) { E.fused(acc, cur, wr, wc, fr, fq, lds, wid, lane); S.done(cur); }
#undef PG8_KA
#undef PG8_SA
#undef PG8_SB
#undef PG8_STAGE
#undef PG8_LDA
#undef PG8_LDB
#undef PG8_MMA
#undef PG8_WAIT_V
#undef PG8_WAIT_L
#undef PG8_BAR
#undef PG8_SCHED
}
}
#include <hip/hip_bf16.h>
#include <cmath>
namespace attn_body {
using bf16=__hip_bfloat16;
using bf16x8=__attribute__((ext_vector_type(8)))short;
using s16x4=__attribute__((ext_vector_type(4)))short;
using f32x16=__attribute__((ext_vector_type(16)))float;
using u32x4=__attribute__((ext_vector_type(4)))unsigned;
constexpr int SEQ=4096,D=64,PQ=3072,PO=1024;
constexpr int NW=8,QBLK=32,QB=QBLK*NW,KVBLK=64,NQB=SEQ/QB;
constexpr int ATTN_UNIT_ROWS=QB;
__device__ __forceinline__ int crow(int r,int hi){return (r&3)+8*(r>>2)+4*hi;}
#define SBAR() __builtin_amdgcn_sched_barrier(0)
__device__ __forceinline__ void cmask(f32x16&p0,f32x16&p1,int jb,int qrel,int hi){
  const float NEG=-INFINITY; int kb=64*jb+4*hi;
  #pragma unroll
  for(int r=0;r<16;++r){int kv=kb+(r&3)+8*(r>>2); if(kv>qrel)p0[r]=NEG; if(kv+32>qrel)p1[r]=NEG;}
}

constexpr int NSLOT=3, SLOTB=8192;
constexpr int LDS_K=0, LDS_V=NSLOT*SLOTB, LDS_WS=2*NSLOT*SLOTB, LDS_OST=LDS_WS+NW*64*4, LDS_BYTES=LDS_OST+NW*4096;
constexpr float C2=0.125f*1.4426950408889634f;
__device__ __forceinline__ void glds16(const void*gsrc,unsigned lds_dst){unsigned keep;
  asm volatile("s_mov_b32 %0, m0\n\ts_mov_b32 m0, %2\n\ts_nop 0\n\tglobal_load_lds_dwordx4 %1, off\n\ts_mov_b32 m0, %0":"=&s"(keep):"v"(gsrc),"s"(lds_dst):"memory");}
__device__ __forceinline__ float max3f(float a,float b,float c){float r;asm("v_max3_f32 %0, %1, %2, %3":"=v"(r):"v"(a),"v"(b),"v"(c));return r;}
__device__ __forceinline__ float max2f(float a,float b){float r;asm("v_max_f32_e32 %0, %1, %2":"=v"(r):"v"(a),"v"(b));return r;}
__device__ __forceinline__ float fadd_s(float a,float b){float r;asm("v_add_f32_e32 %0, %1, %2":"=v"(r):"v"(a),"v"(b));return r;}
__device__ __forceinline__ float fsub_s(float a,float b){float r;asm("v_sub_f32_e32 %0, %1, %2":"=v"(r):"v"(a),"v"(b));return r;}
typedef float f32x2_t __attribute__((ext_vector_type(2))); typedef __bf16 bf16x2_t __attribute__((ext_vector_type(2)));
__device__ __forceinline__ unsigned cvtpk_s(float lo,float hi){f32x2_t v={lo,hi};bf16x2_t b=__builtin_convertvector(v,bf16x2_t);return __builtin_bit_cast(unsigned,b);}
#define WAIT_BAR(N) asm volatile("s_waitcnt vmcnt(" #N ") lgkmcnt(0)\n\ts_barrier":::"memory")

__device__ __forceinline__ void qkt(f32x16&p0,f32x16&p1,const char*Kslot,const bf16x8*qr,const f32x16&negm,int r32,int hi){
  const char*kb=Kslot+hi*1024+r32*16;
  #pragma unroll
  for(int d0=0;d0<4;++d0){
    const bf16x8 b0=*reinterpret_cast<const bf16x8*>(kb+d0*2048);
    const bf16x8 b1=*reinterpret_cast<const bf16x8*>(kb+d0*2048+512);
    if(d0==0){p0=__builtin_amdgcn_mfma_f32_32x32x16_bf16(b0,qr[0],negm,0,0,0);p1=__builtin_amdgcn_mfma_f32_32x32x16_bf16(b1,qr[0],negm,0,0,0);}
    else{p0=__builtin_amdgcn_mfma_f32_32x32x16_bf16(b0,qr[d0],p0,0,0,0);p1=__builtin_amdgcn_mfma_f32_32x32x16_bf16(b1,qr[d0],p1,0,0,0);}}
}
typedef __attribute__((address_space(3))) const char* lds_cptr;
typedef short v4i16_t __attribute__((ext_vector_type(4)));
__device__ __forceinline__ void kload8(bf16x8*kf,lds_cptr kp){
  kf[0]=*(const __attribute__((address_space(3))) bf16x8*)(kp);      kf[1]=*(const __attribute__((address_space(3))) bf16x8*)(kp+512);
  kf[2]=*(const __attribute__((address_space(3))) bf16x8*)(kp+2048); kf[3]=*(const __attribute__((address_space(3))) bf16x8*)(kp+2560);
  kf[4]=*(const __attribute__((address_space(3))) bf16x8*)(kp+4096); kf[5]=*(const __attribute__((address_space(3))) bf16x8*)(kp+4608);
  kf[6]=*(const __attribute__((address_space(3))) bf16x8*)(kp+6144); kf[7]=*(const __attribute__((address_space(3))) bf16x8*)(kp+6656);
}
__device__ __forceinline__ void kload2(bf16x8*kf,lds_cptr kp,int j){ kf[2*j]=*(const __attribute__((address_space(3))) bf16x8*)(kp+j*2048); kf[2*j+1]=*(const __attribute__((address_space(3))) bf16x8*)(kp+j*2048+512); }
__device__ __forceinline__ s16x4 vtr(lds_cptr p){ return __builtin_bit_cast(s16x4,__builtin_amdgcn_ds_read_tr16_b64_v4i16((__attribute__((address_space(3))) v4i16_t*)p)); }
__device__ __forceinline__ float rowmax(const f32x16&p0,const f32x16&p1){
  float a=max3f(p0[0],p0[1],p1[0]),b=max3f(p0[2],p0[3],p1[1]);a=max3f(a,p1[2],p1[3]);
  #pragma unroll
  for(int r=4;r<16;r+=4){a=max3f(a,p0[r],p0[r+1]);b=max3f(b,p0[r+2],p0[r+3]);a=max3f(a,p1[r],p1[r+1]);b=max3f(b,p1[r+2],p1[r+3]);}
  const float m=max2f(a,b);
  auto rr=__builtin_amdgcn_permlane32_swap(__float_as_uint(m),__float_as_uint(m),false,false);
  return max2f(__uint_as_float(rr[0]),__uint_as_float(rr[1]));
}
__device__ __forceinline__ void pv(f32x16*o,int vb,bf16x8 pa0,bf16x8 pa1,bf16x8 pa2,bf16x8 pa3){
  #pragma unroll
  for(int d0=0;d0<2;++d0){s16x4 lo[4],hi[4];
    #pragma unroll
    for(int ks=0;ks<4;++ks){
      asm volatile("ds_read_b64_tr_b16 %0,%1 offset:%c2":"=&v"(lo[ks]):"v"(vb),"i"(d0*4096+ks*1024):"memory");
      asm volatile("ds_read_b64_tr_b16 %0,%1 offset:%c2":"=&v"(hi[ks]):"v"(vb),"i"(d0*4096+ks*1024+512):"memory");}
    asm volatile("s_waitcnt lgkmcnt(0)":::"memory");SBAR();
    #define PK(k) (bf16x8){lo[k][0],lo[k][1],lo[k][2],lo[k][3],hi[k][0],hi[k][1],hi[k][2],hi[k][3]}
    o[d0]=__builtin_amdgcn_mfma_f32_32x32x16_bf16(pa0,PK(0),o[d0],0,0,0);
    o[d0]=__builtin_amdgcn_mfma_f32_32x32x16_bf16(pa1,PK(1),o[d0],0,0,0);
    o[d0]=__builtin_amdgcn_mfma_f32_32x32x16_bf16(pa2,PK(2),o[d0],0,0,0);
    o[d0]=__builtin_amdgcn_mfma_f32_32x32x16_bf16(pa3,PK(3),o[d0],0,0,0);
    #undef PK
  }
}

#ifndef ATTN_STORE16
#define ATTN_STORE16(p,v) (*(u32x4*)(p)=(v))
#endif
template<int THRL> __device__ __forceinline__ void attn_unit(int b,int qb,const bf16*Q,const bf16*__restrict__ K,const bf16*__restrict__ V,bf16*O,char*shm){
  int tid_=threadIdx.x; asm volatile("":"+v"(tid_)); const int tid=tid_,lane=tid&63,r32=lane&31,hi=lane>>5; const int wid=__builtin_amdgcn_readfirstlane(tid>>6);
  const long rowbase=(long)b*SEQ; const int q0=qb*QB;
  const bf16*Qw=Q+(rowbase+q0+wid*QBLK)*PQ;
  const bf16*Kh=K+rowbase*PQ,*Vh=V+rowbase*PQ;
  const unsigned lds0=(unsigned)(uintptr_t)shm;
  float*wsf=(float*)(shm+LDS_WS)+wid*64;
  const bf16*ksrc=Kh+(long)lane*PQ+wid*8;
  const bf16*vsrc=Vh+(long)(16*(wid&3)+(lane>>2))*PQ+(wid>>2)*32+(lane&3)*8;
  const unsigned kdst=lds0+LDS_K+wid*1024, vdst=lds0+LDS_V+wid*1024;
  #define DMA_K(t,slot) glds16(ksrc+(long)(t)*KVBLK*PQ,(unsigned)__builtin_amdgcn_readfirstlane(kdst+(slot)))
  #define DMA_V(t,slot) glds16(vsrc+(long)(t)*KVBLK*PQ,(unsigned)__builtin_amdgcn_readfirstlane(vdst+(slot)))
  const int vb0=(int)(lds0+LDS_V)+((lane>>4)&1)*32+(lane&3)*8+(4*hi+((lane&15)>>2))*64;
  const char*Kbase=shm+LDS_K; bf16x8 kf[8];
  const lds_cptr shm3=(lds_cptr)shm; const lds_cptr kp0=shm3+LDS_K+hi*1024+r32*16; const lds_cptr vp0=shm3+LDS_V+((lane>>4)&1)*32+(lane&3)*8+(4*hi+((lane&15)>>2))*64;
  const int NT=(q0+QB)/KVBLK;
  DMA_K(0,0);DMA_V(0,0);DMA_K(1,SLOTB);
  bf16x8 qr[4];
  #pragma unroll
  for(int d0=0;d0<4;++d0)qr[d0]=*reinterpret_cast<const bf16x8*>(&Qw[(long)r32*PQ+d0*16+hi*8]);
  float mhat=0.f,l_reg=0.f;f32x16 o[2];o[0]=f32x16{};o[1]=f32x16{};f32x16 negm=f32x16{};asm volatile("":"+v"(negm));
  const int qrel=wid*QBLK+r32;
  #define CMASK(P0,P1,t) do{int jb_=(t)-(NT-4); if(jb_>=0)cmask(P0,P1,jb_,qrel,hi);}while(0)
  bool resc=false;
  #define START(P0,P1) do{ const float rm=rowmax(P0,P1); resc=false; \
    { const float dl=rm; mhat=fadd_s(mhat,dl); \
      _Pragma("unroll") for(int r=0;r<16;++r){P0[r]=fsub_s(P0[r],dl);P1[r]=fsub_s(P1[r],dl);} \
      _Pragma("unroll") for(int r=0;r<16;++r)negm[r]=-mhat; asm volatile("":"+v"(negm)); } \
    _Pragma("unroll") for(int r=0;r<16;++r)P0[r]=__builtin_amdgcn_exp2f(P0[r]); }while(0)
  #define RESC() do{ if(resc){ asm volatile("s_waitcnt lgkmcnt(0)":::"memory"); \
      _Pragma("unroll") for(int d_=0;d_<2;++d_) _Pragma("unroll") for(int r=0;r<16;++r)o[d_][r]*=wsf[crow(r,hi)]; } }while(0)
  f32x16 pA0,pA1,pB0,pB1;
  int sl_prev=0,sl_cur=0,sl_next=SLOTB;
  #define ROT() do{sl_prev=sl_cur;sl_cur=sl_next;sl_next=(sl_next==(NSLOT-1)*SLOTB)?0:sl_next+SLOTB;}while(0)
  DMA_K(2,2*SLOTB);
  WAIT_BAR(3);
  qkt(pA0,pA1,Kbase,qr,negm,r32,hi);asm volatile("s_nop 15\n\ts_nop 7":"+v"(pA0),"+v"(pA1));CMASK(pA0,pA1,0);
  START(pA0,pA1);
  _Pragma("unroll") for(int r=0;r<16;++r)pA1[r]=__builtin_amdgcn_exp2f(pA1[r]);
  WAIT_BAR(0);
  DMA_K(3,0);DMA_V(1,SLOTB);
  ROT();
  kload8(kf,kp0+sl_cur);
  WAIT_BAR(2);
  s16x4 vlo[8],vhi[8]; u32x4 pw0,pw1,pw2,pw3;
  #define PKW(P,B) cvtpk_s(P[B],P[B+1])
  #define PAF(k) __builtin_bit_cast(bf16x8,pw##k)
  #define VFR(i) (bf16x8){vlo[i][0],vlo[i][1],vlo[i][2],vlo[i][3],vhi[i][0],vhi[i][1],vhi[i][2],vhi[i][3]}
  #define PIN(x) asm volatile("":"+v"(x))
  #define MX3(a,b,c) __builtin_fmaxf(__builtin_fmaxf((a),(b)),(c))
  #define GAPA(MF,A0,A1,A2,A3,W0,W1,PW) do{ MF; sacc+=A0; sacc+=A1; sacc+=A2; sacc+=A3; PIN(sacc); W0; W1; PIN(PW); SBAR(); }while(0)
  #define EX(v) __builtin_amdgcn_exp2f(v)
  #define GAPB(MF,X,B) do{ MF; X[B]=EX(X[B]); X[B+1]=EX(X[B+1]); X[B+2]=EX(X[B+2]); X[B+3]=EX(X[B+3]); PIN(X); SBAR(); }while(0)
  #define VRD(i) do{ vlo[i]=vtr(vp_+(((i)>>2)*4096+((i)&3)*1024)); vhi[i]=vtr(vp_+(((i)>>2)*4096+((i)&3)*1024+512)); }while(0)
  #define KRD(G,j) do{ if(G){ kload2(kf,kp0+sl_next,j); SBAR(); } }while(0)
  #define STEP(C0,C1,P0,P1,t,GK,GV,GL) do{ SBAR(); \
    const lds_cptr vp_=vp0+sl_prev; \
    VRD(0); SBAR(); float sacc=(P0[0]+P0[1]); \
    GAPA(C0=__builtin_amdgcn_mfma_f32_32x32x16_bf16(kf[0],qr[0],negm,0,0,0), P0[2],P0[3],P0[4],P0[5],     pw0[0]=PKW(P0,0), pw0[1]=PKW(P0,2), pw0); \
    VRD(4); SBAR(); GAPA(C1=__builtin_amdgcn_mfma_f32_32x32x16_bf16(kf[1],qr[0],negm,0,0,0), P0[6],P0[7],P0[8],P0[9],     pw0[2]=PKW(P0,4), pw0[3]=PKW(P0,6), pw0); \
    VRD(1); SBAR(); GAPA(C0=__builtin_amdgcn_mfma_f32_32x32x16_bf16(kf[2],qr[1],C0,0,0,0),   P0[10],P0[11],P0[12],P0[13], pw1[0]=PKW(P0,8), pw1[1]=PKW(P0,10), pw1); \
    VRD(5); SBAR(); GAPA(C1=__builtin_amdgcn_mfma_f32_32x32x16_bf16(kf[3],qr[1],C1,0,0,0),   P0[14],P0[15],P1[0],P1[1],   pw1[2]=PKW(P0,12),pw1[3]=PKW(P0,14), pw1); \
    VRD(2); SBAR(); GAPA(C0=__builtin_amdgcn_mfma_f32_32x32x16_bf16(kf[4],qr[2],C0,0,0,0),   P1[2],P1[3],P1[4],P1[5],     pw2[0]=PKW(P1,0), pw2[1]=PKW(P1,2), pw2); \
    VRD(6); SBAR(); GAPA(C1=__builtin_amdgcn_mfma_f32_32x32x16_bf16(kf[5],qr[2],C1,0,0,0),   P1[6],P1[7],P1[8],P1[9],     pw2[2]=PKW(P1,4), pw2[3]=PKW(P1,6), pw2); \
    VRD(3); SBAR(); GAPA(C0=__builtin_amdgcn_mfma_f32_32x32x16_bf16(kf[6],qr[3],C0,0,0,0),   P1[10],P1[11],P1[12],P1[13], pw3[0]=PKW(P1,8), pw3[1]=PKW(P1,10), pw3); \
    VRD(7); SBAR(); GAPA(C1=__builtin_amdgcn_mfma_f32_32x32x16_bf16(kf[7],qr[3],C1,0,0,0),   P1[14],P1[15],0.f,0.f,       pw3[2]=PKW(P1,12),pw3[3]=PKW(P1,14), pw3); \
    l_reg+=sacc; \
    if(GK){DMA_K((t)+3,sl_cur);} if(GV){DMA_V((t)+1,sl_next);} \
    CMASK(C0,C1,t); \
    { float a=MX3(C0[0],C0[1],C1[0]),b=MX3(C0[2],C0[3],C1[1]); a=MX3(a,C1[2],C1[3]); \
      _Pragma("unroll") for(int r=4;r<16;r+=4){a=MX3(a,C0[r],C0[r+1]);b=MX3(b,C0[r+2],C0[r+3]);a=MX3(a,C1[r],C1[r+1]);b=MX3(b,C1[r+2],C1[r+3]);} \
      float rm=__builtin_fmaxf(a,b); { auto rr=__builtin_amdgcn_permlane32_swap(__float_as_uint(rm),__float_as_uint(rm),false,false); rm=__builtin_fmaxf(__uint_as_float(rr[0]),__uint_as_float(rr[1])); } \
      resc=false; \
      if(__builtin_expect(__any(rm>(float)THRL),0)){ const float dl=__builtin_fmaxf(rm,0.f); mhat+=dl; \
        _Pragma("unroll") for(int r=0;r<16;++r){C0[r]-=dl;C1[r]-=dl;} \
        _Pragma("unroll") for(int r=0;r<16;++r)negm[r]=-mhat; asm volatile("":"+v"(negm)); \
        const float f=__builtin_amdgcn_exp2f(-dl); l_reg*=f; if(hi==0)wsf[r32]=f; resc=true; } } \
    SBAR(); \
    GAPB(o[0]=__builtin_amdgcn_mfma_f32_32x32x16_bf16(PAF(0),VFR(0),o[0],0,0,0), C0,0); \
    GAPB(o[1]=__builtin_amdgcn_mfma_f32_32x32x16_bf16(PAF(0),VFR(4),o[1],0,0,0), C0,4); \
    KRD(GL,0); GAPB(o[0]=__builtin_amdgcn_mfma_f32_32x32x16_bf16(PAF(1),VFR(1),o[0],0,0,0), C0,8); \
    KRD(GL,1); GAPB(o[1]=__builtin_amdgcn_mfma_f32_32x32x16_bf16(PAF(1),VFR(5),o[1],0,0,0), C0,12); \
    KRD(GL,2); GAPB(o[0]=__builtin_amdgcn_mfma_f32_32x32x16_bf16(PAF(2),VFR(2),o[0],0,0,0), C1,0); \
    KRD(GL,3); GAPB(o[1]=__builtin_amdgcn_mfma_f32_32x32x16_bf16(PAF(2),VFR(6),o[1],0,0,0), C1,4); \
    GAPB(o[0]=__builtin_amdgcn_mfma_f32_32x32x16_bf16(PAF(3),VFR(3),o[0],0,0,0), C1,8); \
    GAPB(o[1]=__builtin_amdgcn_mfma_f32_32x32x16_bf16(PAF(3),VFR(7),o[1],0,0,0), C1,12); \
    }while(0)
  int t=1;
  #undef CMASK
  #define CMASK(P0,P1,t) do{}while(0)
  for(;t+5<NT;t+=2){
    STEP(pB0,pB1,pA0,pA1,t,true,true,true);     WAIT_BAR(2); RESC(); ROT();
    STEP(pA0,pA1,pB0,pB1,t+1,true,true,true);   WAIT_BAR(2); RESC(); ROT();
  }
  #undef CMASK
  #define CMASK(P0,P1,t) do{int jb_=(t)-(NT-4); if(jb_>=0)cmask(P0,P1,jb_,qrel,hi);}while(0)
  #define ENDW(tt) do{ if((tt)+3<NT){WAIT_BAR(2);} else if((tt)+2<NT){WAIT_BAR(1);} else {WAIT_BAR(0);} }while(0)
  for(;t+1<NT;t+=2){
    STEP(pB0,pB1,pA0,pA1,t,(t+3<NT),(t+1<NT),(t+1<NT));       ENDW(t);   RESC(); ROT();
    STEP(pA0,pA1,pB0,pB1,t+1,(t+4<NT),(t+2<NT),(t+2<NT));     ENDW(t+1); RESC(); ROT();
  }
  STEP(pB0,pB1,pA0,pA1,NT-1,false,false,false); RESC();
  { float sacc=pB0[0]+pB0[1]; _Pragma("unroll") for(int r=2;r<16;++r)sacc+=pB0[r]; _Pragma("unroll") for(int r=0;r<16;++r)sacc+=pB1[r]; l_reg+=sacc;
    pw0=(u32x4){PKW(pB0,0),PKW(pB0,2),PKW(pB0,4),PKW(pB0,6)};pw1=(u32x4){PKW(pB0,8),PKW(pB0,10),PKW(pB0,12),PKW(pB0,14)};pw2=(u32x4){PKW(pB1,0),PKW(pB1,2),PKW(pB1,4),PKW(pB1,6)};pw3=(u32x4){PKW(pB1,8),PKW(pB1,10),PKW(pB1,12),PKW(pB1,14)};
    SBAR(); pv(o,vb0+sl_cur,PAF(0),PAF(1),PAF(2),PAF(3)); }
  #undef PKW
  #undef PAF
  #undef VFR
  #undef PIN
  #undef MX3
  #undef GAPA
  #undef GAPB
  #undef EX
  #undef VRD
  #undef KRD
  #undef STEP
  #undef ENDW
  {auto rr=__builtin_amdgcn_permlane32_swap(__float_as_uint(l_reg),__float_as_uint(l_reg),false,false);l_reg=__uint_as_float(rr[0])+__uint_as_float(rr[1]);}
  if(hi==0)wsf[32+r32]=l_reg;asm volatile("s_waitcnt lgkmcnt(0)":::"memory");
  float rli[16];
  #pragma unroll
  for(int r=0;r<16;++r)rli[r]=__builtin_amdgcn_rcpf(wsf[32+crow(r,hi)]);
  bf16*Ow=O+(rowbase+q0+wid*QBLK)*PO;
  { bf16*stg=(bf16*)(shm+LDS_OST)+wid*2048;
    #pragma unroll
    for(int r=0;r<16;++r){const int orow=crow(r,hi);
      #pragma unroll
      for(int d0=0;d0<2;++d0)stg[orow*64+d0*32+r32]=__float2bfloat16(o[d0][r]*rli[r]);}
    asm volatile("s_waitcnt lgkmcnt(0)":::"memory");
    #pragma unroll
    for(int i=0;i<4;++i){const int row=i*8+(lane>>3),ch=lane&7; const u32x4 v=*(const u32x4*)(stg+row*64+ch*8); ATTN_STORE16(Ow+(long)row*PO+ch*8,v);} }
  asm volatile("s_waitcnt lgkmcnt(0)\n\ts_barrier":::"memory");
  #undef DMA_K
  #undef DMA_V
  #undef CMASK
  #undef START
  #undef RESC
  #undef ROT
}
constexpr int ATTN_LDS_BYTES=LDS_BYTES;
#undef SBAR
#undef WAIT_BAR
}
#define GAS __attribute__((address_space(1)))
#define LAS __attribute__((address_space(3)))
typedef unsigned short bf16;
typedef unsigned v4u __attribute__((ext_vector_type(4)));
typedef unsigned v2u __attribute__((ext_vector_type(2)));
typedef float f32x4 __attribute__((ext_vector_type(4)));
typedef float f32x16 __attribute__((ext_vector_type(16)));
typedef short bf16x8 __attribute__((ext_vector_type(8)));
#define LDS_WAIT() asm volatile("s_waitcnt lgkmcnt(0)" ::: "memory")

constexpr int NWAVES = 8;
constexpr int BATCH = 8, SEQ = 4096, DMODEL = 1024, FF = 4096;
constexpr int M = BATCH * SEQ;
constexpr int EVEN_IN = 3072, ODD_IN = 1280;
constexpr float C2 = 0.125f * 1.4426950408889634f;
constexpr float LOG2E = 1.4426950408889634f;
constexpr float RMS_EPS = 1e-6f, DIFF_EPS = 1e-5f;
constexpr float LAM_INIT0 = 0.2f;

constexpr size_t MiB = 1u << 20;
constexpr int RING_BYTES = 131072;
constexpr int LDS_BYTES = 147456;
constexpr size_t WS_WIN = 2 * MiB, WS_WOUT = 8 * MiB, WS_WQKV = 10 * MiB, WS_WO = 13 * MiB, WS_W1 = 16 * MiB  , WS_W2 = 32 * MiB  ;
constexpr size_t WS_CS = 48 * MiB  , WS_BQKV = 50 * MiB, WS_RS = 51 * MiB  ;
constexpr size_t WS_BAR = 0;
constexpr int MISC_OFF = RING_BYTES + 320;
constexpr size_t WS_XN = 64 * MiB;
constexpr size_t WS_A2 = 448 * MiB;
constexpr size_t WS_H = 128 * MiB;
constexpr size_t WS_PROJ = 192 * MiB;
constexpr size_t WS_ATT = 384 * MiB;
constexpr size_t WS_HF = 192 * MiB;
constexpr size_t WS_END = 512 * MiB;


struct Args {
    const float* x; const int* pos;
    const float *npre_mix, *npost_mix, *npre_mlp, *npost_mlp;
    const float *w_in, *conv_w, *lq1, *lk1, *lq2, *lk2, *subln, *w_out;
    const float *w_qkv, *b_qkv, *sinks, *w_o, *b_o, *w1, *w2;
    float* out; unsigned char* ws;
    float inv_freq[8];
};

__device__ __forceinline__ float wave_sum(float v) {
#pragma unroll
    for (int o = 1; o < 64; o <<= 1) v += __shfl_xor(v, o);
    return v;
}
__device__ __forceinline__ unsigned f2bf(float f) { unsigned u = __builtin_bit_cast(unsigned, f); return (u + 0x7fffu + ((u >> 16) & 1u)) >> 16; }
__device__ __forceinline__ unsigned pk2(float lo, float hi) { return f2bf(lo) | (f2bf(hi) << 16); }
__device__ __forceinline__ float bflo(unsigned w) { return __builtin_bit_cast(float, w << 16); }
__device__ __forceinline__ float bfhi(unsigned w) { return __builtin_bit_cast(float, w & 0xffff0000u); }
__device__ __forceinline__ int mapcol(int n) { const int hl = n & 63; return hl < 16 ? (n & ~63) + (hl >> 1) + 8 * (hl & 1) : n; }

__device__ __forceinline__ void p0_transpose_item(const float* W, int K, int N, bf16* WT, LAS float* scr, int item, int lane, int perm_lo, int perm_hi, const float* g) {
    const int nblk = N / 32, kb = item / nblk, nb = item % nblk, k0 = 64 * kb, n0 = 32 * nb;
    int ncol = n0 + (lane & 31); if (ncol >= perm_lo && ncol < perm_hi) ncol = mapcol(ncol);
    if (perm_lo == 1536 && ncol >= 512 && ncol < 1536) { const int w_ = (ncol - 512) & 255, tt_ = (ncol - 512) >> 8; ncol = (w_ < 128 ? 512 : 1024 - 128) + 128 * tt_ + w_; }
    float wv[32];
#pragma unroll
    for (int i = 0; i < 32; ++i) { const int kk = 2 * i + (lane >> 5); wv[i] = __builtin_nontemporal_load(W + (size_t)(k0 + kk) * N + ncol); }
    if (g) {
#pragma unroll
        for (int i = 0; i < 32; ++i) { const int kk = 2 * i + (lane >> 5); wv[i] *= g[k0 + kk]; } }
#pragma unroll
    for (int i = 0; i < 32; ++i) { const int kk = 2 * i + (lane >> 5); scr[kk * 33 + (lane & 31)] = wv[i]; }
    LDS_WAIT(); asm volatile("" ::: "memory");
    const int c = lane & 7;
#pragma unroll
    for (int j = 0; j < 4; ++j) { const int n = (lane >> 3) + 8 * j; const LAS float* s = scr + (8 * c) * 33 + n;
        v4u o; o.x = pk2(s[0 * 33], s[1 * 33]); o.y = pk2(s[2 * 33], s[3 * 33]); o.z = pk2(s[4 * 33], s[5 * 33]); o.w = pk2(s[6 * 33], s[7 * 33]);
        *(GAS v4u*)(WT + (size_t)(n0 + n) * K + k0 + 8 * c) = o; }
    LDS_WAIT(); asm volatile("" ::: "memory");
}

__device__ __forceinline__ void unpack8(const v4u w, float (&f)[8]) { f[0] = bflo(w.x); f[1] = bfhi(w.x); f[2] = bflo(w.y); f[3] = bfhi(w.y); f[4] = bflo(w.z); f[5] = bfhi(w.z); f[6] = bflo(w.w); f[7] = bfhi(w.w); }
template <int RPI> __device__ __forceinline__ void x_rows_to_bf16(const float* x, bf16* XB, float* rsp, int row0, int lane) {
    f32x4 v[RPI][4];
#pragma unroll
    for (int r = 0; r < RPI; ++r) { const GAS f32x4* xr = (const GAS f32x4*)(x + (size_t)(row0 + r) * DMODEL) + lane;
#pragma unroll
        for (int j = 0; j < 4; ++j) v[r][j] = __builtin_nontemporal_load(xr + 64 * j); }
    float s[RPI];
#pragma unroll
    for (int r = 0; r < RPI; ++r) { s[r] = 0.f; GAS unsigned long long* o8 = (GAS unsigned long long*)(XB + (size_t)(row0 + r) * DMODEL) + lane;
#pragma unroll
        for (int j = 0; j < 4; ++j) { s[r] += (v[r][j].x * v[r][j].x + v[r][j].y * v[r][j].y) + (v[r][j].z * v[r][j].z + v[r][j].w * v[r][j].w);
            o8[64 * j] = (unsigned long long)pk2(v[r][j].x, v[r][j].y) | ((unsigned long long)pk2(v[r][j].z, v[r][j].w) << 32); } }
#pragma unroll
    for (int o = 1; o < 64; o <<= 1)
#pragma unroll
        for (int r = 0; r < RPI; ++r) s[r] += __shfl_xor(s[r], o);
#pragma unroll
    for (int r = 0; r < RPI; ++r) if (lane == r) rsp[row0 + r] = 1.f / sqrtf(s[r] * (1.f / DMODEL) + RMS_EPS);
}

template <int RPI> __device__ __forceinline__ void nr_pass(int gw, int NGW, int lane_, const bf16* H, bf16* XB, const float* wpost, float* rsout, float* outf) {
    int lane = lane_; asm volatile("" : "+v"(lane));
    f32x4 wp[2][2];
#pragma unroll
    for (int j = 0; j < 2; ++j)
#pragma unroll
        for (int e = 0; e < 2; ++e) wp[j][e] = *(const f32x4*)(wpost + 8 * lane + 512 * j + 4 * e);
    for (int row0 = gw * RPI; row0 < M; row0 += NGW * RPI) {
        v4u hw[RPI][2], xw[RPI][2];
#pragma unroll
        for (int r = 0; r < RPI; ++r)
#pragma unroll
            for (int j = 0; j < 2; ++j) { hw[r][j] = __builtin_nontemporal_load((const GAS v4u*)(H + (size_t)(row0 + r) * DMODEL + 8 * lane + 512 * j)); xw[r][j] = *(const GAS v4u*)(XB + (size_t)(row0 + r) * DMODEL + 8 * lane + 512 * j); }
        float ss[RPI];
#pragma unroll
        for (int r = 0; r < RPI; ++r) { ss[r] = 0.f;
#pragma unroll
            for (int j = 0; j < 2; ++j) { float f[8]; unpack8(hw[r][j], f);
#pragma unroll
                for (int e = 0; e < 8; ++e) ss[r] += f[e] * f[e]; } }
#pragma unroll
        for (int o = 1; o < 64; o <<= 1)
#pragma unroll
            for (int r = 0; r < RPI; ++r) ss[r] += __shfl_xor(ss[r], o);
        float s2[RPI];
#pragma unroll
        for (int r = 0; r < RPI; ++r) { const float rs = 1.f / sqrtf(ss[r] * (1.f / DMODEL) + RMS_EPS); s2[r] = 0.f;
#pragma unroll
            for (int j = 0; j < 2; ++j) { float f[8], x[8]; unpack8(hw[r][j], f); unpack8(xw[r][j], x);
                f32x4 x0 = (f32x4){x[0], x[1], x[2], x[3]} + (f32x4){f[0], f[1], f[2], f[3]} * rs * wp[j][0], x1 = (f32x4){x[4], x[5], x[6], x[7]} + (f32x4){f[4], f[5], f[6], f[7]} * rs * wp[j][1];
                s2[r] += ((x0.x * x0.x + x0.y * x0.y) + (x0.z * x0.z + x0.w * x0.w)) + ((x1.x * x1.x + x1.y * x1.y) + (x1.z * x1.z + x1.w * x1.w));
                if (outf) { *(GAS f32x4*)(outf + (size_t)(row0 + r) * DMODEL + 8 * lane + 512 * j) = x0; *(GAS f32x4*)(outf + (size_t)(row0 + r) * DMODEL + 8 * lane + 512 * j + 4) = x1; }
                else { v4u o; o.x = pk2(x0.x, x0.y); o.y = pk2(x0.z, x0.w); o.z = pk2(x1.x, x1.y); o.w = pk2(x1.z, x1.w); *(GAS v4u*)(XB + (size_t)(row0 + r) * DMODEL + 8 * lane + 512 * j) = o; } } }
        if (rsout) {
#pragma unroll
            for (int o = 1; o < 64; o <<= 1)
#pragma unroll
                for (int r = 0; r < RPI; ++r) s2[r] += __shfl_xor(s2[r], o);
#pragma unroll
            for (int r = 0; r < RPI; ++r) if (lane == r) rsout[row0 + r] = 1.f / sqrtf(s2[r] * (1.f / DMODEL) + RMS_EPS);
        }
    }
}


__device__ __forceinline__ void mix_pass(int gw, int NGW, int lane_, const bf16* PROJ, const bf16* ATT, bf16* A2, const float* conv_w, const float* subln, float lam) {
    int lane = lane_; asm volatile("" : "+v"(lane));
    float cw[3][8], sw[8];
#pragma unroll
    for (int i = 0; i < 3; ++i)
#pragma unroll
        for (int e = 0; e < 8; ++e) cw[i][e] = conv_w[i * 512 + 8 * lane + e];
#pragma unroll
    for (int e = 0; e < 8; ++e) sw[e] = subln[(lane & 15) * 8 + e] * (1.0f - LAM_INIT0);
    for (int row0 = gw * 2; row0 < M; row0 += NGW * 2) {
        const int t0 = row0 & (SEQ - 1);
        const bf16* pr = PROJ + (size_t)row0 * EVEN_IN + 8 * lane;
        const bf16* ar = ATT + (size_t)row0 * DMODEL + (lane >> 4) * 256 + (lane & 15) * 8;
        v4u gbw[2], uw[4], o0w[2], o1w[2];
#pragma unroll
        for (int r = 0; r < 2; ++r) { gbw[r] = *(const GAS v4u*)(pr + r * EVEN_IN); o0w[r] = *(const GAS v4u*)(ar + r * DMODEL); o1w[r] = *(const GAS v4u*)(ar + r * DMODEL + 128); }
#pragma unroll
        for (int r = 0; r < 4; ++r) { if (r >= 2 || t0 > 0) uw[r] = *(const GAS v4u*)(pr + (r - 2) * EVEN_IN + 512);
            else uw[r] = (v4u){0u, 0u, 0u, 0u}; }
        float u[4][8];
#pragma unroll
        for (int r = 0; r < 4; ++r) unpack8(uw[r], u[r]);
#pragma unroll
        for (int r = 0; r < 2; ++r) { float gb[8], co[8]; unpack8(gbw[r], gb);
#pragma unroll
            for (int e = 0; e < 8; ++e) co[e] = gb[e] * (cw[0][e] * u[r][e] + cw[1][e] * u[r + 1][e] + cw[2][e] * u[r + 2][e]);
            v4u o; o.x = pk2(co[0], co[1]); o.y = pk2(co[2], co[3]); o.z = pk2(co[4], co[5]); o.w = pk2(co[6], co[7]);
            *(GAS v4u*)(A2 + (size_t)(row0 + r) * DMODEL + 8 * lane) = o; }
#pragma unroll
        for (int r = 0; r < 2; ++r) { float o0[8], o1[8], d[8]; unpack8(o0w[r], o0); unpack8(o1w[r], o1);
            float ss = 0.f;
#pragma unroll
            for (int e = 0; e < 8; ++e) { d[e] = o0[e] - lam * o1[e]; ss += d[e] * d[e]; }
            ss += __shfl_xor(ss, 1); ss += __shfl_xor(ss, 2); ss += __shfl_xor(ss, 4); ss += __shfl_xor(ss, 8);
            const float rs = 1.f / sqrtf(ss * (1.f / 128.f) + DIFF_EPS);
#pragma unroll
            for (int e = 0; e < 8; ++e) d[e] = d[e] * rs * sw[e];
            v4u o; o.x = pk2(d[0], d[1]); o.y = pk2(d[2], d[3]); o.z = pk2(d[4], d[5]); o.w = pk2(d[6], d[7]);
            *(GAS v4u*)(A2 + (size_t)(row0 + r) * DMODEL + 512 + 8 * lane) = o; }
    }
}

__device__ __forceinline__ int crow16(int r, int hi) { return (r & 3) + 8 * (r >> 2) + 4 * hi; }
__device__ __forceinline__ unsigned cvtpk(float lo, float hi) { typedef float f2 __attribute__((ext_vector_type(2))); typedef __bf16 b2 __attribute__((ext_vector_type(2))); f2 v = {lo, hi}; b2 b = __builtin_convertvector(v, b2); return __builtin_bit_cast(unsigned, b); }

constexpr int VTP = 264;
__device__ __forceinline__ void swa_phase(int vcu, int G, LAS unsigned char* lds, const bf16* QKV, const float* sinks, bf16* ATT) {
    int tid_ = threadIdx.x; asm volatile("" : "+v"(tid_)); const int tid = tid_, lane = tid & 63, q = lane & 31, hi = lane >> 5; const int wid = __builtin_amdgcn_readfirstlane(tid >> 6);
    LAS unsigned char* Kl = lds; LAS bf16* Vt = (LAS bf16*)(lds + 32768);
    for (int unit = vcu; unit < BATCH * 32 * 2; unit += G) {
        const int b = unit >> 6, blk = (unit & 63) >> 1, kvh = unit & 1;
        __syncthreads();
        v4u kvr[4], vvr[4];
#pragma unroll
        for (int i = 0; i < 4; ++i) { const int idx = tid + 512 * i, row = idx >> 3, ch = idx & 7; const int t = blk * 128 - 128 + row;
            kvr[i] = (v4u){0u, 0u, 0u, 0u}; if (t >= 0) kvr[i] = *(const GAS v4u*)(QKV + (size_t)(b * SEQ + t) * ODD_IN + 1024 + kvh * 64 + ch * 8);
            const int row2 = idx & 255, ch2 = idx >> 8; const int t2 = blk * 128 - 128 + row2;
            vvr[i] = (v4u){0u, 0u, 0u, 0u}; if (t2 >= 0) vvr[i] = *(const GAS v4u*)(QKV + (size_t)(b * SEQ + t2) * ODD_IN + 1152 + kvh * 64 + ch2 * 8); }
#pragma unroll
        for (int i = 0; i < 4; ++i) { const int idx = tid + 512 * i, row = idx >> 3, ch = idx & 7; const v4u kv = kvr[i], vv = vvr[i];
            *(LAS v4u*)(Kl + ch * 4096 + row * 16) = kv;
            const int kvi = idx & 255, kc = kvi & 15, kpos = (kvi & ~15) + ((kc & 3) | ((kc & 4) << 1) | ((kc & 8) >> 1));
            LAS bf16* vp = Vt + ((idx >> 8) * 8) * VTP + kpos;
            vp[0 * VTP] = (bf16)(vv.x & 0xffffu); vp[1 * VTP] = (bf16)(vv.x >> 16); vp[2 * VTP] = (bf16)(vv.y & 0xffffu); vp[3 * VTP] = (bf16)(vv.y >> 16);
            vp[4 * VTP] = (bf16)(vv.z & 0xffffu); vp[5 * VTP] = (bf16)(vv.z >> 16); vp[6 * VTP] = (bf16)(vv.w & 0xffffu); vp[7 * VTP] = (bf16)(vv.w >> 16); }
        __syncthreads();
        const int head = kvh * 8 + wid; const float sink2 = sinks[head] * LOG2E;
        if (wid >= 4) __builtin_amdgcn_s_sleep(90);
        bf16x8 qn[4];
        { const size_t tok0 = (size_t)b * SEQ + blk * 128 + q;
#pragma unroll
            for (int ks = 0; ks < 4; ++ks) qn[ks] = *(const GAS bf16x8*)(QKV + tok0 * ODD_IN + head * 64 + 16 * ks + 8 * hi); }
        for (int ci = 0; ci < 4; ++ci) {
            const int r0 = 32 * ci; const size_t tok = (size_t)b * SEQ + blk * 128 + r0 + q;
            bf16x8 qf[4];
#pragma unroll
            for (int ks = 0; ks < 4; ++ks) qf[ks] = qn[ks];
            if (ci < 3) {
#pragma unroll
                for (int ks = 0; ks < 4; ++ks) qn[ks] = *(const GAS bf16x8*)(QKV + (tok + 32) * ODD_IN + head * 64 + 16 * ks + 8 * hi); }
            f32x16 p[5];
#pragma unroll
            for (int jt = 0; jt < 5; ++jt) p[jt] = (f32x16){};
#pragma unroll
            for (int ks = 0; ks < 4; ++ks)
#pragma unroll
                for (int jt = 0; jt < 5; ++jt) { const bf16x8 kf = *(const LAS bf16x8*)(Kl + (2 * ks + hi) * 4096 + (r0 + 32 * jt + q) * 16); p[jt] = __builtin_amdgcn_mfma_f32_32x32x16_bf16(kf, qf[ks], p[jt], 0, 0, 0); }
            float mx = -INFINITY;
            if (blk == 0) {
#pragma unroll
                for (int jt = 0; jt < 5; ++jt)
#pragma unroll
                    for (int r = 0; r < 16; ++r) { const int j = r0 + 32 * jt + crow16(r, hi); const bool valid = (j >= r0 + q + 1) && (j <= r0 + q + 128) && (j >= 128);
                        p[jt][r] = valid ? p[jt][r] : -INFINITY; }
            } else {
#pragma unroll
                for (int r = 0; r < 16; ++r) { const int c = crow16(r, hi); p[0][r] = (c > q) ? p[0][r] : -INFINITY; p[4][r] = (c <= q) ? p[4][r] : -INFINITY; }
            }
#pragma unroll
            for (int jt = 0; jt < 5; ++jt)
#pragma unroll
                for (int r = 0; r < 16; ++r) mx = fmaxf(mx, p[jt][r]);
            mx = fmaxf(mx, __shfl_xor(mx, 32)); mx = fmaxf(mx, sink2);
            float l = 0.f;
#pragma unroll
            for (int jt = 0; jt < 5; ++jt)
#pragma unroll
                for (int r = 0; r < 16; ++r) { p[jt][r] = __builtin_amdgcn_exp2f(p[jt][r] - mx); l += p[jt][r]; }
            l += __shfl_xor(l, 32); l += __builtin_amdgcn_exp2f(sink2 - mx);
            f32x16 o[2]; o[0] = (f32x16){}; o[1] = (f32x16){};
#pragma unroll
            for (int jt = 0; jt < 5; ++jt)
#pragma unroll
                for (int kb = 0; kb < 2; ++kb) { v4u pw; pw.x = cvtpk(p[jt][8 * kb + 0], p[jt][8 * kb + 1]); pw.y = cvtpk(p[jt][8 * kb + 2], p[jt][8 * kb + 3]); pw.z = cvtpk(p[jt][8 * kb + 4], p[jt][8 * kb + 5]); pw.w = cvtpk(p[jt][8 * kb + 6], p[jt][8 * kb + 7]);
                    const bf16x8 pf = __builtin_bit_cast(bf16x8, pw);
#pragma unroll
                    for (int dt = 0; dt < 2; ++dt) { const bf16x8 vf = *(const LAS bf16x8*)(Vt + (32 * dt + q) * VTP + r0 + 32 * jt + 16 * kb + 8 * hi);
                        o[dt] = __builtin_amdgcn_mfma_f32_32x32x16_bf16(vf, pf, o[dt], 0, 0, 0); } }
            const float il = 1.f / l;
            bf16* op = ATT + tok * DMODEL + head * 64 + 8 * hi;
#pragma unroll
            for (int dt = 0; dt < 2; ++dt)
#pragma unroll
                for (int rp = 0; rp < 2; ++rp) {
                    v2u y, x; y.x = cvtpk(o[dt][8 * rp] * il, o[dt][8 * rp + 1] * il); y.y = cvtpk(o[dt][8 * rp + 2] * il, o[dt][8 * rp + 3] * il);
                    x.x = cvtpk(o[dt][8 * rp + 4] * il, o[dt][8 * rp + 5] * il); x.y = cvtpk(o[dt][8 * rp + 6] * il, o[dt][8 * rp + 7] * il);
                    const v2u snd = hi ? y : x;
                    v2u rcv; rcv.x = __shfl_xor(snd.x, 32); rcv.y = __shfl_xor(snd.y, 32);
                    v4u w; if (hi) { w.x = rcv.x; w.y = rcv.y; w.z = x.x; w.w = x.y; } else { w.x = y.x; w.y = y.y; w.z = rcv.x; w.w = rcv.y; }
                    *(GAS v4u*)(op + 32 * dt + 16 * rp) = w; }
        }
    }
}
#define RLX_AGENT __ATOMIC_RELAXED, __HIP_MEMORY_SCOPE_AGENT
#define XB_TMO      128
#define XB_XCNT(j)  (256  + 64 * (j))
#define XB_XSUB(j)  (1280 + 64 * (j))
#define XB_XGEN(j)  (2304 + 64 * (j))
#define XB_TOP      3328
#define XB_TOPGEN   3392
#define XCD_BAR_WORDS 3456
#define XB_SPIN_CAP (1u << 18)

__device__ __forceinline__ unsigned xb_ld(unsigned* p)              { return __hip_atomic_load(p, __ATOMIC_RELAXED, __HIP_MEMORY_SCOPE_AGENT); }
__device__ __forceinline__ unsigned xb_add(unsigned* p, unsigned v) { return __hip_atomic_fetch_add(p, v, __ATOMIC_RELAXED, __HIP_MEMORY_SCOPE_AGENT); }
__device__ __forceinline__ unsigned xb_xcc_id() { return (unsigned)__builtin_amdgcn_s_getreg((3 << 11) | 20) & 0xFu; }
#define XB_SPIN(cond, bar) do { unsigned _sp = 0; while (cond) { __builtin_amdgcn_s_sleep(1); \
    if ((++_sp & 255u) == 0u) { if (xb_ld(&(bar)[XB_TMO])) break; if (_sp > XB_SPIN_CAP) { atomicAdd(&(bar)[XB_TMO], 1u); break; } } } } while (0)

struct XcdBarrier {
    unsigned* bar; unsigned x;
    volatile LAS unsigned* st;
};

__device__ __forceinline__ XcdBarrier xcd_barrier_post(unsigned* bar, volatile LAS unsigned* st) {
    XcdBarrier b; b.bar = bar; b.x = xb_xcc_id(); b.st = st;
    if (threadIdx.x == 0) (void)xb_add(&bar[XB_XCNT(b.x)], 1u);
    return b;
}
__device__ __forceinline__ void xcd_barrier_complete(unsigned* bar, unsigned x, unsigned& nloc, unsigned& nx) {
    const unsigned G = gridDim.x * gridDim.y * gridDim.z;
    unsigned sum, cnt, mine, sp = 0u;
    for (;;) {
        sum = 0u; cnt = 0u; mine = 0u;
#pragma unroll
        for (unsigned j = 0; j < 16; ++j) { const unsigned c = xb_ld(&bar[XB_XCNT(j)]); sum += c; cnt += (c > 0u) ? 1u : 0u; mine = (j == x) ? c : mine; }
        if (sum == G) break;
        __builtin_amdgcn_s_sleep(1);
        if ((++sp & 255u) == 0u) { if (xb_ld(&bar[XB_TMO])) break; if (sp > XB_SPIN_CAP) { atomicAdd(&bar[XB_TMO], 1u); break; } }
    }
    nloc = mine > 0u ? mine : 1u; nx = cnt > 0u ? cnt : 1u;
}

__device__ __forceinline__ void xcd_barrier(const XcdBarrier& b) {
    asm volatile("s_waitcnt vmcnt(0)" ::: "memory");
    __syncthreads();
    if (threadIdx.x == 0) {
        unsigned* bar = b.bar;
        __builtin_amdgcn_s_waitcnt(0);
        unsigned nloc = b.st[0], nx = b.st[1];
        if (nloc == 0u) { xcd_barrier_complete(bar, b.x, nloc, nx); b.st[0] = nloc; b.st[1] = nx; }
        const unsigned old = xb_add(&bar[XB_XSUB(b.x)], 1u);
        const unsigned gen = old / nloc;
        if (old + 1u == (gen + 1u) * nloc) {
            __builtin_amdgcn_fence(__ATOMIC_RELEASE, "agent");
            asm volatile("s_waitcnt vmcnt(0)" ::: "memory");
            const unsigned og = xb_add(&bar[XB_TOP], 1u);
            const unsigned tg = og / nx;
            if (og + 1u == (tg + 1u) * nx) xb_add(&bar[XB_TOPGEN], 1u);
            else XB_SPIN(xb_ld(&bar[XB_TOPGEN]) == tg, bar);
            __builtin_amdgcn_fence(__ATOMIC_ACQUIRE, "agent");
            xb_add(&bar[XB_XGEN(b.x)], 1u);
            asm volatile("s_waitcnt vmcnt(0)" ::: "memory");
        } else {
            XB_SPIN(xb_ld(&bar[XB_XGEN(b.x)]) == gen, bar);
            __builtin_amdgcn_fence(__ATOMIC_ACQUIRE, "agent");
            asm volatile("s_waitcnt vmcnt(0)" ::: "memory");
        }
    }
    __syncthreads();
}
__global__ void __launch_bounds__(NWAVES * 64, 2) fwd_kernel(Args a) {
    extern __shared__ __attribute__((aligned(16))) unsigned char lds_raw[];
    cg::grid_group grid = cg::this_grid();
    LAS unsigned char* lds = (LAS unsigned char*)lds_raw;
    const int tid = threadIdx.x, lane = tid & 63, wave = __builtin_amdgcn_readfirstlane(tid >> 6);
    const int G = gridDim.x, bx = blockIdx.x, vcu = (G % 8 == 0) ? (bx % 8) * (G / 8) + bx / 8 : bx;
    const int gw = vcu * NWAVES + wave, NGW = G * NWAVES;
    unsigned char* ws = a.ws;
    bf16* Win_t = (bf16*)(ws + WS_WIN); bf16* Wout_t = (bf16*)(ws + WS_WOUT); bf16* Wqkv_t = (bf16*)(ws + WS_WQKV); bf16* Wo_t = (bf16*)(ws + WS_WO);
    bf16* W1_t = (bf16*)(ws + WS_W1); bf16* W2_t = (bf16*)(ws + WS_W2);
    float* cs = (float*)(ws + WS_CS); float* bqkv_p = (float*)(ws + WS_BQKV);
    bf16* XB = (bf16*)(ws + WS_XN); bf16* A2 = (bf16*)(ws + WS_A2); bf16* H = (bf16*)(ws + WS_H); float* RS = (float*)(ws + WS_RS); bf16* PROJ = (bf16*)(ws + WS_PROJ); bf16* ATT = (bf16*)(ws + WS_ATT); bf16* HF = (bf16*)(ws + WS_HF);

    unsigned* barw = (unsigned*)(ws + WS_BAR);
    volatile LAS unsigned* MISC = (volatile LAS unsigned*)(lds + MISC_OFF);
    if (tid < 32) MISC[tid] = 0u;
    if (bx == 0) for (int i = tid; i < XCD_BAR_WORDS; i += NWAVES * 64) barw[i] = 0u;
    {
        LAS float* scr = (LAS float*)(lds + wave * 16384);
        constexpr int I_IN = 16 * 96, I_SQ = 16 * 32, I_QKV = 16 * 40, I_W1 = 16 * 128, I_W2 = 64 * 32;
        constexpr int NITEMS = I_IN + I_SQ + I_QKV + I_SQ + I_W1 + I_W2;
        for (int it = gw; it < NITEMS; it += NGW) {
            int r = it;
            if (r < I_IN) { p0_transpose_item(a.w_in, 1024, EVEN_IN, Win_t, scr, r, lane, 1536, 2560, a.npre_mix); continue; } r -= I_IN;
            if (r < I_SQ) { p0_transpose_item(a.w_out, 1024, 1024, Wout_t, scr, r, lane, 0, 0, nullptr); continue; } r -= I_SQ;
            if (r < I_QKV) { p0_transpose_item(a.w_qkv, 1024, ODD_IN, Wqkv_t, scr, r, lane, 0, 1152, a.npre_mix + 1024); continue; } r -= I_QKV;
            if (r < I_SQ) { p0_transpose_item(a.w_o, 1024, 1024, Wo_t, scr, r, lane, 0, 0, nullptr); continue; } r -= I_SQ;
            if (r < I_W1) { p0_transpose_item(a.w1, 1024, FF, W1_t, scr, r, lane, 0, 0, a.npre_mlp); continue; } r -= I_W1;
            p0_transpose_item(a.w2, FF, 1024, W2_t, scr, r, lane, 0, 0, nullptr);
        }
        const int gtid = vcu * (NWAVES * 64) + tid, nthr = G * NWAVES * 64;
        for (int i = gtid; i < ODD_IN; i += nthr) bqkv_p[i] = a.b_qkv[i < 1152 ? mapcol(i) : i];
        for (int row = gtid; row < M; row += nthr) { const float pf = (float)a.pos[row];
#pragma unroll
            for (int i = 0; i < 8; ++i) { const float ang = pf * a.inv_freq[i]; const double t = (double)ang * 0.15915494309189535; const float fr = (float)(t - floor(t));
                cs[(size_t)row * 16 + 2 * i] = __builtin_amdgcn_cosf(fr); cs[(size_t)row * 16 + 2 * i + 1] = __builtin_amdgcn_sinf(fr); } }
        for (int m = gw * 4; m < M; m += NGW * 4) x_rows_to_bf16<4>(a.x, XB, RS, m, lane);
    }
    grid.sync();
    const XcdBarrier bar = xcd_barrier_post(barw, MISC + 8);
#define GRID_BAR() xcd_barrier(bar)

    {
        pg8::Gemm g{XB, Win_t, M, EVEN_IN, 1024};
        pg8::StaticOrder S; S.init(M, EVEN_IN, G, bx);
        pg8::EpiInProj E{{PROJ, EVEN_IN, nullptr, cs, 1536, 2048, 2048, 2560, C2, RS, 0}, {PROJ, EVEN_IN, RS}};
        pg8::gemm_phase<pg8::EpiInProj, pg8::StaticOrder, true, true>(lds, g, S, E);
    }
    GRID_BAR();
    {
        for (int p = vcu; p < BATCH * 16 * 8; p += G) {
            const int bvh = p >> 3, s = p & 7, b = bvh >> 4, vh = bvh & 15, h = vh >> 2, c = (vh >> 1) & 1, half = vh & 1;
            const attn_body::bf16* Q = (const attn_body::bf16*)PROJ + 1536 + (h * 2 + c) * 64;
            const attn_body::bf16* K = (const attn_body::bf16*)PROJ + 2048 + (h * 2 + c) * 64;
            const attn_body::bf16* V = (const attn_body::bf16*)PROJ + 2560 + h * 128 + half * 64;
            attn_body::bf16* O = (attn_body::bf16*)ATT + vh * 64;
            attn_body::attn_unit<8>(b, 15 - s, Q, K, V, O, (char*)lds_raw);
            attn_body::attn_unit<8>(b, s, Q, K, V, O, (char*)lds_raw);
        }
    }
    GRID_BAR();
    {
        const float s1 = wave_sum(a.lq1[lane] * a.lk1[lane]), s2 = wave_sum(a.lq2[lane] * a.lk2[lane]);
        const float lam = expf(s1) - expf(s2) + LAM_INIT0;
        mix_pass(gw, NGW, lane, PROJ, ATT, A2, a.conv_w, a.subln, lam);
    }
    GRID_BAR();
    {
        pg8::Gemm g{A2, Wout_t, M, 1024, 1024}; pg8::StaticOrder S; S.init(M, 1024, G, bx);
        pg8::EpiX<0> E{H, 1024, nullptr, nullptr, 0, 0, 0, 0, 1.f, nullptr, 0};
        pg8::gemm_phase<pg8::EpiX<0>, pg8::StaticOrder, true, true>(lds, g, S, E);
    }
    GRID_BAR();
    nr_pass<4>(gw, NGW, lane, H, XB, a.npost_mix, RS, nullptr);
    GRID_BAR();
#define MLP_PHASES(l) \
    {     \
        pg8::Gemm g{XB, W1_t + (size_t)(l) * 1024 * FF, M, FF, 1024}; pg8::StaticOrder S; S.init(M, FF, G, bx); \
        pg8::EpiX<1> E{HF, FF, nullptr, nullptr, 0, 0, 0, 0, 1.f, RS, 16}; \
        pg8::gemm_phase<pg8::EpiX<1>, pg8::StaticOrder, true, true>(lds, g, S, E); \
    } \
    GRID_BAR(); \
    {     \
        pg8::Gemm g{HF, W2_t + (size_t)(l) * 1024 * FF, M, 1024, FF}; pg8::RevOrder S; S.so.init(M, 1024, G, bx); S.nrounds = (S.so.nwg + G - 1) / G; \
        pg8::EpiX<0> E{H, 1024, nullptr, nullptr, 0, 0, 0, 0, 1.f, nullptr, 0}; \
        pg8::gemm_phase<pg8::EpiX<0>, pg8::RevOrder, true, true, true>(lds, g, S, E); \
    } \
    GRID_BAR();
    MLP_PHASES(0)
    nr_pass<4>(gw, NGW, lane, H, XB, a.npost_mlp, RS, nullptr);
    GRID_BAR();
    {
        pg8::Gemm g{XB, Wqkv_t, M, ODD_IN, 1024}; pg8::StaticOrder S; S.init(M, ODD_IN, G, bx);
        pg8::EpiX<2> E{PROJ, ODD_IN, bqkv_p, cs, 0, 1024, 1024, 1152, C2, RS, 0};
        pg8::gemm_phase<pg8::EpiX<2>, pg8::StaticOrder, true, true>(lds, g, S, E);
        int nbusy = M / 256 * (ODD_IN / 256) - 2 * G;
        if (nbusy < 0 || nbusy >= G) nbusy = 0;
        if (bx >= nbusy) {
            LAS float* scr = (LAS float*)(lds + wave * 16384);
            constexpr int I_W1 = 16 * 128, I_W2 = 64 * 32;
            for (int it = (bx - nbusy) * NWAVES + wave; it < I_W1 + I_W2; it += (G - nbusy) * NWAVES) {
                if (it < I_W1) p0_transpose_item(a.w1 + (size_t)1024 * FF, 1024, FF, W1_t + (size_t)1024 * FF, scr, it, lane, 0, 0, a.npre_mlp + 1024);
                else p0_transpose_item(a.w2 + (size_t)1024 * FF, FF, 1024, W2_t + (size_t)1024 * FF, scr, it - I_W1, lane, 0, 0, nullptr);
            }
        }
    }
    GRID_BAR();
    swa_phase(vcu, G, lds, PROJ, a.sinks, ATT);
    GRID_BAR();
    {
        pg8::Gemm g{ATT, Wo_t, M, 1024, 1024}; pg8::StaticOrder S; S.init(M, 1024, G, bx);
        pg8::EpiX<0> E{H, 1024, a.b_o, nullptr, 0, 0, 0, 0, 1.f, nullptr, 0};
        pg8::gemm_phase<pg8::EpiX<0>, pg8::StaticOrder, true, true>(lds, g, S, E);
    }
    GRID_BAR();
    nr_pass<4>(gw, NGW, lane, H, XB, a.npost_mix + 1024, RS, nullptr);
    GRID_BAR();
    MLP_PHASES(1)
    nr_pass<4>(gw, NGW, lane, H, XB, a.npost_mlp + 1024, nullptr, a.out);
#undef MLP_PHASES
}

extern "C" void kernel_launch(void* const* d_in, const int* in_sizes, int n_in, void* d_out, int out_size, void* d_ws, size_t ws_size, hipStream_t stream) {
    static int grid_blocks = 0;
    if (grid_blocks == 0) {
        if (n_in != 21 || in_sizes[0] != M * DMODEL || out_size != M * DMODEL || ws_size < WS_END) { fprintf(stderr, "kernel_launch: unexpected problem shape / workspace (n_in %d, ws %zu)\n", n_in, ws_size); grid_blocks = -1; return; }
        int dev = 0, cus = 0, per_cu = 0;
        if (hipGetDevice(&dev) != hipSuccess || hipDeviceGetAttribute(&cus, hipDeviceAttributeMultiprocessorCount, dev) != hipSuccess) { grid_blocks = -1; return; }
        if (hipFuncSetAttribute((const void*)fwd_kernel, hipFuncAttributeMaxDynamicSharedMemorySize, LDS_BYTES) != hipSuccess) { fprintf(stderr, "kernel_launch: hipFuncSetAttribute failed\n"); grid_blocks = -1; return; }
        if (hipOccupancyMaxActiveBlocksPerMultiprocessor(&per_cu, (const void*)fwd_kernel, NWAVES * 64, LDS_BYTES) != hipSuccess || per_cu < 1) { fprintf(stderr, "kernel_launch: occupancy query says %d blocks per CU\n", per_cu); grid_blocks = -1; (void)hipGetLastError(); return; }
        grid_blocks = cus;
    }
    if (grid_blocks < 0) return;
    Args a{};
    a.x = (const float*)d_in[0]; a.pos = (const int*)d_in[1];
    a.npre_mix = (const float*)d_in[2]; a.npost_mix = (const float*)d_in[3]; a.npre_mlp = (const float*)d_in[4]; a.npost_mlp = (const float*)d_in[5];
    a.w_in = (const float*)d_in[6]; a.conv_w = (const float*)d_in[7]; a.lq1 = (const float*)d_in[8]; a.lk1 = (const float*)d_in[9]; a.lq2 = (const float*)d_in[10]; a.lk2 = (const float*)d_in[11];
    a.subln = (const float*)d_in[12]; a.w_out = (const float*)d_in[13]; a.w_qkv = (const float*)d_in[14]; a.b_qkv = (const float*)d_in[15]; a.sinks = (const float*)d_in[16];
    a.w_o = (const float*)d_in[17]; a.b_o = (const float*)d_in[18]; a.w1 = (const float*)d_in[19]; a.w2 = (const float*)d_in[20];
    a.out = (float*)d_out; a.ws = (unsigned char*)d_ws;
    for (int i = 0; i < 8; ++i) a.inv_freq[i] = (float)pow(500000.0, -(double)i / 8.0);
    void* args[] = {&a};
    hipError_t e = hipLaunchCooperativeKernel((const void*)fwd_kernel, dim3(grid_blocks), dim3(NWAVES * 64), args, LDS_BYTES, stream);
    if (e != hipSuccess) fprintf(stderr, "kernel_launch: cooperative launch failed: %s (grid %d)\n", hipGetErrorString(e), grid_blocks);
}
```

```cpp
#include <hip/hip_runtime.h>
#include <hip/hip_cooperative_groups.h>
#include <cstdio>
#include <cstdint>
#include <cmath>
namespace cg = cooperative_groups;
namespace pg8 {
#define PG8_LAS __attribute__((address_space(3)))
typedef unsigned short bf16_t;
typedef short bf16x8 __attribute__((ext_vector_type(8)));
typedef float f32x4 __attribute__((ext_vector_type(4)));
typedef unsigned u32x4 __attribute__((ext_vector_type(4)));
constexpr int BM = 256, BK = 64, HALF = 128, HTB = HALF * BK * 2  , STAGE_BYTES = 8 * HTB, NXCD = 8, WGM = 8;

__host__ __device__ __forceinline__ int lds_byte(int r, int c) { const int st = (r >> 4) * 2 + (c >> 5), rr = r & 15, cc = c & 31, ob = rr * 64 + cc * 2; return st * 1024 + (ob ^ (((ob >> 9) & 1) << 5)); }
__host__ __device__ __forceinline__ void stage_rc(int b, int& R, int& C) { const int st = b / 1024, sb = b % 1024, swz = sb ^ (((sb >> 9) & 1) << 5); R = (st >> 1) * 16 + swz / 64; C = (st & 1) * 32 + (swz % 64) / 2; }
__host__ __device__ __forceinline__ int perm32(int rho) { const int n = rho >> 4, i = rho & 15; return 8 * (i >> 2) + 4 * n + (i & 3); }

struct Unit { int pm, pn; };
struct Gemm { const bf16_t* A; const bf16_t* Bt; int M, N, K; };

struct StaticOrder {
    int nM, nN, nwg, G, c;
    __host__ __device__ void init(int M, int N, int G_, int c_) { nM = M / BM; nN = N / BM; nwg = nM * nN; G = G_; c = c_; }
    __host__ __device__ bool next(int i, Unit& u) const {
        const long L = (long)i * G + c; if (L >= nwg) return false;
        int wgid = (int)L; { const int q = nwg / NXCD, r = nwg % NXCD, xcd = wgid % NXCD, off = wgid / NXCD; wgid = (xcd < r ? xcd * (q + 1) : r * (q + 1) + (xcd - r) * q) + off; }
        const int nig = WGM * nN, gid = wgid / nig, fm = gid * WGM, gsz = (nM - fm) < WGM ? (nM - fm) : WGM;
        u.pm = fm + ((wgid % nig) % gsz); u.pn = (wgid % nig) / gsz; return true;
    }
    __device__ __forceinline__ void a_ready(const Unit&) const {}
    __device__ __forceinline__ void done(const Unit&) const {}
};

__device__ __forceinline__ unsigned cvt_pk_bf16(float lo, float hi) { unsigned r; asm volatile("v_cvt_pk_bf16_f32 %0, %1, %2" : "=v"(r) : "v"(lo), "v"(hi)); return r; }
typedef float f32x2 __attribute__((ext_vector_type(2)));
struct RevOrder {
    StaticOrder so; int nrounds;
    __host__ __device__ bool next(int i, Unit& u) const { return i < nrounds && so.next(nrounds - 1 - i, u); }
    __device__ __forceinline__ void a_ready(const Unit&) const {}
    __device__ __forceinline__ void done(const Unit&) const {}
};
template <int MODE> struct EpiX {
    static constexpr bool PERM = true, AFTER_DRAIN = false;
    bf16_t* O; int ldc; const float* bias; const float* cs; int q_lo, q_hi, k_lo, k_hi; float qscale; const float* rs; int blk;
    __device__ __forceinline__ void operator()(const f32x4 (&acc)[2][2][4][2], const Unit& u, int wr, int wc, int fr, int fq) const {
        const int row0 = u.pm * BM + wr * 64 + fr; const int col0 = u.pn * BM + wc * 32 + 8 * fq;
        f32x4 bv[2][2];
#pragma unroll
        for (int bj = 0; bj < 2; ++bj)
#pragma unroll
            for (int n = 0; n < 2; ++n) bv[bj][n] = bias ? *(const f32x4*)(bias + col0 + bj * HALF + 4 * n) : (f32x4){0.f, 0.f, 0.f, 0.f};
        const bool ropelane = (MODE == 2) && ((wc & 1) == 0) && (fq < 2);
#pragma unroll
        for (int ai = 0; ai < 2; ++ai)
#pragma unroll
            for (int m = 0; m < 4; ++m) { const int row = row0 + ai * HALF + m * 16; bf16_t* rowp = blk ? O + ((size_t)u.pm * blk + u.pn) * 65536 + (size_t)(row - u.pm * BM) * 256 + (col0 - u.pn * BM) : O + (size_t)row * ldc + col0;
                const float rsv = rs ? rs[row] : 1.0f;
                f32x4 c01 = (f32x4){1.f, 0.f, 1.f, 0.f}, c23 = (f32x4){1.f, 0.f, 1.f, 0.f};
                if (MODE == 2) { if (ropelane) { const float* cp = cs + (size_t)row * 16 + fq * 8; c01 = *(const f32x4*)cp; c23 = *(const f32x4*)(cp + 4); } }
#pragma unroll
                for (int bj = 0; bj < 2; ++bj) { f32x4 v0 = acc[ai][bj][m][0] * rsv + bv[bj][0], v1 = acc[ai][bj][m][1] * rsv + bv[bj][1];
                    if (MODE == 1) { v0 = __builtin_elementwise_max(v0, (f32x4){0.f, 0.f, 0.f, 0.f}); v1 = __builtin_elementwise_max(v1, (f32x4){0.f, 0.f, 0.f, 0.f}); v0 = v0 * v0; v1 = v1 * v1; }
                    if (MODE == 2) { const int cb = u.pn * BM + bj * HALF + wc * 32; const bool isq = cb >= q_lo && cb < q_hi, isk = cb >= k_lo && cb < k_hi;
                        if (ropelane && (isq || isk)) {
                            f32x4 r0, r1;
                            r0[0] = v0[0] * c01[0] - v0[1] * c01[1]; r0[1] = v0[1] * c01[0] + v0[0] * c01[1];
                            r0[2] = v0[2] * c01[2] - v0[3] * c01[3]; r0[3] = v0[3] * c01[2] + v0[2] * c01[3];
                            r1[0] = v1[0] * c23[0] - v1[1] * c23[1]; r1[1] = v1[1] * c23[0] + v1[0] * c23[1];
                            r1[2] = v1[2] * c23[2] - v1[3] * c23[3]; r1[3] = v1[3] * c23[2] + v1[2] * c23[3];
                            v0 = r0; v1 = r1; }
                        if (isq) { v0 = v0 * qscale; v1 = v1 * qscale; } }
                    u32x4 w; w.x = cvt_pk_bf16(v0[0], v0[1]); w.y = cvt_pk_bf16(v0[2], v0[3]); w.z = cvt_pk_bf16(v1[0], v1[1]); w.w = cvt_pk_bf16(v1[2], v1[3]);
                    *(u32x4*)(rowp + bj * HALF) = w; } }
    }
};
struct EpiU {
    static constexpr bool PERM = true, AFTER_DRAIN = false;
    bf16_t* O; int ldc; const float* rs;
    __device__ __forceinline__ void operator()(const f32x4 (&acc)[2][2][4][2], const Unit& u, int wr, int wc, int fr, int fq) const {
        const int row0 = u.pm * BM + wr * 64 + fr; bf16_t* base = O + 512 + (u.pn - 2) * 128 + wc * 32 + 8 * fq;
#pragma unroll
        for (int ai = 0; ai < 2; ++ai)
#pragma unroll
            for (int m = 0; m < 4; ++m) { const int row = row0 + ai * HALF + m * 16; const float r2 = rs[row] * rs[row];
                const f32x4 p0 = acc[ai][0][m][0] * acc[ai][1][m][0] * r2, p1 = acc[ai][0][m][1] * acc[ai][1][m][1] * r2;
                u32x4 w; w.x = cvt_pk_bf16(p0[0], p0[1]); w.y = cvt_pk_bf16(p0[2], p0[3]); w.z = cvt_pk_bf16(p1[0], p1[1]); w.w = cvt_pk_bf16(p1[2], p1[3]);
                *(u32x4*)(base + (size_t)row * ldc) = w; }
    }
};
struct EpiInProj {
    static constexpr bool PERM = true, AFTER_DRAIN = false;
    EpiX<2> ex; EpiU eu;
    __device__ __forceinline__ void operator()(const f32x4 (&acc)[2][2][4][2], const Unit& u, int wr, int wc, int fr, int fq) const {
        if (u.pn >= 2 && u.pn < 6) eu(acc, u, wr, wc, fr, fq); else ex(acc, u, wr, wc, fr, fq);
    }
};
struct SubsetOrder {
    StaticOrder so; int keep, skip;
    __host__ __device__ bool next(int i, Unit& u) const { if (!so.next(i, u)) return false; if (u.pn >= keep) u.pn += skip; return true; }
    __device__ __forceinline__ void a_ready(const Unit&) const {}
    __device__ __forceinline__ void done(const Unit&) const {}
};
struct PanelSS {
    float* xbuf;
    unsigned* cnt;
    float eps;
    __device__ __forceinline__ void run(const f32x4 (&v)[2][2][4][2], const Unit& u, int wr, int wc, int fr, int fq, PG8_LAS unsigned char* lds, int wid, int lane) const {
        PG8_LAS float* P = (PG8_LAS float*)lds;
        PG8_LAS float* S = (PG8_LAS float*)(lds + 8192);
#pragma unroll
        for (int ai = 0; ai < 2; ++ai)
#pragma unroll
            for (int m = 0; m < 4; ++m) {
                float s = 0.f;
#pragma unroll
                for (int bj = 0; bj < 2; ++bj)
#pragma unroll
                    for (int n = 0; n < 2; ++n) { const f32x4 x = v[ai][bj][m][n]; s += (x[0] * x[0] + x[1] * x[1]) + (x[2] * x[2] + x[3] * x[3]); }
                s += __shfl_xor(s, 16); s += __shfl_xor(s, 32);
                if (fq == 0) P[(ai * HALF + wr * 64 + m * 16 + fr) * 4 + wc] = s;
            }
        asm volatile("s_waitcnt lgkmcnt(0)" ::: "memory"); __builtin_amdgcn_s_barrier(); asm volatile("" ::: "memory");
        const int row = wid * 32 + (lane & 31);
        if (lane < 32) {
            const float t = (P[row * 4 + 0] + P[row * 4 + 1]) + (P[row * 4 + 2] + P[row * 4 + 3]);
            __hip_atomic_store(xbuf + ((size_t)(u.pm * BM + row) * 4 + u.pn), t, __ATOMIC_RELAXED, __HIP_MEMORY_SCOPE_AGENT);
        }
        asm volatile("s_waitcnt vmcnt(0)" ::: "memory");
        if (lane == 0) __hip_atomic_fetch_add(cnt + 64 * u.pm, 1u, __ATOMIC_RELAXED, __HIP_MEMORY_SCOPE_AGENT);
        if (wid == 0) {
            unsigned sp = 0;
            for (;;) {
                if ((unsigned)__builtin_amdgcn_readfirstlane(__hip_atomic_load(cnt + 64 * u.pm, __ATOMIC_RELAXED, __HIP_MEMORY_SCOPE_AGENT)) >= 32u) break;
                if (++sp > (1u << 22)) break;
                __builtin_amdgcn_s_sleep(2);
            }
            __builtin_amdgcn_fence(__ATOMIC_ACQUIRE, "agent");
        }
        asm volatile("s_waitcnt vmcnt(0) lgkmcnt(0)" ::: "memory"); __builtin_amdgcn_s_barrier(); asm volatile("" ::: "memory");
        if (lane < 32) {
            const float* slot = xbuf + (size_t)(u.pm * BM + row) * 4; float q = 0.f;
#pragma unroll
            for (int t = 0; t < 4; ++t) q += __hip_atomic_load(slot + t, __ATOMIC_RELAXED, __HIP_MEMORY_SCOPE_AGENT);
            S[row] = 1.0f / sqrtf(q * (1.0f / 1024.0f) + eps);
        }
        asm volatile("s_waitcnt lgkmcnt(0)" ::: "memory"); __builtin_amdgcn_s_barrier(); asm volatile("" ::: "memory");
    }
};
struct EpiRmsOut {
    static constexpr bool PERM = false, AFTER_DRAIN = true;
    const bf16_t* xb; float* out; const float* wpost; PanelSS st;
    __device__ __forceinline__ void fused(f32x4 (&acc)[2][2][4][2], const Unit& u, int wr, int wc, int fr, int fq, PG8_LAS unsigned char* lds, int wid, int lane) const {
        typedef unsigned u32x2v __attribute__((ext_vector_type(2)));
        const PG8_LAS float* S = (const PG8_LAS float*)(lds + 8192);
        const int col0 = u.pn * BM + wc * 32 + 4 * fq;
        st.run(acc, u, wr, wc, fr, fq, lds, wid, lane);
#pragma unroll
        for (int ai = 0; ai < 2; ++ai)
#pragma unroll
            for (int m = 0; m < 4; ++m) { const int r = ai * HALF + wr * 64 + m * 16 + fr; const float sr = S[r]; const size_t off = (size_t)(u.pm * BM + r) * 1024 + col0;
                u32x2v xw[2][2];
#pragma unroll
                for (int bj = 0; bj < 2; ++bj)
#pragma unroll
                    for (int n = 0; n < 2; ++n) xw[bj][n] = *(const u32x2v*)(xb + off + bj * HALF + n * 16);
#pragma unroll
                for (int bj = 0; bj < 2; ++bj)
#pragma unroll
                    for (int n = 0; n < 2; ++n) { const f32x4 g = *(const f32x4*)(wpost + col0 + bj * HALF + n * 16);
                        f32x4 x; x[0] = __builtin_bit_cast(float, xw[bj][n].x << 16); x[1] = __builtin_bit_cast(float, xw[bj][n].x & 0xffff0000u); x[2] = __builtin_bit_cast(float, xw[bj][n].y << 16); x[3] = __builtin_bit_cast(float, xw[bj][n].y & 0xffff0000u);
                        *(f32x4*)(out + off + bj * HALF + n * 16) = x + acc[ai][bj][m][n] * sr * g; }
                if (m & 1) asm volatile("" ::: "memory"); }
    }
};
struct OneRound {
    StaticOrder so; int rnd;
    __device__ __forceinline__ bool next(int i, Unit& u) const { return i == 0 && so.next(rnd, u); }
    __device__ __forceinline__ void a_ready(const Unit&) const {}
    __device__ __forceinline__ void done(const Unit&) const {}
};
template <class Epi, class Sched, bool ALIGN_EPI = false, bool SP2 = false, bool ABLK = false>
__device__ __forceinline__ void gemm_phase(PG8_LAS unsigned char* lds, const Gemm g, const Sched& S, const Epi& E) {
    int tid_ = threadIdx.x; asm volatile("" : "+v"(tid_));
    const int tid = tid_, wid = __builtin_amdgcn_readfirstlane(tid >> 6), lane = tid & 63, wr = wid >> 2, wc = wid & 3, fr = lane & 15, fq = lane >> 4;
    const int K = g.K, nt = K / BK;
    unsigned voffA[2], voffB[2];
#pragma unroll
    for (int i = 0; i < 2; ++i) { int R, C; stage_rc(tid * 16 + i * 8192, R, C); const int Rb = Epi::PERM ? ((R & ~31) + perm32(R & 31)) : R;
        voffA[i] = (unsigned)(R * (ABLK ? 256 : K) + C) * 2u; voffB[i] = (unsigned)(Rb * K + C) * 2u; }
    const size_t kstep = (size_t)(BK * 2);
    const size_t hstep = (size_t)HALF * K * 2;
    const size_t tstep = 2 * hstep;
    const size_t hstepA = ABLK ? (size_t)HALF * 256 * 2 : hstep;
#define PG8_KA(t) (ABLK ? ((size_t)((t) >> 2) * 131072 + (size_t)(((t) >> 1) & 1) * 256) : (size_t)(t) * kstep)
    const unsigned ldsw = (unsigned)wid * 1024u;
    const int aoff = lds_byte(wr * 64 + fr, fq * 8), boff = lds_byte(wc * 32 + fr, fq * 8);
#define PG8_SA(b, h) (((b) * 2 + (h)) * HTB)
#define PG8_SB(b, h) ((4 + (b) * 2 + (h)) * HTB)
#define PG8_STAGE(bufoff, gbase, voff) do { _Pragma("unroll") for (int _i = 0; _i < 2; ++_i) \
        __builtin_amdgcn_global_load_lds((const unsigned*)((const char*)(gbase) + (voff)[_i]), (PG8_LAS unsigned*)(lds + (bufoff) + ldsw + _i * 8192), 16, 0, 0); } while (0)
#define PG8_LDA(dst, b, h) do { _Pragma("unroll") for (int m = 0; m < 4; ++m) _Pragma("unroll") for (int k = 0; k < 2; ++k) dst[m][k] = *(const PG8_LAS bf16x8*)(lds + PG8_SA(b, h) + aoff + m * 2048 + k * 1024); } while (0)
#define PG8_LDB(dst, b, h) do { _Pragma("unroll") for (int n = 0; n < 2; ++n) _Pragma("unroll") for (int k = 0; k < 2; ++k) dst[n][k] = *(const PG8_LAS bf16x8*)(lds + PG8_SB(b, h) + boff + n * 2048 + k * 1024); } while (0)
#define PG8_MMA(ai, bj, At, Bt) do { __builtin_amdgcn_s_setprio(1); _Pragma("unroll") for (int m = 0; m < 4; ++m) _Pragma("unroll") for (int n = 0; n < 2; ++n) _Pragma("unroll") for (int k = 0; k < 2; ++k) \
        acc[ai][bj][m][n] = __builtin_amdgcn_mfma_f32_16x16x32_bf16(Bt[n][k], At[m][k], acc[ai][bj][m][n], 0, 0, 0); __builtin_amdgcn_s_setprio(0); } while (0)
#define PG8_WAIT_V(n) asm volatile("s_waitcnt vmcnt(" #n ")" ::: "memory")
#define PG8_WAIT_L(n) asm volatile("s_waitcnt lgkmcnt(" #n ")" ::: "memory")
#define PG8_BAR __builtin_amdgcn_s_barrier()
#define PG8_SCHED __builtin_amdgcn_sched_barrier(0)
    Unit cur, nxt; int ui = 0;
    if (!S.next(0, cur)) return;
    f32x4 acc[2][2][4][2];
#pragma unroll
    for (int a = 0; a < 2; ++a)
#pragma unroll
        for (int b = 0; b < 2; ++b)
#pragma unroll
            for (int m = 0; m < 4; ++m)
#pragma unroll
                for (int n = 0; n < 2; ++n) acc[a][b][m][n] = (f32x4){0.f, 0.f, 0.f, 0.f};
    bf16x8 At[4][2], B0[2][2], B1[2][2];
    const char* cA = (const char*)g.A + (size_t)cur.pm * tstep; const char* cB = (const char*)g.Bt + (size_t)cur.pn * tstep;
    S.a_ready(cur);
    if constexpr (SP2) {
        PG8_STAGE(PG8_SB(0, 0), cB, voffB); PG8_STAGE(PG8_SB(0, 1), cB + hstep, voffB); PG8_STAGE(PG8_SA(0, 0), cA, voffA); PG8_STAGE(PG8_SA(0, 1), cA + hstepA, voffA);
        if (wr == 1) PG8_BAR;
        PG8_WAIT_V(2); PG8_BAR;
        PG8_STAGE(PG8_SB(1, 0), cB + kstep, voffB); PG8_STAGE(PG8_SA(1, 0), cA + kstep, voffA); PG8_STAGE(PG8_SB(1, 1), cB + hstep + kstep, voffB);
        PG8_WAIT_V(6); PG8_BAR;
    } else {
        PG8_STAGE(PG8_SB(0, 0), cB, voffB); PG8_STAGE(PG8_SA(0, 0), cA, voffA); PG8_STAGE(PG8_SB(0, 1), cB + hstep, voffB); PG8_STAGE(PG8_SA(0, 1), cA + hstepA, voffA);
        if (wr == 1) PG8_BAR;
        PG8_WAIT_V(4); PG8_BAR;
        PG8_STAGE(PG8_SB(1, 0), cB + kstep, voffB); PG8_STAGE(PG8_SA(1, 0), cA + kstep, voffA); PG8_STAGE(PG8_SB(1, 1), cB + hstep + kstep, voffB);
        PG8_WAIT_V(6); PG8_BAR;
    }
    for (;;) {
        const bool has_next = S.next(ui + 1, nxt);
        const char* nA = has_next ? (const char*)g.A + (size_t)nxt.pm * tstep : cA; const char* nB = has_next ? (const char*)g.Bt + (size_t)nxt.pn * tstep : cB;
        for (int t = 0; t < nt; t += 2) {
            const bool last = (t == nt - 2);
            const char* a1 = cA + PG8_KA(t) + kstep;
            const char* a2 = last ? nA : cA + PG8_KA(t + 2); const char* b2 = last ? nB : cB + (size_t)(t + 2) * kstep;
            const char* a3 = a2 + kstep; const char* b3 = b2 + kstep;
            if (last && has_next) S.a_ready(nxt);
            if constexpr (SP2) {
            PG8_LDB(B0, 0, 0); PG8_LDB(B1, 0, 1); PG8_SCHED; PG8_LDA(At, 0, 0); PG8_STAGE(PG8_SA(1, 1), a1 + hstepA, voffA);
            PG8_WAIT_V(8); PG8_WAIT_L(0); PG8_BAR; PG8_MMA(0, 0, At, B0); PG8_MMA(0, 1, At, B1); PG8_BAR; PG8_SCHED;
            PG8_LDA(At, 0, 1); PG8_STAGE(PG8_SB(0, 0), b2, voffB); PG8_STAGE(PG8_SB(0, 1), b2 + hstep, voffB); PG8_STAGE(PG8_SA(0, 0), a2, voffA);
            PG8_WAIT_V(8); PG8_WAIT_L(0); PG8_BAR; PG8_MMA(1, 0, At, B0); PG8_MMA(1, 1, At, B1); PG8_BAR; PG8_SCHED;
            PG8_LDB(B0, 1, 0); PG8_LDB(B1, 1, 1); PG8_SCHED; PG8_LDA(At, 1, 0); PG8_STAGE(PG8_SA(0, 1), a2 + hstepA, voffA);
            PG8_WAIT_V(8); PG8_WAIT_L(0); PG8_BAR; PG8_MMA(0, 0, At, B0); PG8_MMA(0, 1, At, B1); PG8_BAR; PG8_SCHED;
            PG8_LDA(At, 1, 1); PG8_STAGE(PG8_SB(1, 0), b3, voffB); PG8_STAGE(PG8_SB(1, 1), b3 + hstep, voffB); PG8_STAGE(PG8_SA(1, 0), a3, voffA);
            PG8_WAIT_V(8); PG8_WAIT_L(0); PG8_BAR; PG8_MMA(1, 0, At, B0); PG8_MMA(1, 1, At, B1); PG8_BAR; PG8_SCHED;
            } else {
            PG8_LDB(B0, 0, 0); PG8_SCHED; PG8_LDA(At, 0, 0); PG8_STAGE(PG8_SA(1, 1), a1 + hstepA, voffA);
            PG8_WAIT_L(8); PG8_BAR; PG8_WAIT_L(0); PG8_MMA(0, 0, At, B0); PG8_BAR; PG8_SCHED;
            PG8_LDB(B1, 0, 1); PG8_STAGE(PG8_SB(0, 0), b2, voffB);
            PG8_BAR; PG8_WAIT_L(0); PG8_MMA(0, 1, At, B1); PG8_BAR;
            PG8_LDA(At, 0, 1); PG8_STAGE(PG8_SA(0, 0), a2, voffA);
            PG8_BAR; PG8_WAIT_L(0); PG8_MMA(1, 0, At, B0); PG8_BAR; PG8_SCHED;
            PG8_STAGE(PG8_SB(0, 1), b2 + hstep, voffB);
            PG8_WAIT_V(6); PG8_BAR; PG8_MMA(1, 1, At, B1); PG8_BAR;
            PG8_LDB(B0, 1, 0); PG8_SCHED; PG8_LDA(At, 1, 0); PG8_STAGE(PG8_SA(0, 1), a2 + hstepA, voffA);
            PG8_WAIT_L(8); PG8_BAR; PG8_WAIT_L(0); PG8_MMA(0, 0, At, B0); PG8_BAR; PG8_SCHED;
            PG8_LDB(B1, 1, 1); PG8_STAGE(PG8_SB(1, 0), b3, voffB);
            PG8_BAR; PG8_WAIT_L(0); PG8_MMA(0, 1, At, B1); PG8_BAR;
            PG8_LDA(At, 1, 1); PG8_STAGE(PG8_SA(1, 0), a3, voffA);
            PG8_BAR; PG8_WAIT_L(0); PG8_MMA(1, 0, At, B0); PG8_BAR; PG8_SCHED;
            PG8_STAGE(PG8_SB(1, 1), b3 + hstep, voffB);
            PG8_WAIT_V(6); PG8_BAR; PG8_MMA(1, 1, At, B1); PG8_BAR;
            }
        }
        if constexpr (ALIGN_EPI) { if (wr == 0) PG8_BAR; }
        if constexpr (!Epi::AFTER_DRAIN) { E(acc, cur, wr, wc, fr, fq); S.done(cur); }
        if (!has_next) break;
#pragma unroll
        for (int a = 0; a < 2; ++a)
#pragma unroll
            for (int b = 0; b < 2; ++b)
#pragma unroll
                for (int m = 0; m < 4; ++m)
#pragma unroll
                    for (int n = 0; n < 2; ++n) acc[a][b][m][n] = (f32x4){0.f, 0.f, 0.f, 0.f};
        cur = nxt; cA = nA; cB = nB; ++ui;
        if constexpr (ALIGN_EPI) { if (wr == 1) PG8_BAR; }
    }
    PG8_WAIT_V(0);
    if constexpr (!ALIGN_EPI) { if (wr == 0) PG8_BAR; }
    PG8_BAR;
    if constexpr (Epi::AFTER_DRAIN) { E.fused(acc, cur, wr, wc, fr, fq, lds, wid, lane); S.done(cur); }
#undef PG8_KA
#undef PG8_SA
#undef PG8_SB
#undef PG8_STAGE
#undef PG8_LDA
#undef PG8_LDB
#undef PG8_MMA
#undef PG8_WAIT_V
#undef PG8_WAIT_L
#undef PG8_BAR
#undef PG8_SCHED
}
}
#include <hip/hip_bf16.h>
#include <cmath>
namespace attn_body {
using bf16=__hip_bfloat16;
using bf16x8=__attribute__((ext_vector_type(8)))short;
using s16x4=__attribute__((ext_vector_type(4)))short;
using f32x16=__attribute__((ext_vector_type(16)))float;
using u32x4=__attribute__((ext_vector_type(4)))unsigned;
constexpr int SEQ=4096,D=64,PQ=3072,PO=1024;
constexpr int NW=8,QBLK=32,QB=QBLK*NW,KVBLK=64,NQB=SEQ/QB;
constexpr int ATTN_UNIT_ROWS=QB;
__device__ __forceinline__ int crow(int r,int hi){return (r&3)+8*(r>>2)+4*hi;}
#define SBAR() __builtin_amdgcn_sched_barrier(0)
__device__ __forceinline__ void cmask(f32x16&p0,f32x16&p1,int jb,int qrel,int hi){
  const float NEG=-INFINITY; int kb=64*jb+4*hi;
  #pragma unroll
  for(int r=0;r<16;++r){int kv=kb+(r&3)+8*(r>>2); if(kv>qrel)p0[r]=NEG; if(kv+32>qrel)p1[r]=NEG;}
}

constexpr int NSLOT=3, SLOTB=8192;
constexpr int LDS_K=0, LDS_V=NSLOT*SLOTB, LDS_WS=2*NSLOT*SLOTB, LDS_OST=LDS_WS+NW*64*4, LDS_BYTES=LDS_OST+NW*4096;
constexpr float C2=0.125f*1.4426950408889634f;
__device__ __forceinline__ void glds16(const void*gsrc,unsigned lds_dst){unsigned keep;
  asm volatile("s_mov_b32 %0, m0\n\ts_mov_b32 m0, %2\n\ts_nop 0\n\tglobal_load_lds_dwordx4 %1, off\n\ts_mov_b32 m0, %0":"=&s"(keep):"v"(gsrc),"s"(lds_dst):"memory");}
__device__ __forceinline__ float max3f(float a,float b,float c){float r;asm("v_max3_f32 %0, %1, %2, %3":"=v"(r):"v"(a),"v"(b),"v"(c));return r;}
__device__ __forceinline__ float max2f(float a,float b){float r;asm("v_max_f32_e32 %0, %1, %2":"=v"(r):"v"(a),"v"(b));return r;}
__device__ __forceinline__ float fadd_s(float a,float b){float r;asm("v_add_f32_e32 %0, %1, %2":"=v"(r):"v"(a),"v"(b));return r;}
__device__ __forceinline__ float fsub_s(float a,float b){float r;asm("v_sub_f32_e32 %0, %1, %2":"=v"(r):"v"(a),"v"(b));return r;}
typedef float f32x2_t __attribute__((ext_vector_type(2))); typedef __bf16 bf16x2_t __attribute__((ext_vector_type(2)));
__device__ __forceinline__ unsigned cvtpk_s(float lo,float hi){f32x2_t v={lo,hi};bf16x2_t b=__builtin_convertvector(v,bf16x2_t);return __builtin_bit_cast(unsigned,b);}
#define WAIT_BAR(N) asm volatile("s_waitcnt vmcnt(" #N ") lgkmcnt(0)\n\ts_barrier":::"memory")

__device__ __forceinline__ void qkt(f32x16&p0,f32x16&p1,const char*Kslot,const bf16x8*qr,const f32x16&negm,int r32,int hi){
  const char*kb=Kslot+hi*1024+r32*16;
  #pragma unroll
  for(int d0=0;d0<4;++d0){
    const bf16x8 b0=*reinterpret_cast<const bf16x8*>(kb+d0*2048);
    const bf16x8 b1=*reinterpret_cast<const bf16x8*>(kb+d0*2048+512);
    if(d0==0){p0=__builtin_amdgcn_mfma_f32_32x32x16_bf16(b0,qr[0],negm,0,0,0);p1=__builtin_amdgcn_mfma_f32_32x32x16_bf16(b1,qr[0],negm,0,0,0);}
    else{p0=__builtin_amdgcn_mfma_f32_32x32x16_bf16(b0,qr[d0],p0,0,0,0);p1=__builtin_amdgcn_mfma_f32_32x32x16_bf16(b1,qr[d0],p1,0,0,0);}}
}
typedef __attribute__((address_space(3))) const char* lds_cptr;
typedef short v4i16_t __attribute__((ext_vector_type(4)));
__device__ __forceinline__ void kload8(bf16x8*kf,lds_cptr kp){
  kf[0]=*(const __attribute__((address_space(3))) bf16x8*)(kp);      kf[1]=*(const __attribute__((address_space(3))) bf16x8*)(kp+512);
  kf[2]=*(const __attribute__((address_space(3))) bf16x8*)(kp+2048); kf[3]=*(const __attribute__((address_space(3))) bf16x8*)(kp+2560);
  kf[4]=*(const __attribute__((address_space(3))) bf16x8*)(kp+4096); kf[5]=*(const __attribute__((address_space(3))) bf16x8*)(kp+4608);
  kf[6]=*(const __attribute__((address_space(3))) bf16x8*)(kp+6144); kf[7]=*(const __attribute__((address_space(3))) bf16x8*)(kp+6656);
}
__device__ __forceinline__ void kload2(bf16x8*kf,lds_cptr kp,int j){ kf[2*j]=*(const __attribute__((address_space(3))) bf16x8*)(kp+j*2048); kf[2*j+1]=*(const __attribute__((address_space(3))) bf16x8*)(kp+j*2048+512); }
__device__ __forceinline__ s16x4 vtr(lds_cptr p){ return __builtin_bit_cast(s16x4,__builtin_amdgcn_ds_read_tr16_b64_v4i16((__attribute__((address_space(3))) v4i16_t*)p)); }
__device__ __forceinline__ float rowmax(const f32x16&p0,const f32x16&p1){
  float a=max3f(p0[0],p0[1],p1[0]),b=max3f(p0[2],p0[3],p1[1]);a=max3f(a,p1[2],p1[3]);
  #pragma unroll
  for(int r=4;r<16;r+=4){a=max3f(a,p0[r],p0[r+1]);b=max3f(b,p0[r+2],p0[r+3]);a=max3f(a,p1[r],p1[r+1]);b=max3f(b,p1[r+2],p1[r+3]);}
  const float m=max2f(a,b);
  auto rr=__builtin_amdgcn_permlane32_swap(__float_as_uint(m),__float_as_uint(m),false,false);
  return max2f(__uint_as_float(rr[0]),__uint_as_float(rr[1]));
}
__device__ __forceinline__ void pv(f32x16*o,int vb,bf16x8 pa0,bf16x8 pa1,bf16x8 pa2,bf16x8 pa3){
  #pragma unroll
  for(int d0=0;d0<2;++d0){s16x4 lo[4],hi[4];
    #pragma unroll
    for(int ks=0;ks<4;++ks){
      asm volatile("ds_read_b64_tr_b16 %0,%1 offset:%c2":"=&v"(lo[ks]):"v"(vb),"i"(d0*4096+ks*1024):"memory");
      asm volatile("ds_read_b64_tr_b16 %0,%1 offset:%c2":"=&v"(hi[ks]):"v"(vb),"i"(d0*4096+ks*1024+512):"memory");}
    asm volatile("s_waitcnt lgkmcnt(0)":::"memory");SBAR();
    #define PK(k) (bf16x8){lo[k][0],lo[k][1],lo[k][2],lo[k][3],hi[k][0],hi[k][1],hi[k][2],hi[k][3]}
    o[d0]=__builtin_amdgcn_mfma_f32_32x32x16_bf16(pa0,PK(0),o[d0],0,0,0);
    o[d0]=__builtin_amdgcn_mfma_f32_32x32x16_bf16(pa1,PK(1),o[d0],0,0,0);
    o[d0]=__builtin_amdgcn_mfma_f32_32x32x16_bf16(pa2,PK(2),o[d0],0,0,0);
    o[d0]=__builtin_amdgcn_mfma_f32_32x32x16_bf16(pa3,PK(3),o[d0],0,0,0);
    #undef PK
  }
}

#ifndef ATTN_STORE16
#define ATTN_STORE16(p,v) (*(u32x4*)(p)=(v))
#endif
template<int THRL> __device__ __forceinline__ void attn_unit(int b,int qb,const bf16*Q,const bf16*__restrict__ K,const bf16*__restrict__ V,bf16*O,char*shm){
  int tid_=threadIdx.x; asm volatile("":"+v"(tid_)); const int tid=tid_,lane=tid&63,r32=lane&31,hi=lane>>5; const int wid=__builtin_amdgcn_readfirstlane(tid>>6);
  const long rowbase=(long)b*SEQ; const int q0=qb*QB;
  const bf16*Qw=Q+(rowbase+q0+wid*QBLK)*PQ;
  const bf16*Kh=K+rowbase*PQ,*Vh=V+rowbase*PQ;
  const unsigned lds0=(unsigned)(uintptr_t)shm;
  float*wsf=(float*)(shm+LDS_WS)+wid*64;
  const bf16*ksrc=Kh+(long)lane*PQ+wid*8;
  const bf16*vsrc=Vh+(long)(16*(wid&3)+(lane>>2))*PQ+(wid>>2)*32+(lane&3)*8;
  const unsigned kdst=lds0+LDS_K+wid*1024, vdst=lds0+LDS_V+wid*1024;
  #define DMA_K(t,slot) glds16(ksrc+(long)(t)*KVBLK*PQ,(unsigned)__builtin_amdgcn_readfirstlane(kdst+(slot)))
  #define DMA_V(t,slot) glds16(vsrc+(long)(t)*KVBLK*PQ,(unsigned)__builtin_amdgcn_readfirstlane(vdst+(slot)))
  const int vb0=(int)(lds0+LDS_V)+((lane>>4)&1)*32+(lane&3)*8+(4*hi+((lane&15)>>2))*64;
  const char*Kbase=shm+LDS_K; bf16x8 kf[8];
  const lds_cptr shm3=(lds_cptr)shm; const lds_cptr kp0=shm3+LDS_K+hi*1024+r32*16; const lds_cptr vp0=shm3+LDS_V+((lane>>4)&1)*32+(lane&3)*8+(4*hi+((lane&15)>>2))*64;
  const int NT=(q0+QB)/KVBLK;
  DMA_K(0,0);DMA_V(0,0);DMA_K(1,SLOTB);
  bf16x8 qr[4];
  #pragma unroll
  for(int d0=0;d0<4;++d0)qr[d0]=*reinterpret_cast<const bf16x8*>(&Qw[(long)r32*PQ+d0*16+hi*8]);
  float mhat=0.f,l_reg=0.f;f32x16 o[2];o[0]=f32x16{};o[1]=f32x16{};f32x16 negm=f32x16{};asm volatile("":"+v"(negm));
  const int qrel=wid*QBLK+r32;
  #define CMASK(P0,P1,t) do{int jb_=(t)-(NT-4); if(jb_>=0)cmask(P0,P1,jb_,qrel,hi);}while(0)
  bool resc=false;
  #define START(P0,P1) do{ const float rm=rowmax(P0,P1); resc=false; \
    { const float dl=rm; mhat=fadd_s(mhat,dl); \
      _Pragma("unroll") for(int r=0;r<16;++r){P0[r]=fsub_s(P0[r],dl);P1[r]=fsub_s(P1[r],dl);} \
      _Pragma("unroll") for(int r=0;r<16;++r)negm[r]=-mhat; asm volatile("":"+v"(negm)); } \
    _Pragma("unroll") for(int r=0;r<16;++r)P0[r]=__builtin_amdgcn_exp2f(P0[r]); }while(0)
  #define RESC() do{ if(resc){ asm volatile("s_waitcnt lgkmcnt(0)":::"memory"); \
      _Pragma("unroll") for(int d_=0;d_<2;++d_) _Pragma("unroll") for(int r=0;r<16;++r)o[d_][r]*=wsf[crow(r,hi)]; } }while(0)
  f32x16 pA0,pA1,pB0,pB1;
  int sl_prev=0,sl_cur=0,sl_next=SLOTB;
  #define ROT() do{sl_prev=sl_cur;sl_cur=sl_next;sl_next=(sl_next==(NSLOT-1)*SLOTB)?0:sl_next+SLOTB;}while(0)
  DMA_K(2,2*SLOTB);
  WAIT_BAR(3);
  qkt(pA0,pA1,Kbase,qr,negm,r32,hi);asm volatile("s_nop 15\n\ts_nop 7":"+v"(pA0),"+v"(pA1));CMASK(pA0,pA1,0);
  START(pA0,pA1);
  _Pragma("unroll") for(int r=0;r<16;++r)pA1[r]=__builtin_amdgcn_exp2f(pA1[r]);
  WAIT_BAR(0);
  DMA_K(3,0);DMA_V(1,SLOTB);
  ROT();
  kload8(kf,kp0+sl_cur);
  WAIT_BAR(2);
  s16x4 vlo[8],vhi[8]; u32x4 pw0,pw1,pw2,pw3;
  #define PKW(P,B) cvtpk_s(P[B],P[B+1])
  #define PAF(k) __builtin_bit_cast(bf16x8,pw##k)
  #define VFR(i) (bf16x8){vlo[i][0],vlo[i][1],vlo[i][2],vlo[i][3],vhi[i][0],vhi[i][1],vhi[i][2],vhi[i][3]}
  #define PIN(x) asm volatile("":"+v"(x))
  #define MX3(a,b,c) __builtin_fmaxf(__builtin_fmaxf((a),(b)),(c))
  #define GAPA(MF,A0,A1,A2,A3,W0,W1,PW) do{ MF; sacc+=A0; sacc+=A1; sacc+=A2; sacc+=A3; PIN(sacc); W0; W1; PIN(PW); SBAR(); }while(0)
  #define EX(v) __builtin_amdgcn_exp2f(v)
  #define GAPB(MF,X,B) do{ MF; X[B]=EX(X[B]); X[B+1]=EX(X[B+1]); X[B+2]=EX(X[B+2]); X[B+3]=EX(X[B+3]); PIN(X); SBAR(); }while(0)
  #define VRD(i) do{ vlo[i]=vtr(vp_+(((i)>>2)*4096+((i)&3)*1024)); vhi[i]=vtr(vp_+(((i)>>2)*4096+((i)&3)*1024+512)); }while(0)
  #define KRD(G,j) do{ if(G){ kload2(kf,kp0+sl_next,j); SBAR(); } }while(0)
  #define STEP(C0,C1,P0,P1,t,GK,GV,GL) do{ SBAR(); \
    const lds_cptr vp_=vp0+sl_prev; \
    VRD(0); SBAR(); float sacc=(P0[0]+P0[1]); \
    GAPA(C0=__builtin_amdgcn_mfma_f32_32x32x16_bf16(kf[0],qr[0],negm,0,0,0), P0[2],P0[3],P0[4],P0[5],     pw0[0]=PKW(P0,0), pw0[1]=PKW(P0,2), pw0); \
    VRD(4); SBAR(); GAPA(C1=__builtin_amdgcn_mfma_f32_32x32x16_bf16(kf[1],qr[0],negm,0,0,0), P0[6],P0[7],P0[8],P0[9],     pw0[2]=PKW(P0,4), pw0[3]=PKW(P0,6), pw0); \
    VRD(1); SBAR(); GAPA(C0=__builtin_amdgcn_mfma_f32_32x32x16_bf16(kf[2],qr[1],C0,0,0,0),   P0[10],P0[11],P0[12],P0[13], pw1[0]=PKW(P0,8), pw1[1]=PKW(P0,10), pw1); \
    VRD(5); SBAR(); GAPA(C1=__builtin_amdgcn_mfma_f32_32x32x16_bf16(kf[3],qr[1],C1,0,0,0),   P0[14],P0[15],P1[0],P1[1],   pw1[2]=PKW(P0,12),pw1[3]=PKW(P0,14), pw1); \
    VRD(2); SBAR(); GAPA(C0=__builtin_amdgcn_mfma_f32_32x32x16_bf16(kf[4],qr[2],C0,0,0,0),   P1[2],P1[3],P1[4],P1[5],     pw2[0]=PKW(P1,0), pw2[1]=PKW(P1,2), pw2); \
    VRD(6); SBAR(); GAPA(C1=__builtin_amdgcn_mfma_f32_32x32x16_bf16(kf[5],qr[2],C1,0,0,0),   P1[6],P1[7],P1[8],P1[9],     pw2[2]=PKW(P1,4), pw2[3]=PKW(P1,6), pw2); \
    VRD(3); SBAR(); GAPA(C0=__builtin_amdgcn_mfma_f32_32x32x16_bf16(kf[6],qr[3],C0,0,0,0),   P1[10],P1[11],P1[12],P1[13], pw3[0]=PKW(P1,8), pw3[1]=PKW(P1,10), pw3); \
    VRD(7); SBAR(); GAPA(C1=__builtin_amdgcn_mfma_f32_32x32x16_bf16(kf[7],qr[3],C1,0,0,0),   P1[14],P1[15],0.f,0.f,       pw3[2]=PKW(P1,12),pw3[3]=PKW(P1,14), pw3); \
    l_reg+=sacc; \
    if(GK){DMA_K((t)+3,sl_cur);} if(GV){DMA_V((t)+1,sl_next);} \
    CMASK(C0,C1,t); \
    { float a=MX3(C0[0],C0[1],C1[0]),b=MX3(C0[2],C0[3],C1[1]); a=MX3(a,C1[2],C1[3]); \
      _Pragma("unroll") for(int r=4;r<16;r+=4){a=MX3(a,C0[r],C0[r+1]);b=MX3(b,C0[r+2],C0[r+3]);a=MX3(a,C1[r],C1[r+1]);b=MX3(b,C1[r+2],C1[r+3]);} \
      float rm=__builtin_fmaxf(a,b); { auto rr=__builtin_amdgcn_permlane32_swap(__float_as_uint(rm),__float_as_uint(rm),false,false); rm=__builtin_fmaxf(__uint_as_float(rr[0]),__uint_as_float(rr[1])); } \
      resc=false; \
      if(__builtin_expect(__any(rm>(float)THRL),0)){ const float dl=__builtin_fmaxf(rm,0.f); mhat+=dl; \
        _Pragma("unroll") for(int r=0;r<16;++r){C0[r]-=dl;C1[r]-=dl;} \
        _Pragma("unroll") for(int r=0;r<16;++r)negm[r]=-mhat; asm volatile("":"+v"(negm)); \
        const float f=__builtin_amdgcn_exp2f(-dl); l_reg*=f; if(hi==0)wsf[r32]=f; resc=true; } } \
    SBAR(); \
    GAPB(o[0]=__builtin_amdgcn_mfma_f32_32x32x16_bf16(PAF(0),VFR(0),o[0],0,0,0), C0,0); \
    GAPB(o[1]=__builtin_amdgcn_mfma_f32_32x32x16_bf16(PAF(0),VFR(4),o[1],0,0,0), C0,4); \
    KRD(GL,0); GAPB(o[0]=__builtin_amdgcn_mfma_f32_32x32x16_bf16(PAF(1),VFR(1),o[0],0,0,0), C0,8); \
    KRD(GL,1); GAPB(o[1]=__builtin_amdgcn_mfma_f32_32x32x16_bf16(PAF(1),VFR(5),o[1],0,0,0), C0,12); \
    KRD(GL,2); GAPB(o[0]=__builtin_amdgcn_mfma_f32_32x32x16_bf16(PAF(2),VFR(2),o[0],0,0,0), C1,0); \
    KRD(GL,3); GAPB(o[1]=__builtin_amdgcn_mfma_f32_32x32x16_bf16(PAF(2),VFR(6),o[1],0,0,0), C1,4); \
    GAPB(o[0]=__builtin_amdgcn_mfma_f32_32x32x16_bf16(PAF(3),VFR(3),o[0],0,0,0), C1,8); \
    GAPB(o[1]=__builtin_amdgcn_mfma_f32_32x32x16_bf16(PAF(3),VFR(7),o[1],0,0,0), C1,12); \
    }while(0)
  int t=1;
  #undef CMASK
  #define CMASK(P0,P1,t) do{}while(0)
  for(;t+5<NT;t+=2){
    STEP(pB0,pB1,pA0,pA1,t,true,true,true);     WAIT_BAR(2); RESC(); ROT();
    STEP(pA0,pA1,pB0,pB1,t+1,true,true,true);   WAIT_BAR(2); RESC(); ROT();
  }
  #undef CMASK
  #define CMASK(P0,P1,t) do{int jb_=(t)-(NT-4); if(jb_>=0)cmask(P0,P1,jb_,qrel,hi);}while(0)
  #define ENDW(tt) do{ if((tt)+3<NT){WAIT_BAR(2);} else if((tt)+2<NT){WAIT_BAR(1);} else {WAIT_BAR(0);} }while(0)
  for(;t+1<NT;t+=2){
    STEP(pB0,pB1,pA0,pA1,t,(t+3<NT),(t+1<NT),(t+1<NT));       ENDW(t);   RESC(); ROT();
    STEP(pA0,pA1,pB0,pB1,t+1,(t+4<NT),(t+2<NT),(t+2<NT));     ENDW(t+1); RESC(); ROT();
  }
  STEP(pB0,pB1,pA0,pA1,NT-1,false,false,false); RESC();
  { float sacc=pB0[0]+pB0[1]; _Pragma("unroll") for(int r=2;r<16;++r)sacc+=pB0[r]; _Pragma("unroll") for(int r=0;r<16;++r)sacc+=pB1[r]; l_reg+=sacc;
    pw0=(u32x4){PKW(pB0,0),PKW(pB0,2),PKW(pB0,4),PKW(pB0,6)};pw1=(u32x4){PKW(pB0,8),PKW(pB0,10),PKW(pB0,12),PKW(pB0,14)};pw2=(u32x4){PKW(pB1,0),PKW(pB1,2),PKW(pB1,4),PKW(pB1,6)};pw3=(u32x4){PKW(pB1,8),PKW(pB1,10),PKW(pB1,12),PKW(pB1,14)};
    SBAR(); pv(o,vb0+sl_cur,PAF(0),PAF(1),PAF(2),PAF(3)); }
  #undef PKW
  #undef PAF
  #undef VFR
  #undef PIN
  #undef MX3
  #undef GAPA
  #undef GAPB
  #undef EX
  #undef VRD
  #undef KRD
  #undef STEP
  #undef ENDW
  {auto rr=__builtin_amdgcn_permlane32_swap(__float_as_uint(l_reg),__float_as_uint(l_reg),false,false);l_reg=__uint_as_float(rr[0])+__uint_as_float(rr[1]);}
  if(hi==0)wsf[32+r32]=l_reg;asm volatile("s_waitcnt lgkmcnt(0)":::"memory");
  float rli[16];
  #pragma unroll
  for(int r=0;r<16;++r)rli[r]=__builtin_amdgcn_rcpf(wsf[32+crow(r,hi)]);
  bf16*Ow=O+(rowbase+q0+wid*QBLK)*PO;
  { bf16*stg=(bf16*)(shm+LDS_OST)+wid*2048;
    #pragma unroll
    for(int r=0;r<16;++r){const int orow=crow(r,hi);
      #pragma unroll
      for(int d0=0;d0<2;++d0)stg[orow*64+d0*32+r32]=__float2bfloat16(o[d0][r]*rli[r]);}
    asm volatile("s_waitcnt lgkmcnt(0)":::"memory");
    #pragma unroll
    for(int i=0;i<4;++i){const int row=i*8+(lane>>3),ch=lane&7; const u32x4 v=*(const u32x4*)(stg+row*64+ch*8); ATTN_STORE16(Ow+(long)row*PO+ch*8,v);} }
  asm volatile("s_waitcnt lgkmcnt(0)\n\ts_barrier":::"memory");
  #undef DMA_K
  #undef DMA_V
  #undef CMASK
  #undef START
  #undef RESC
  #undef ROT
}
constexpr int ATTN_LDS_BYTES=LDS_BYTES;
#undef SBAR
#undef WAIT_BAR
}
#define GAS __attribute__((address_space(1)))
#define LAS __attribute__((address_space(3)))
typedef unsigned short bf16;
typedef unsigned v4u __attribute__((ext_vector_type(4)));
typedef unsigned v2u __attribute__((ext_vector_type(2)));
typedef float f32x4 __attribute__((ext_vector_type(4)));
typedef float f32x16 __attribute__((ext_vector_type(16)));
typedef short bf16x8 __attribute__((ext_vector_type(8)));
#define LDS_WAIT() asm volatile("s_waitcnt lgkmcnt(0)" ::: "memory")

constexpr int NWAVES = 8;
constexpr int BATCH = 8, SEQ = 4096, DMODEL = 1024, FF = 4096;
constexpr int M = BATCH * SEQ;
constexpr int EVEN_IN = 3072, ODD_IN = 1280;
constexpr float C2 = 0.125f * 1.4426950408889634f;
constexpr float LOG2E = 1.4426950408889634f;
constexpr float RMS_EPS = 1e-6f, DIFF_EPS = 1e-5f;
constexpr float LAM_INIT0 = 0.2f;

constexpr size_t MiB = 1u << 20;
constexpr int RING_BYTES = 131072;
constexpr int LDS_BYTES = 147456;
constexpr size_t WS_WIN = 2 * MiB, WS_WOUT = 8 * MiB, WS_WQKV = 10 * MiB, WS_WO = 13 * MiB, WS_W1 = 16 * MiB  , WS_W2 = 32 * MiB  ;
constexpr size_t WS_CS = 48 * MiB  , WS_BQKV = 50 * MiB, WS_RS = 51 * MiB  ;
constexpr size_t WS_CNT = 64 * 1024;
constexpr size_t WS_SLOT = 52 * MiB;
constexpr size_t WS_BAR = 0;
constexpr int MISC_OFF = RING_BYTES + 320;
constexpr size_t WS_XN = 64 * MiB;
constexpr size_t WS_A2 = 448 * MiB;
constexpr size_t WS_H = 128 * MiB;
constexpr size_t WS_PROJ = 192 * MiB;
constexpr size_t WS_ATT = 384 * MiB;
constexpr size_t WS_HF = 192 * MiB;
constexpr size_t WS_END = 512 * MiB;


struct Args {
    const float* x; const int* pos;
    const float *npre_mix, *npost_mix, *npre_mlp, *npost_mlp;
    const float *w_in, *conv_w, *lq1, *lk1, *lq2, *lk2, *subln, *w_out;
    const float *w_qkv, *b_qkv, *sinks, *w_o, *b_o, *w1, *w2;
    float* out; unsigned char* ws;
    float inv_freq[8];
};

__device__ __forceinline__ float wave_sum(float v) {
#pragma unroll
    for (int o = 1; o < 64; o <<= 1) v += __shfl_xor(v, o);
    return v;
}
__device__ __forceinline__ unsigned f2bf(float f) { unsigned u = __builtin_bit_cast(unsigned, f); return (u + 0x7fffu + ((u >> 16) & 1u)) >> 16; }
__device__ __forceinline__ unsigned pk2(float lo, float hi) { return f2bf(lo) | (f2bf(hi) << 16); }
__device__ __forceinline__ float bflo(unsigned w) { return __builtin_bit_cast(float, w << 16); }
__device__ __forceinline__ float bfhi(unsigned w) { return __builtin_bit_cast(float, w & 0xffff0000u); }
__device__ __forceinline__ int mapcol(int n) { const int hl = n & 63; return hl < 16 ? (n & ~63) + (hl >> 1) + 8 * (hl & 1) : n; }

__device__ __forceinline__ void p0_transpose_item(const float* W, int K, int N, bf16* WT, LAS float* scr, int item, int lane, int perm_lo, int perm_hi, const float* g) {
    const int nblk = N / 32, kb = item / nblk, nb = item % nblk, k0 = 64 * kb, n0 = 32 * nb;
    int ncol = n0 + (lane & 31); if (ncol >= perm_lo && ncol < perm_hi) ncol = mapcol(ncol);
    if (perm_lo == 1536 && ncol >= 512 && ncol < 1536) { const int w_ = (ncol - 512) & 255, tt_ = (ncol - 512) >> 8; ncol = (w_ < 128 ? 512 : 1024 - 128) + 128 * tt_ + w_; }
    float wv[32];
#pragma unroll
    for (int i = 0; i < 32; ++i) { const int kk = 2 * i + (lane >> 5); wv[i] = __builtin_nontemporal_load(W + (size_t)(k0 + kk) * N + ncol); }
    if (g) {
#pragma unroll
        for (int i = 0; i < 32; ++i) { const int kk = 2 * i + (lane >> 5); wv[i] *= g[k0 + kk]; } }
#pragma unroll
    for (int i = 0; i < 32; ++i) { const int kk = 2 * i + (lane >> 5); scr[kk * 33 + (lane & 31)] = wv[i]; }
    LDS_WAIT(); asm volatile("" ::: "memory");
    const int c = lane & 7;
#pragma unroll
    for (int j = 0; j < 4; ++j) { const int n = (lane >> 3) + 8 * j; const LAS float* s = scr + (8 * c) * 33 + n;
        v4u o; o.x = pk2(s[0 * 33], s[1 * 33]); o.y = pk2(s[2 * 33], s[3 * 33]); o.z = pk2(s[4 * 33], s[5 * 33]); o.w = pk2(s[6 * 33], s[7 * 33]);
        *(GAS v4u*)(WT + (size_t)(n0 + n) * K + k0 + 8 * c) = o; }
    LDS_WAIT(); asm volatile("" ::: "memory");
}

__device__ __forceinline__ void unpack8(const v4u w, float (&f)[8]) { f[0] = bflo(w.x); f[1] = bfhi(w.x); f[2] = bflo(w.y); f[3] = bfhi(w.y); f[4] = bflo(w.z); f[5] = bfhi(w.z); f[6] = bflo(w.w); f[7] = bfhi(w.w); }
template <int RPI> __device__ __forceinline__ void x_rows_to_bf16(const float* x, bf16* XB, float* rsp, int row0, int lane) {
    f32x4 v[RPI][4];
#pragma unroll
    for (int r = 0; r < RPI; ++r) { const GAS f32x4* xr = (const GAS f32x4*)(x + (size_t)(row0 + r) * DMODEL) + lane;
#pragma unroll
        for (int j = 0; j < 4; ++j) v[r][j] = __builtin_nontemporal_load(xr + 64 * j); }
    float s[RPI];
#pragma unroll
    for (int r = 0; r < RPI; ++r) { s[r] = 0.f; GAS unsigned long long* o8 = (GAS unsigned long long*)(XB + (size_t)(row0 + r) * DMODEL) + lane;
#pragma unroll
        for (int j = 0; j < 4; ++j) { s[r] += (v[r][j].x * v[r][j].x + v[r][j].y * v[r][j].y) + (v[r][j].z * v[r][j].z + v[r][j].w * v[r][j].w);
            o8[64 * j] = (unsigned long long)pk2(v[r][j].x, v[r][j].y) | ((unsigned long long)pk2(v[r][j].z, v[r][j].w) << 32); } }
#pragma unroll
    for (int o = 1; o < 64; o <<= 1)
#pragma unroll
        for (int r = 0; r < RPI; ++r) s[r] += __shfl_xor(s[r], o);
#pragma unroll
    for (int r = 0; r < RPI; ++r) if (lane == r) rsp[row0 + r] = 1.f / sqrtf(s[r] * (1.f / DMODEL) + RMS_EPS);
}

template <int RPI> __device__ __forceinline__ void nr_pass(int gw, int NGW, int lane_, const bf16* H, bf16* XB, const float* wpost, float* rsout, float* outf) {
    int lane = lane_; asm volatile("" : "+v"(lane));
    f32x4 wp[2][2];
#pragma unroll
    for (int j = 0; j < 2; ++j)
#pragma unroll
        for (int e = 0; e < 2; ++e) wp[j][e] = *(const f32x4*)(wpost + 8 * lane + 512 * j + 4 * e);
    for (int row0 = gw * RPI; row0 < M; row0 += NGW * RPI) {
        v4u hw[RPI][2], xw[RPI][2];
#pragma unroll
        for (int r = 0; r < RPI; ++r)
#pragma unroll
            for (int j = 0; j < 2; ++j) { hw[r][j] = __builtin_nontemporal_load((const GAS v4u*)(H + (size_t)(row0 + r) * DMODEL + 8 * lane + 512 * j)); xw[r][j] = *(const GAS v4u*)(XB + (size_t)(row0 + r) * DMODEL + 8 * lane + 512 * j); }
        float ss[RPI];
#pragma unroll
        for (int r = 0; r < RPI; ++r) { ss[r] = 0.f;
#pragma unroll
            for (int j = 0; j < 2; ++j) { float f[8]; unpack8(hw[r][j], f);
#pragma unroll
                for (int e = 0; e < 8; ++e) ss[r] += f[e] * f[e]; } }
#pragma unroll
        for (int o = 1; o < 64; o <<= 1)
#pragma unroll
            for (int r = 0; r < RPI; ++r) ss[r] += __shfl_xor(ss[r], o);
        float s2[RPI];
#pragma unroll
        for (int r = 0; r < RPI; ++r) { const float rs = 1.f / sqrtf(ss[r] * (1.f / DMODEL) + RMS_EPS); s2[r] = 0.f;
#pragma unroll
            for (int j = 0; j < 2; ++j) { float f[8], x[8]; unpack8(hw[r][j], f); unpack8(xw[r][j], x);
                f32x4 x0 = (f32x4){x[0], x[1], x[2], x[3]} + (f32x4){f[0], f[1], f[2], f[3]} * rs * wp[j][0], x1 = (f32x4){x[4], x[5], x[6], x[7]} + (f32x4){f[4], f[5], f[6], f[7]} * rs * wp[j][1];
                s2[r] += ((x0.x * x0.x + x0.y * x0.y) + (x0.z * x0.z + x0.w * x0.w)) + ((x1.x * x1.x + x1.y * x1.y) + (x1.z * x1.z + x1.w * x1.w));
                if (outf) { *(GAS f32x4*)(outf + (size_t)(row0 + r) * DMODEL + 8 * lane + 512 * j) = x0; *(GAS f32x4*)(outf + (size_t)(row0 + r) * DMODEL + 8 * lane + 512 * j + 4) = x1; }
                else { v4u o; o.x = pk2(x0.x, x0.y); o.y = pk2(x0.z, x0.w); o.z = pk2(x1.x, x1.y); o.w = pk2(x1.z, x1.w); *(GAS v4u*)(XB + (size_t)(row0 + r) * DMODEL + 8 * lane + 512 * j) = o; } } }
        if (rsout) {
#pragma unroll
            for (int o = 1; o < 64; o <<= 1)
#pragma unroll
                for (int r = 0; r < RPI; ++r) s2[r] += __shfl_xor(s2[r], o);
#pragma unroll
            for (int r = 0; r < RPI; ++r) if (lane == r) rsout[row0 + r] = 1.f / sqrtf(s2[r] * (1.f / DMODEL) + RMS_EPS);
        }
    }
}


__device__ __forceinline__ void mix_pass(int gw, int NGW, int lane_, const bf16* PROJ, const bf16* ATT, bf16* A2, const float* conv_w, const float* subln, float lam) {
    int lane = lane_; asm volatile("" : "+v"(lane));
    float cw[3][8], sw[8];
#pragma unroll
    for (int i = 0; i < 3; ++i)
#pragma unroll
        for (int e = 0; e < 8; ++e) cw[i][e] = conv_w[i * 512 + 8 * lane + e];
#pragma unroll
    for (int e = 0; e < 8; ++e) sw[e] = subln[(lane & 15) * 8 + e] * (1.0f - LAM_INIT0);
    for (int row0 = gw * 2; row0 < M; row0 += NGW * 2) {
        const int t0 = row0 & (SEQ - 1);
        const bf16* pr = PROJ + (size_t)row0 * EVEN_IN + 8 * lane;
        const bf16* ar = ATT + (size_t)row0 * DMODEL + (lane >> 4) * 256 + (lane & 15) * 8;
        v4u gbw[2], uw[4], o0w[2], o1w[2];
#pragma unroll
        for (int r = 0; r < 2; ++r) { gbw[r] = *(const GAS v4u*)(pr + r * EVEN_IN); o0w[r] = *(const GAS v4u*)(ar + r * DMODEL); o1w[r] = *(const GAS v4u*)(ar + r * DMODEL + 128); }
#pragma unroll
        for (int r = 0; r < 4; ++r) { if (r >= 2 || t0 > 0) uw[r] = *(const GAS v4u*)(pr + (r - 2) * EVEN_IN + 512);
            else uw[r] = (v4u){0u, 0u, 0u, 0u}; }
        float u[4][8];
#pragma unroll
        for (int r = 0; r < 4; ++r) unpack8(uw[r], u[r]);
#pragma unroll
        for (int r = 0; r < 2; ++r) { float gb[8], co[8]; unpack8(gbw[r], gb);
#pragma unroll
            for (int e = 0; e < 8; ++e) co[e] = gb[e] * (cw[0][e] * u[r][e] + cw[1][e] * u[r + 1][e] + cw[2][e] * u[r + 2][e]);
            v4u o; o.x = pk2(co[0], co[1]); o.y = pk2(co[2], co[3]); o.z = pk2(co[4], co[5]); o.w = pk2(co[6], co[7]);
            *(GAS v4u*)(A2 + (size_t)(row0 + r) * DMODEL + 8 * lane) = o; }
#pragma unroll
        for (int r = 0; r < 2; ++r) { float o0[8], o1[8], d[8]; unpack8(o0w[r], o0); unpack8(o1w[r], o1);
            float ss = 0.f;
#pragma unroll
            for (int e = 0; e < 8; ++e) { d[e] = o0[e] - lam * o1[e]; ss += d[e] * d[e]; }
            ss += __shfl_xor(ss, 1); ss += __shfl_xor(ss, 2); ss += __shfl_xor(ss, 4); ss += __shfl_xor(ss, 8);
            const float rs = 1.f / sqrtf(ss * (1.f / 128.f) + DIFF_EPS);
#pragma unroll
            for (int e = 0; e < 8; ++e) d[e] = d[e] * rs * sw[e];
            v4u o; o.x = pk2(d[0], d[1]); o.y = pk2(d[2], d[3]); o.z = pk2(d[4], d[5]); o.w = pk2(d[6], d[7]);
            *(GAS v4u*)(A2 + (size_t)(row0 + r) * DMODEL + 512 + 8 * lane) = o; }
    }
}

__device__ __forceinline__ int crow16(int r, int hi) { return (r & 3) + 8 * (r >> 2) + 4 * hi; }
__device__ __forceinline__ unsigned cvtpk(float lo, float hi) { typedef float f2 __attribute__((ext_vector_type(2))); typedef __bf16 b2 __attribute__((ext_vector_type(2))); f2 v = {lo, hi}; b2 b = __builtin_convertvector(v, b2); return __builtin_bit_cast(unsigned, b); }

constexpr int VTP = 264;
__device__ __forceinline__ void swa_phase(int vcu, int G, LAS unsigned char* lds, const bf16* QKV, const float* sinks, bf16* ATT) {
    int tid_ = threadIdx.x; asm volatile("" : "+v"(tid_)); const int tid = tid_, lane = tid & 63, q = lane & 31, hi = lane >> 5; const int wid = __builtin_amdgcn_readfirstlane(tid >> 6);
    LAS unsigned char* Kl = lds; LAS bf16* Vt = (LAS bf16*)(lds + 32768);
    for (int unit = vcu; unit < BATCH * 32 * 2; unit += G) {
        const int b = unit >> 6, blk = (unit & 63) >> 1, kvh = unit & 1;
        __syncthreads();
        v4u kvr[4], vvr[4];
#pragma unroll
        for (int i = 0; i < 4; ++i) { const int idx = tid + 512 * i, row = idx >> 3, ch = idx & 7; const int t = blk * 128 - 128 + row;
            kvr[i] = (v4u){0u, 0u, 0u, 0u}; if (t >= 0) kvr[i] = *(const GAS v4u*)(QKV + (size_t)(b * SEQ + t) * ODD_IN + 1024 + kvh * 64 + ch * 8);
            const int row2 = idx & 255, ch2 = idx >> 8; const int t2 = blk * 128 - 128 + row2;
            vvr[i] = (v4u){0u, 0u, 0u, 0u}; if (t2 >= 0) vvr[i] = *(const GAS v4u*)(QKV + (size_t)(b * SEQ + t2) * ODD_IN + 1152 + kvh * 64 + ch2 * 8); }
#pragma unroll
        for (int i = 0; i < 4; ++i) { const int idx = tid + 512 * i, row = idx >> 3, ch = idx & 7; const v4u kv = kvr[i], vv = vvr[i];
            *(LAS v4u*)(Kl + ch * 4096 + row * 16) = kv;
            const int kvi = idx & 255, kc = kvi & 15, kpos = (kvi & ~15) + ((kc & 3) | ((kc & 4) << 1) | ((kc & 8) >> 1));
            LAS bf16* vp = Vt + ((idx >> 8) * 8) * VTP + kpos;
            vp[0 * VTP] = (bf16)(vv.x & 0xffffu); vp[1 * VTP] = (bf16)(vv.x >> 16); vp[2 * VTP] = (bf16)(vv.y & 0xffffu); vp[3 * VTP] = (bf16)(vv.y >> 16);
            vp[4 * VTP] = (bf16)(vv.z & 0xffffu); vp[5 * VTP] = (bf16)(vv.z >> 16); vp[6 * VTP] = (bf16)(vv.w & 0xffffu); vp[7 * VTP] = (bf16)(vv.w >> 16); }
        __syncthreads();
        const int head = kvh * 8 + wid; const float sink2 = sinks[head] * LOG2E;
        if (wid >= 4) __builtin_amdgcn_s_sleep(90);
        bf16x8 qn[4];
        { const size_t tok0 = (size_t)b * SEQ + blk * 128 + q;
#pragma unroll
            for (int ks = 0; ks < 4; ++ks) qn[ks] = *(const GAS bf16x8*)(QKV + tok0 * ODD_IN + head * 64 + 16 * ks + 8 * hi); }
        for (int ci = 0; ci < 4; ++ci) {
            const int r0 = 32 * ci; const size_t tok = (size_t)b * SEQ + blk * 128 + r0 + q;
            bf16x8 qf[4];
#pragma unroll
            for (int ks = 0; ks < 4; ++ks) qf[ks] = qn[ks];
            if (ci < 3) {
#pragma unroll
                for (int ks = 0; ks < 4; ++ks) qn[ks] = *(const GAS bf16x8*)(QKV + (tok + 32) * ODD_IN + head * 64 + 16 * ks + 8 * hi); }
            f32x16 p[5];
#pragma unroll
            for (int jt = 0; jt < 5; ++jt) p[jt] = (f32x16){};
#pragma unroll
            for (int ks = 0; ks < 4; ++ks)
#pragma unroll
                for (int jt = 0; jt < 5; ++jt) { const bf16x8 kf = *(const LAS bf16x8*)(Kl + (2 * ks + hi) * 4096 + (r0 + 32 * jt + q) * 16); p[jt] = __builtin_amdgcn_mfma_f32_32x32x16_bf16(kf, qf[ks], p[jt], 0, 0, 0); }
            float mx = -INFINITY;
            if (blk == 0) {
#pragma unroll
                for (int jt = 0; jt < 5; ++jt)
#pragma unroll
                    for (int r = 0; r < 16; ++r) { const int j = r0 + 32 * jt + crow16(r, hi); const bool valid = (j >= r0 + q + 1) && (j <= r0 + q + 128) && (j >= 128);
                        p[jt][r] = valid ? p[jt][r] : -INFINITY; }
            } else {
#pragma unroll
                for (int r = 0; r < 16; ++r) { const int c = crow16(r, hi); p[0][r] = (c > q) ? p[0][r] : -INFINITY; p[4][r] = (c <= q) ? p[4][r] : -INFINITY; }
            }
#pragma unroll
            for (int jt = 0; jt < 5; ++jt)
#pragma unroll
                for (int r = 0; r < 16; ++r) mx = fmaxf(mx, p[jt][r]);
            mx = fmaxf(mx, __shfl_xor(mx, 32)); mx = fmaxf(mx, sink2);
            float l = 0.f;
#pragma unroll
            for (int jt = 0; jt < 5; ++jt)
#pragma unroll
                for (int r = 0; r < 16; ++r) { p[jt][r] = __builtin_amdgcn_exp2f(p[jt][r] - mx); l += p[jt][r]; }
            l += __shfl_xor(l, 32); l += __builtin_amdgcn_exp2f(sink2 - mx);
            f32x16 o[2]; o[0] = (f32x16){}; o[1] = (f32x16){};
#pragma unroll
            for (int jt = 0; jt < 5; ++jt)
#pragma unroll
                for (int kb = 0; kb < 2; ++kb) { v4u pw; pw.x = cvtpk(p[jt][8 * kb + 0], p[jt][8 * kb + 1]); pw.y = cvtpk(p[jt][8 * kb + 2], p[jt][8 * kb + 3]); pw.z = cvtpk(p[jt][8 * kb + 4], p[jt][8 * kb + 5]); pw.w = cvtpk(p[jt][8 * kb + 6], p[jt][8 * kb + 7]);
                    const bf16x8 pf = __builtin_bit_cast(bf16x8, pw);
#pragma unroll
                    for (int dt = 0; dt < 2; ++dt) { const bf16x8 vf = *(const LAS bf16x8*)(Vt + (32 * dt + q) * VTP + r0 + 32 * jt + 16 * kb + 8 * hi);
                        o[dt] = __builtin_amdgcn_mfma_f32_32x32x16_bf16(vf, pf, o[dt], 0, 0, 0); } }
            const float il = 1.f / l;
            bf16* op = ATT + tok * DMODEL + head * 64 + 8 * hi;
#pragma unroll
            for (int dt = 0; dt < 2; ++dt)
#pragma unroll
                for (int rp = 0; rp < 2; ++rp) {
                    v2u y, x; y.x = cvtpk(o[dt][8 * rp] * il, o[dt][8 * rp + 1] * il); y.y = cvtpk(o[dt][8 * rp + 2] * il, o[dt][8 * rp + 3] * il);
                    x.x = cvtpk(o[dt][8 * rp + 4] * il, o[dt][8 * rp + 5] * il); x.y = cvtpk(o[dt][8 * rp + 6] * il, o[dt][8 * rp + 7] * il);
                    const v2u snd = hi ? y : x;
                    v2u rcv; rcv.x = __shfl_xor(snd.x, 32); rcv.y = __shfl_xor(snd.y, 32);
                    v4u w; if (hi) { w.x = rcv.x; w.y = rcv.y; w.z = x.x; w.w = x.y; } else { w.x = y.x; w.y = y.y; w.z = rcv.x; w.w = rcv.y; }
                    *(GAS v4u*)(op + 32 * dt + 16 * rp) = w; }
        }
    }
}
#define RLX_AGENT __ATOMIC_RELAXED, __HIP_MEMORY_SCOPE_AGENT
#define XB_TMO      128
#define XB_XCNT(j)  (256  + 64 * (j))
#define XB_XSUB(j)  (1280 + 64 * (j))
#define XB_XGEN(j)  (2304 + 64 * (j))
#define XB_TOP      3328
#define XB_TOPGEN   3392
#define XCD_BAR_WORDS 3456
#define XB_SPIN_CAP (1u << 18)

__device__ __forceinline__ unsigned xb_ld(unsigned* p)              { return __hip_atomic_load(p, __ATOMIC_RELAXED, __HIP_MEMORY_SCOPE_AGENT); }
__device__ __forceinline__ unsigned xb_add(unsigned* p, unsigned v) { return __hip_atomic_fetch_add(p, v, __ATOMIC_RELAXED, __HIP_MEMORY_SCOPE_AGENT); }
__device__ __forceinline__ unsigned xb_xcc_id() { return (unsigned)__builtin_amdgcn_s_getreg((3 << 11) | 20) & 0xFu; }
#define XB_SPIN(cond, bar) do { unsigned _sp = 0; while (cond) { __builtin_amdgcn_s_sleep(1); \
    if ((++_sp & 255u) == 0u) { if (xb_ld(&(bar)[XB_TMO])) break; if (_sp > XB_SPIN_CAP) { atomicAdd(&(bar)[XB_TMO], 1u); break; } } } } while (0)

struct XcdBarrier {
    unsigned* bar; unsigned x;
    volatile LAS unsigned* st;
};

__device__ __forceinline__ XcdBarrier xcd_barrier_post(unsigned* bar, volatile LAS unsigned* st) {
    XcdBarrier b; b.bar = bar; b.x = xb_xcc_id(); b.st = st;
    if (threadIdx.x == 0) (void)xb_add(&bar[XB_XCNT(b.x)], 1u);
    return b;
}
__device__ __forceinline__ void xcd_barrier_complete(unsigned* bar, unsigned x, unsigned& nloc, unsigned& nx) {
    const unsigned G = gridDim.x * gridDim.y * gridDim.z;
    unsigned sum, cnt, mine, sp = 0u;
    for (;;) {
        sum = 0u; cnt = 0u; mine = 0u;
#pragma unroll
        for (unsigned j = 0; j < 16; ++j) { const unsigned c = xb_ld(&bar[XB_XCNT(j)]); sum += c; cnt += (c > 0u) ? 1u : 0u; mine = (j == x) ? c : mine; }
        if (sum == G) break;
        __builtin_amdgcn_s_sleep(1);
        if ((++sp & 255u) == 0u) { if (xb_ld(&bar[XB_TMO])) break; if (sp > XB_SPIN_CAP) { atomicAdd(&bar[XB_TMO], 1u); break; } }
    }
    nloc = mine > 0u ? mine : 1u; nx = cnt > 0u ? cnt : 1u;
}

__device__ __forceinline__ void xcd_barrier(const XcdBarrier& b) {
    asm volatile("s_waitcnt vmcnt(0)" ::: "memory");
    __syncthreads();
    if (threadIdx.x == 0) {
        unsigned* bar = b.bar;
        __builtin_amdgcn_s_waitcnt(0);
        unsigned nloc = b.st[0], nx = b.st[1];
        if (nloc == 0u) { xcd_barrier_complete(bar, b.x, nloc, nx); b.st[0] = nloc; b.st[1] = nx; }
        const unsigned old = xb_add(&bar[XB_XSUB(b.x)], 1u);
        const unsigned gen = old / nloc;
        if (old + 1u == (gen + 1u) * nloc) {
            __builtin_amdgcn_fence(__ATOMIC_RELEASE, "agent");
            asm volatile("s_waitcnt vmcnt(0)" ::: "memory");
            const unsigned og = xb_add(&bar[XB_TOP], 1u);
            const unsigned tg = og / nx;
            if (og + 1u == (tg + 1u) * nx) xb_add(&bar[XB_TOPGEN], 1u);
            else XB_SPIN(xb_ld(&bar[XB_TOPGEN]) == tg, bar);
            __builtin_amdgcn_fence(__ATOMIC_ACQUIRE, "agent");
            xb_add(&bar[XB_XGEN(b.x)], 1u);
            asm volatile("s_waitcnt vmcnt(0)" ::: "memory");
        } else {
            XB_SPIN(xb_ld(&bar[XB_XGEN(b.x)]) == gen, bar);
            __builtin_amdgcn_fence(__ATOMIC_ACQUIRE, "agent");
            asm volatile("s_waitcnt vmcnt(0)" ::: "memory");
        }
    }
    __syncthreads();
}
__global__ void __launch_bounds__(NWAVES * 64, 2) fwd_kernel(Args a) {
    extern __shared__ __attribute__((aligned(16))) unsigned char lds_raw[];
    cg::grid_group grid = cg::this_grid();
    LAS unsigned char* lds = (LAS unsigned char*)lds_raw;
    const int tid = threadIdx.x, lane = tid & 63, wave = __builtin_amdgcn_readfirstlane(tid >> 6);
    const int G = gridDim.x, bx = blockIdx.x, vcu = (G % 8 == 0) ? (bx % 8) * (G / 8) + bx / 8 : bx;
    const int gw = vcu * NWAVES + wave, NGW = G * NWAVES;
    unsigned char* ws = a.ws;
    bf16* Win_t = (bf16*)(ws + WS_WIN); bf16* Wout_t = (bf16*)(ws + WS_WOUT); bf16* Wqkv_t = (bf16*)(ws + WS_WQKV); bf16* Wo_t = (bf16*)(ws + WS_WO);
    bf16* W1_t = (bf16*)(ws + WS_W1); bf16* W2_t = (bf16*)(ws + WS_W2);
    float* cs = (float*)(ws + WS_CS); float* bqkv_p = (float*)(ws + WS_BQKV);
    bf16* XB = (bf16*)(ws + WS_XN); bf16* A2 = (bf16*)(ws + WS_A2); bf16* H = (bf16*)(ws + WS_H); float* RS = (float*)(ws + WS_RS); bf16* PROJ = (bf16*)(ws + WS_PROJ); bf16* ATT = (bf16*)(ws + WS_ATT); bf16* HF = (bf16*)(ws + WS_HF);

    unsigned* barw = (unsigned*)(ws + WS_BAR);
    volatile LAS unsigned* MISC = (volatile LAS unsigned*)(lds + MISC_OFF);
    if (tid < 32) MISC[tid] = 0u;
    if (bx == 0) for (int i = tid; i < XCD_BAR_WORDS; i += NWAVES * 64) barw[i] = 0u;
    {
        LAS float* scr = (LAS float*)(lds + wave * 16384);
        constexpr int I_IN = 16 * 96, I_SQ = 16 * 32, I_QKV = 16 * 40, I_W1 = 16 * 128, I_W2 = 64 * 32;
        constexpr int NITEMS = I_IN + I_SQ + I_QKV + I_SQ + I_W1 + I_W2;
        for (int it = gw; it < NITEMS; it += NGW) {
            int r = it;
            if (r < I_IN) { p0_transpose_item(a.w_in, 1024, EVEN_IN, Win_t, scr, r, lane, 1536, 2560, a.npre_mix); continue; } r -= I_IN;
            if (r < I_SQ) { p0_transpose_item(a.w_out, 1024, 1024, Wout_t, scr, r, lane, 0, 0, nullptr); continue; } r -= I_SQ;
            if (r < I_QKV) { p0_transpose_item(a.w_qkv, 1024, ODD_IN, Wqkv_t, scr, r, lane, 0, 1152, a.npre_mix + 1024); continue; } r -= I_QKV;
            if (r < I_SQ) { p0_transpose_item(a.w_o, 1024, 1024, Wo_t, scr, r, lane, 0, 0, nullptr); continue; } r -= I_SQ;
            if (r < I_W1) { p0_transpose_item(a.w1, 1024, FF, W1_t, scr, r, lane, 0, 0, a.npre_mlp); continue; } r -= I_W1;
            p0_transpose_item(a.w2, FF, 1024, W2_t, scr, r, lane, 0, 0, nullptr);
        }
        const int gtid = vcu * (NWAVES * 64) + tid, nthr = G * NWAVES * 64;
        for (int i = gtid; i < ODD_IN; i += nthr) bqkv_p[i] = a.b_qkv[i < 1152 ? mapcol(i) : i];
        for (int i = gtid; i < 128 * 64; i += nthr) ((unsigned*)(ws + WS_CNT))[i] = 0u;
        for (int row = gtid; row < M; row += nthr) { const float pf = (float)a.pos[row];
#pragma unroll
            for (int i = 0; i < 8; ++i) { const float ang = pf * a.inv_freq[i]; const double t = (double)ang * 0.15915494309189535; const float fr = (float)(t - floor(t));
                cs[(size_t)row * 16 + 2 * i] = __builtin_amdgcn_cosf(fr); cs[(size_t)row * 16 + 2 * i + 1] = __builtin_amdgcn_sinf(fr); } }
        for (int m = gw * 4; m < M; m += NGW * 4) x_rows_to_bf16<4>(a.x, XB, RS, m, lane);
    }
    grid.sync();
    const XcdBarrier bar = xcd_barrier_post(barw, MISC + 8);
#define GRID_BAR() xcd_barrier(bar)

    {
        pg8::Gemm g{XB, Win_t, M, EVEN_IN, 1024};
        pg8::StaticOrder S; S.init(M, EVEN_IN, G, bx);
        pg8::EpiInProj E{{PROJ, EVEN_IN, nullptr, cs, 1536, 2048, 2048, 2560, C2, RS, 0}, {PROJ, EVEN_IN, RS}};
        pg8::gemm_phase<pg8::EpiInProj, pg8::StaticOrder, true, true>(lds, g, S, E);
    }
    GRID_BAR();
    {
        for (int p = vcu; p < BATCH * 16 * 8; p += G) {
            const int bvh = p >> 3, s = p & 7, b = bvh >> 4, vh = bvh & 15, h = vh >> 2, c = (vh >> 1) & 1, half = vh & 1;
            const attn_body::bf16* Q = (const attn_body::bf16*)PROJ + 1536 + (h * 2 + c) * 64;
            const attn_body::bf16* K = (const attn_body::bf16*)PROJ + 2048 + (h * 2 + c) * 64;
            const attn_body::bf16* V = (const attn_body::bf16*)PROJ + 2560 + h * 128 + half * 64;
            attn_body::bf16* O = (attn_body::bf16*)ATT + vh * 64;
            attn_body::attn_unit<8>(b, 15 - s, Q, K, V, O, (char*)lds_raw);
            attn_body::attn_unit<8>(b, s, Q, K, V, O, (char*)lds_raw);
        }
    }
    GRID_BAR();
    {
        const float s1 = wave_sum(a.lq1[lane] * a.lk1[lane]), s2 = wave_sum(a.lq2[lane] * a.lk2[lane]);
        const float lam = expf(s1) - expf(s2) + LAM_INIT0;
        mix_pass(gw, NGW, lane, PROJ, ATT, A2, a.conv_w, a.subln, lam);
    }
    GRID_BAR();
    {
        pg8::Gemm g{A2, Wout_t, M, 1024, 1024}; pg8::StaticOrder S; S.init(M, 1024, G, bx);
        pg8::EpiX<0> E{H, 1024, nullptr, nullptr, 0, 0, 0, 0, 1.f, nullptr, 0};
        pg8::gemm_phase<pg8::EpiX<0>, pg8::StaticOrder, true, true>(lds, g, S, E);
    }
    GRID_BAR();
    nr_pass<4>(gw, NGW, lane, H, XB, a.npost_mix, RS, nullptr);
    GRID_BAR();
#define MLP_PHASES(l) \
    {     \
        pg8::Gemm g{XB, W1_t + (size_t)(l) * 1024 * FF, M, FF, 1024}; pg8::StaticOrder S; S.init(M, FF, G, bx); \
        pg8::EpiX<1> E{HF, FF, nullptr, nullptr, 0, 0, 0, 0, 1.f, RS, 16}; \
        pg8::gemm_phase<pg8::EpiX<1>, pg8::StaticOrder, true, true>(lds, g, S, E); \
    } \
    GRID_BAR(); \
    {     \
        pg8::Gemm g{HF, W2_t + (size_t)(l) * 1024 * FF, M, 1024, FF}; pg8::RevOrder S; S.so.init(M, 1024, G, bx); S.nrounds = (S.so.nwg + G - 1) / G; \
        pg8::EpiX<0> E{H, 1024, nullptr, nullptr, 0, 0, 0, 0, 1.f, nullptr, 0}; \
        pg8::gemm_phase<pg8::EpiX<0>, pg8::RevOrder, true, true, true>(lds, g, S, E); \
    } \
    GRID_BAR();
    MLP_PHASES(0)
    nr_pass<4>(gw, NGW, lane, H, XB, a.npost_mlp, RS, nullptr);
    GRID_BAR();
    {
        pg8::Gemm g{XB, Wqkv_t, M, ODD_IN, 1024}; pg8::StaticOrder S; S.init(M, ODD_IN, G, bx);
        pg8::EpiX<2> E{PROJ, ODD_IN, bqkv_p, cs, 0, 1024, 1024, 1152, C2, RS, 0};
        pg8::gemm_phase<pg8::EpiX<2>, pg8::StaticOrder, true, true>(lds, g, S, E);
        int nbusy = M / 256 * (ODD_IN / 256) - 2 * G;
        if (nbusy < 0 || nbusy >= G) nbusy = 0;
        if (bx >= nbusy) {
            LAS float* scr = (LAS float*)(lds + wave * 16384);
            constexpr int I_W1 = 16 * 128, I_W2 = 64 * 32;
            for (int it = (bx - nbusy) * NWAVES + wave; it < I_W1 + I_W2; it += (G - nbusy) * NWAVES) {
                if (it < I_W1) p0_transpose_item(a.w1 + (size_t)1024 * FF, 1024, FF, W1_t + (size_t)1024 * FF, scr, it, lane, 0, 0, a.npre_mlp + 1024);
                else p0_transpose_item(a.w2 + (size_t)1024 * FF, FF, 1024, W2_t + (size_t)1024 * FF, scr, it - I_W1, lane, 0, 0, nullptr);
            }
        }
    }
    GRID_BAR();
    swa_phase(vcu, G, lds, PROJ, a.sinks, ATT);
    GRID_BAR();
    {
        pg8::Gemm g{ATT, Wo_t, M, 1024, 1024}; pg8::StaticOrder S; S.init(M, 1024, G, bx);
        pg8::EpiX<0> E{H, 1024, a.b_o, nullptr, 0, 0, 0, 0, 1.f, nullptr, 0};
        pg8::gemm_phase<pg8::EpiX<0>, pg8::StaticOrder, true, true>(lds, g, S, E);
    }
    GRID_BAR();
    nr_pass<4>(gw, NGW, lane, H, XB, a.npost_mix + 1024, RS, nullptr);
    GRID_BAR();
    {
        pg8::Gemm g{XB, W1_t + (size_t)1024 * FF, M, FF, 1024}; pg8::StaticOrder S; S.init(M, FF, G, bx);
        pg8::EpiX<1> E{HF, FF, nullptr, nullptr, 0, 0, 0, 0, 1.f, RS, 16};
        pg8::gemm_phase<pg8::EpiX<1>, pg8::StaticOrder, true, true>(lds, g, S, E);
    }
    GRID_BAR();
    for (int rnd = 0; rnd < 2; ++rnd) {
        pg8::Gemm g{HF, W2_t + (size_t)1024 * FF, M, 1024, FF}; pg8::OneRound S; S.so.init(M, 1024, G, bx); S.rnd = rnd;
        const pg8::PanelSS st{(float*)(ws + WS_SLOT), (unsigned*)(ws + WS_CNT), RMS_EPS};
        const pg8::EpiRmsOut E{XB, a.out, a.npost_mlp + 1024, st};
        pg8::gemm_phase<pg8::EpiRmsOut, pg8::OneRound, false, true, true>(lds, g, S, E);
        asm volatile("s_waitcnt lgkmcnt(0)" ::: "memory"); __builtin_amdgcn_s_barrier();
    }
#undef MLP_PHASES
}

extern "C" void kernel_launch(void* const* d_in, const int* in_sizes, int n_in, void* d_out, int out_size, void* d_ws, size_t ws_size, hipStream_t stream) {
    static int grid_blocks = 0;
    if (grid_blocks == 0) {
        if (n_in != 21 || in_sizes[0] != M * DMODEL || out_size != M * DMODEL || ws_size < WS_END) { fprintf(stderr, "kernel_launch: unexpected problem shape / workspace (n_in %d, ws %zu)\n", n_in, ws_size); grid_blocks = -1; return; }
        int dev = 0, cus = 0, per_cu = 0;
        if (hipGetDevice(&dev) != hipSuccess || hipDeviceGetAttribute(&cus, hipDeviceAttributeMultiprocessorCount, dev) != hipSuccess) { grid_blocks = -1; return; }
        if (hipFuncSetAttribute((const void*)fwd_kernel, hipFuncAttributeMaxDynamicSharedMemorySize, LDS_BYTES) != hipSuccess) { fprintf(stderr, "kernel_launch: hipFuncSetAttribute failed\n"); grid_blocks = -1; return; }
        if (hipOccupancyMaxActiveBlocksPerMultiprocessor(&per_cu, (const void*)fwd_kernel, NWAVES * 64, LDS_BYTES) != hipSuccess || per_cu < 1) { fprintf(stderr, "kernel_launch: occupancy query says %d blocks per CU\n", per_cu); grid_blocks = -1; (void)hipGetLastError(); return; }
        grid_blocks = cus;
    }
    if (grid_blocks < 0) return;
    Args a{};
    a.x = (const float*)d_in[0]; a.pos = (const int*)d_in[1];
    a.npre_mix = (const float*)d_in[2]; a.npost_mix = (const float*)d_in[3]; a.npre_mlp = (const float*)d_in[4]; a.npost_mlp = (const float*)d_in[5];
    a.w_in = (const float*)d_in[6]; a.conv_w = (const float*)d_in[7]; a.lq1 = (const float*)d_in[8]; a.lk1 = (const float*)d_in[9]; a.lq2 = (const float*)d_in[10]; a.lk2 = (const float*)d_in[11];
    a.subln = (const float*)d_in[12]; a.w_out = (const float*)d_in[13]; a.w_qkv = (const float*)d_in[14]; a.b_qkv = (const float*)d_in[15]; a.sinks = (const float*)d_in[16];
    a.w_o = (const float*)d_in[17]; a.b_o = (const float*)d_in[18]; a.w1 = (const float*)d_in[19]; a.w2 = (const float*)d_in[20];
    a.out = (float*)d_out; a.ws = (unsigned char*)d_ws;
    for (int i = 0; i < 8; ++i) a.inv_freq[i] = (float)pow(500000.0, -(double)i / 8.0);
    void* args[] = {&a};
    hipError_t e = hipLaunchCooperativeKernel((const void*)fwd_kernel, dim3(grid_blocks), dim3(NWAVES * 64), args, LDS_BYTES, stream);
    if (e != hipSuccess) fprintf(stderr, "kernel_launch: cooperative launch failed: %s (grid %d)\n", hipGetErrorString(e), grid_blocks);
}
```
